# Optimizing an MI355X kernel written in HIP

```python
import math
import jax, jax.numpy as jnp
from jax import lax
import numpy as np

D_MODEL = 2048
BATCH = 2
SEQ = 4096
DEPTH = 4

LRU_WIDTH = D_MODEL // 4
LRU_BLOCKS = 8
LRU_BLOCK_DIM = LRU_WIDTH // LRU_BLOCKS
LRU_CONV = 4
LRU_C = 8.0
RWKV_HEAD_DIM = 64
RWKV_HEADS = (3 * D_MODEL) // (8 * RWKV_HEAD_DIM)
RWKV_WIDTH = RWKV_HEADS * RWKV_HEAD_DIM
RWKV_DECAY_LORA = 64
RWKV_ICLR_LORA = 64
RWKV_DECAY_SCALE = math.exp(-0.5)
RWKV_GN_EPS = 64e-5
MOBA_HEAD_DIM = 64
MOBA_HEADS = (3 * D_MODEL) // (8 * MOBA_HEAD_DIM)
MOBA_WIDTH = MOBA_HEADS * MOBA_HEAD_DIM
MOBA_BLOCK = 256
MOBA_TOPK = 3
MOBA_QCHUNK = 64
MIX_WIDTH = LRU_WIDTH + RWKV_WIDTH + MOBA_WIDTH
REL_BUCKETS = 32
REL_MAX_DIST = 128
NORM_EPS = 1e-6

RWKV_STREAM = 3 * RWKV_WIDTH + RWKV_DECAY_LORA + RWKV_ICLR_LORA
IN_SPLITS = (LRU_WIDTH, LRU_WIDTH, RWKV_STREAM, RWKV_WIDTH, 3 * MOBA_WIDTH, MOBA_WIDTH)
IN_COLS = sum(IN_SPLITS)
IN_OFFSETS = tuple(int(o) for o in np.cumsum(IN_SPLITS)[:-1])
RWKV_OFFSETS = (RWKV_WIDTH, 2 * RWKV_WIDTH, 3 * RWKV_WIDTH, 3 * RWKV_WIDTH + RWKV_DECAY_LORA)

kernel_name = 'hybrid_lru_rwkv7_moba_block'


def rms_norm(x, w):
    xf = x.astype(jnp.float32)
    y = xf * lax.rsqrt(jnp.mean(xf * xf, axis=-1, keepdims=True) + NORM_EPS)
    return (y * w.astype(jnp.float32)).astype(x.dtype)


def rg_lru_branch(xa, conv_w, conv_b, ga_w, ga_b, gx_w, gx_b, lam):
    B, T, C = xa.shape
    xf = xa.astype(jnp.float32)
    xc = lax.conv_general_dilated(
        xf, conv_w.astype(jnp.float32)[:, None, :], window_strides=(1,),
        padding=[(LRU_CONV - 1, 0)], dimension_numbers=('NWC', 'WIO', 'NWC'),
        feature_group_count=C) + conv_b.astype(jnp.float32)
    xg = xc.reshape(B, T, LRU_BLOCKS, LRU_BLOCK_DIM)
    r = jax.nn.sigmoid(jnp.einsum('btgi,gij->btgj', xg, ga_w.astype(jnp.float32)).reshape(B, T, C) + ga_b)
    i = jax.nn.sigmoid(jnp.einsum('btgi,gij->btgj', xg, gx_w.astype(jnp.float32)).reshape(B, T, C) + gx_b)
    log_a = -LRU_C * r * jax.nn.softplus(-lam.astype(jnp.float32))
    a = jnp.exp(log_a)
    b = jnp.sqrt(-jnp.expm1(2.0 * log_a)) * (i * xc)

    def combine(left, right):
        a1, b1 = left
        a2, b2 = right
        return a1 * a2, a2 * b1 + b2

    _, h = lax.associative_scan(combine, (a, b), axis=1)
    return h


def token_shift(p):
    return jnp.pad(p, ((0, 0), (1, 0), (0, 0)))[:, :-1]


def rwkv7_branch(stream, mix, w0, w_up, a0, a_up, k_k, k_a, r_k, ln_w, ln_b):
    B, T, _ = stream.shape
    H, N = RWKV_HEADS, RWKV_HEAD_DIM
    s = stream.astype(jnp.float32)
    s = s + mix.astype(jnp.float32) * (token_shift(s) - s)
    r, k, v, wd, ad = jnp.split(s, RWKV_OFFSETS, axis=-1)
    log_w = -RWKV_DECAY_SCALE * jax.nn.sigmoid(w0 + jnp.tanh(wd) @ w_up.astype(jnp.float32))
    a = jax.nn.sigmoid(a0 + ad @ a_up.astype(jnp.float32))
    heads = lambda t: t.reshape(B, T, H, N)
    kk = heads(k * k_k)
    kk = kk / jnp.maximum(jnp.sqrt(jnp.sum(kk * kk, axis=-1, keepdims=True)), 1e-12)
    k = k * (1.0 + (a - 1.0) * k_a)
    r, k, v, a, w = heads(r), heads(k), heads(v), heads(a), heads(jnp.exp(log_w))

    def step(S, inp):
        r_t, w_t, k_t, v_t, kk_t, a_t = inp
        S = (S * w_t[:, :, None, :]
             + jnp.einsum('bhij,bhj->bhi', S, -kk_t)[..., None] * (kk_t * a_t)[:, :, None, :]
             + v_t[..., None] * k_t[:, :, None, :])
        return S, jnp.einsum('bhij,bhj->bhi', S, r_t)

    xs = tuple(jnp.moveaxis(t, 1, 0) for t in (r, w, k, v, kk, a))
    _, y = lax.scan(step, jnp.zeros((B, H, N, N), jnp.float32), xs)
    y = jnp.moveaxis(y, 0, 1)
    mu = jnp.mean(y, axis=-1, keepdims=True)
    var = jnp.mean(jnp.square(y - mu), axis=-1, keepdims=True)
    yn = ((y - mu) * lax.rsqrt(var + RWKV_GN_EPS)).reshape(B, T, RWKV_WIDTH) * ln_w + ln_b
    bonus = jnp.sum(r * k * r_k.astype(jnp.float32), axis=-1, keepdims=True) * v
    return yn + bonus.reshape(B, T, RWKV_WIDTH)


def rel_bucket(dist):
    n = jnp.maximum(dist, 0)
    max_exact = REL_BUCKETS // 2
    large = max_exact + (jnp.log(jnp.maximum(n, 1).astype(jnp.float32) / max_exact)
                         / math.log(REL_MAX_DIST / max_exact) * (REL_BUCKETS - max_exact)).astype(jnp.int32)
    large = jnp.minimum(large, REL_BUCKETS - 1)
    return jnp.where(n < max_exact, n, large)


def moba_branch(qkv, rel_bias):
    B, T, _ = qkv.shape
    H, Dh, BS, QC = MOBA_HEADS, MOBA_HEAD_DIM, MOBA_BLOCK, MOBA_QCHUNK
    t_pad = -(-T // BS) * BS

    def heads(t):
        t = t.astype(jnp.float32).reshape(B, T, H, Dh).transpose(0, 2, 1, 3)
        return jnp.pad(t, ((0, 0), (0, 0), (0, t_pad - T), (0, 0)))

    q, k, v = (heads(t) for t in jnp.split(qkv, 3, axis=-1))
    nb = t_pad // BS
    kb = k.reshape(B, H, nb, BS, Dh)
    vb = v.reshape(B, H, nb, BS, Dh)
    kmean = jnp.mean(kb, axis=3)
    gate = jnp.einsum('bhtd,bhnd->bhtn', q, kmean)
    qblk = jnp.arange(t_pad) // BS
    gate = jnp.where(jnp.arange(nb)[None, :] < qblk[:, None], gate, -jnp.inf)
    k_sel = min(MOBA_TOPK, nb)
    _, sel = lax.top_k(gate, k_sel)
    scale = Dh ** -0.5
    bi = jnp.arange(B)[:, None, None, None]
    hi = jnp.arange(H)[None, :, None, None]
    hi5 = jnp.arange(H)[None, :, None, None, None]
    rb = rel_bias.astype(jnp.float32)

    def chunk(c):
        start = c * QC
        qc = lax.dynamic_slice_in_dim(q, start, QC, axis=2)
        sc = lax.dynamic_slice_in_dim(sel, start, QC, axis=2)
        qpos = start + jnp.arange(QC)
        own = start // BS
        k_g = kb[bi, hi, sc]
        v_g = vb[bi, hi, sc]
        k_o = lax.dynamic_index_in_dim(kb, own, axis=2, keepdims=False)
        v_o = lax.dynamic_index_in_dim(vb, own, axis=2, keepdims=False)
        kpos_g = sc[..., None] * BS + jnp.arange(BS)
        kpos_o = own * BS + jnp.arange(BS)
        bias_g = rb[rel_bucket(qpos[:, None, None] - kpos_g), hi5]
        bias_o = jnp.transpose(rb[rel_bucket(qpos[:, None] - kpos_o[None, :])], (2, 0, 1))
        s_g = jnp.einsum('bhqd,bhqkjd->bhqkj', qc, k_g) * scale + bias_g
        s_o = jnp.einsum('bhqd,bhjd->bhqj', qc, k_o) * scale + bias_o
        ok_g = jnp.arange(k_sel)[None, :] < (qpos // BS)[:, None]
        ok_o = kpos_o[None, :] <= qpos[:, None]
        logits = jnp.concatenate(
            [jnp.where(ok_g[:, :, None], s_g, -jnp.inf).reshape(B, H, QC, k_sel * BS),
             jnp.where(ok_o, s_o, -jnp.inf)], axis=-1)
        p = jax.nn.softmax(logits, axis=-1)
        p_g = p[..., :k_sel * BS].reshape(B, H, QC, k_sel, BS)
        p_o = p[..., k_sel * BS:]
        return (jnp.einsum('bhqkj,bhqkjd->bhqd', p_g, v_g)
                + jnp.einsum('bhqj,bhjd->bhqd', p_o, v_o))

    out = lax.map(chunk, jnp.arange(t_pad // QC))
    out = out.transpose(1, 0, 3, 2, 4).reshape(B, t_pad, MOBA_WIDTH)
    return out[:, :T]


def setup_inputs(seed: int = 0) -> dict:
    key = jax.random.key(seed)
    ks = jax.random.split(key, 23)
    nrm = lambda k, shape: jax.random.normal(k, shape, jnp.float32)
    u = jax.random.uniform(ks[10], (DEPTH, LRU_WIDTH), jnp.float32, minval=0.9, maxval=0.999)
    a_base = u ** (1.0 / LRU_C)
    return {
        'x': nrm(ks[0], (BATCH, SEQ, D_MODEL)),
        'norm_w': 1.0 + 0.02 * nrm(ks[1], (DEPTH, D_MODEL)),
        'w_in': nrm(ks[2], (DEPTH, D_MODEL, IN_COLS)) * D_MODEL ** -0.5,
        'w_out': nrm(ks[3], (DEPTH, MIX_WIDTH, D_MODEL)) * MIX_WIDTH ** -0.5,
        'lru_conv_w': nrm(ks[4], (DEPTH, LRU_CONV, LRU_WIDTH)) * LRU_CONV ** -0.5,
        'lru_conv_b': 0.02 * nrm(ks[5], (DEPTH, LRU_WIDTH)),
        'lru_gate_a_w': nrm(ks[6], (DEPTH, LRU_BLOCKS, LRU_BLOCK_DIM, LRU_BLOCK_DIM)) * LRU_BLOCK_DIM ** -0.5,
        'lru_gate_a_b': 0.02 * nrm(ks[7], (DEPTH, LRU_WIDTH)),
        'lru_gate_x_w': nrm(ks[8], (DEPTH, LRU_BLOCKS, LRU_BLOCK_DIM, LRU_BLOCK_DIM)) * LRU_BLOCK_DIM ** -0.5,
        'lru_gate_x_b': 0.02 * nrm(ks[9], (DEPTH, LRU_WIDTH)),
        'lru_lambda': jnp.log(a_base) - jnp.log1p(-a_base),
        'rwkv_mix': jax.random.uniform(ks[11], (DEPTH, RWKV_STREAM), jnp.float32),
        'rwkv_w0': jax.random.uniform(ks[12], (DEPTH, RWKV_WIDTH), jnp.float32, minval=-6.0, maxval=1.0),
        'rwkv_w_up': 0.5 * nrm(ks[13], (DEPTH, RWKV_DECAY_LORA, RWKV_WIDTH)) * RWKV_DECAY_LORA ** -0.5,
        'rwkv_a0': 0.1 * nrm(ks[14], (DEPTH, RWKV_WIDTH)),
        'rwkv_a_up': 0.5 * nrm(ks[15], (DEPTH, RWKV_ICLR_LORA, RWKV_WIDTH)) * RWKV_ICLR_LORA ** -0.5,
        'rwkv_k_k': 0.85 + 0.05 * nrm(ks[16], (DEPTH, RWKV_WIDTH)),
        'rwkv_k_a': 1.0 + 0.05 * nrm(ks[17], (DEPTH, RWKV_WIDTH)),
        'rwkv_r_k': 0.1 * nrm(ks[18], (DEPTH, RWKV_HEADS, RWKV_HEAD_DIM)),
        'rwkv_ln_w': 1.0 + 0.02 * nrm(ks[19], (DEPTH, RWKV_WIDTH)),
        'rwkv_ln_b': 0.02 * nrm(ks[20], (DEPTH, RWKV_WIDTH)),
        'rel_bias': 0.1 * nrm(ks[21], (REL_BUCKETS, MOBA_HEADS)),
        'final_norm_w': 1.0 + 0.02 * nrm(ks[22], (D_MODEL,)),
    }


def reference(x, norm_w, w_in, w_out, lru_conv_w, lru_conv_b, lru_gate_a_w, lru_gate_a_b,
              lru_gate_x_w, lru_gate_x_b, lru_lambda, rwkv_mix, rwkv_w0, rwkv_w_up, rwkv_a0,
              rwkv_a_up, rwkv_k_k, rwkv_k_a, rwkv_r_k, rwkv_ln_w, rwkv_ln_b, rel_bias, final_norm_w):
    for l in range(DEPTH):
        h = rms_norm(x, norm_w[l])
        p = h @ w_in[l]
        xa, ga, sb, gb, qkv, gc = jnp.split(p, IN_OFFSETS, axis=-1)
        y_a = rg_lru_branch(xa, lru_conv_w[l], lru_conv_b[l], lru_gate_a_w[l], lru_gate_a_b[l],
                            lru_gate_x_w[l], lru_gate_x_b[l], lru_lambda[l]) * jax.nn.silu(ga.astype(jnp.float32))
        y_b = rwkv7_branch(sb, rwkv_mix[l], rwkv_w0[l], rwkv_w_up[l], rwkv_a0[l], rwkv_a_up[l],
                           rwkv_k_k[l], rwkv_k_a[l], rwkv_r_k[l], rwkv_ln_w[l],
                           rwkv_ln_b[l]) * jax.nn.silu(gb.astype(jnp.float32))
        y_c = moba_branch(qkv, rel_bias) * jax.nn.silu(gc.astype(jnp.float32))
        y = jnp.concatenate([y_a, y_b, y_c], axis=-1).astype(x.dtype)
        x = x + y @ w_out[l]
    return rms_norm(x, final_norm_w)
```

```cpp
#include <hip/hip_runtime.h>
#include <cstdio>
#include <cstdint>
#include <cstring>
#include <cmath>
namespace pg8 {
#define PG8_LAS __attribute__((address_space(3)))
typedef unsigned short bf16_t;
typedef short bf16x8 __attribute__((ext_vector_type(8)));
typedef float f32x4 __attribute__((ext_vector_type(4)));
typedef unsigned u32x4 __attribute__((ext_vector_type(4)));
constexpr int BM = 256, BK = 64, HALF = 128, HTB = HALF * BK * 2  , STAGE_BYTES = 8 * HTB, NXCD = 8, WGM = 8;

__host__ __device__ __forceinline__ int lds_byte(int r, int c) { const int st = (r >> 4) * 2 + (c >> 5), rr = r & 15, cc = c & 31, ob = rr * 64 + cc * 2; return st * 1024 + (ob ^ (((ob >> 9) & 1) << 5)); }
__host__ __device__ __forceinline__ void stage_rc(int b, int& R, int& C) { const int st = b / 1024, sb = b % 1024, swz = sb ^ (((sb >> 9) & 1) << 5); R = (st >> 1) * 16 + swz / 64; C = (st & 1) * 32 + (swz % 64) / 2; }
__host__ __device__ __forceinline__ int perm32(int rho) { const int n = rho >> 4, i = rho & 15; return 8 * (i >> 2) + 4 * n + (i & 3); }

struct Unit { int pm, pn; };
struct Gemm { const bf16_t* A; const bf16_t* Bt; int M, N, K; };

struct StaticOrder {
    int nM, nN, nwg, G, c;
    __host__ __device__ void init(int M, int N, int G_, int c_) { nM = M / BM; nN = N / BM; nwg = nM * nN; G = G_; c = c_; }
    __host__ __device__ bool next(int i, Unit& u) const {
        const long L = (long)i * G + c; if (L >= nwg) return false;
        int wgid = (int)L; { const int q = nwg / NXCD, r = nwg % NXCD, xcd = wgid % NXCD, off = wgid / NXCD; wgid = (xcd < r ? xcd * (q + 1) : r * (q + 1) + (xcd - r) * q) + off; }
        const int nig = WGM * nN, gid = wgid / nig, fm = gid * WGM, gsz = (nM - fm) < WGM ? (nM - fm) : WGM;
        u.pm = fm + ((wgid % nig) % gsz); u.pn = (wgid % nig) / gsz; return true;
    }
    __device__ __forceinline__ void a_ready(const Unit&) const {}
    __device__ __forceinline__ void done(const Unit&) const {}
};

__device__ __forceinline__ unsigned cvt_pk_bf16(float lo, float hi) { unsigned r; asm volatile("v_cvt_pk_bf16_f32 %0, %1, %2" : "=v"(r) : "v"(lo), "v"(hi)); return r; }
typedef float f32x2 __attribute__((ext_vector_type(2)));
__device__ __forceinline__ f32x2 gelu_pk(f32x2 v) {
    const f32x2 av = __builtin_elementwise_abs(v), d = av * 0.2316418882f + 1.0f;
    f32x2 t; t.x = __builtin_amdgcn_rcpf(d.x); t.y = __builtin_amdgcn_rcpf(d.y);
    f32x2 q = t * 0.5307027145f + (-0.7265760135f); q = q * t + 0.7107068705f; q = q * t + (-0.142248368f); q = q * t + 0.127414796f; q = q * t;
    const f32x2 s = (v * v) * (-0.72134752044f);
    f32x2 e; e.x = __builtin_amdgcn_exp2f(s.x); e.y = __builtin_amdgcn_exp2f(s.y);
    const f32x2 m = v * (q * e), r = v - m;
    f32x2 o; o.x = v.x < 0.f ? m.x : r.x; o.y = v.y < 0.f ? m.y : r.y; return o;
}

template <int ACT  > struct EpiBf16 {
    static constexpr bool PERM = true, AFTER_DRAIN = false; static_assert(ACT == 0 || ACT == 1, "EpiBf16: ACT is 0 (none) or 1 (gelu_pk)");
    bf16_t* O; int ldc; const float* bias; int split_cols; size_t split_stride; float scale0;
    __device__ __forceinline__ void operator()(const f32x4 (&acc)[2][2][4][2], const Unit& u, int wr, int wc, int fr, int fq) const {
        const int row0 = u.pm * BM + wr * 64 + fr; int colt = u.pn * BM; bf16_t* base = O;
        float sc = 1.f; if (split_cols) { const int t = colt / split_cols; base += (size_t)t * split_stride; colt -= t * split_cols; if (t == 0) sc = scale0; }
        const int col0 = colt + wc * 32 + 8 * fq, bcol0 = u.pn * BM + wc * 32 + 8 * fq;
        f32x4 bv[2][2];
#pragma unroll
        for (int bj = 0; bj < 2; ++bj)
#pragma unroll
            for (int n = 0; n < 2; ++n) bv[bj][n] = bias ? *(const f32x4*)(bias + bcol0 + bj * HALF + 4 * n) : (f32x4){0.f, 0.f, 0.f, 0.f};
#pragma unroll
        for (int ai = 0; ai < 2; ++ai)
#pragma unroll
            for (int m = 0; m < 4; ++m) { bf16_t* rowp = base + (size_t)(row0 + ai * HALF + m * 16) * ldc + col0;
#pragma unroll
                for (int bj = 0; bj < 2; ++bj) { f32x4 v0 = acc[ai][bj][m][0] + bv[bj][0], v1 = acc[ai][bj][m][1] + bv[bj][1];
                    if (ACT == 1) { f32x2 a = gelu_pk((f32x2){v0[0], v0[1]}), b = gelu_pk((f32x2){v0[2], v0[3]}), c = gelu_pk((f32x2){v1[0], v1[1]}), d = gelu_pk((f32x2){v1[2], v1[3]});
                        v0 = (f32x4){a.x, a.y, b.x, b.y}; v1 = (f32x4){c.x, c.y, d.x, d.y}; }
                    v0 = v0 * sc; v1 = v1 * sc; u32x4 w; w.x = cvt_pk_bf16(v0[0], v0[1]); w.y = cvt_pk_bf16(v0[2], v0[3]); w.z = cvt_pk_bf16(v1[0], v1[1]); w.w = cvt_pk_bf16(v1[2], v1[3]);
                    *(u32x4*)(rowp + bj * HALF) = w; } }
    }
};
template <class Epi, class Sched, bool ALIGN_EPI = false, bool SP2 = false>
__device__ __forceinline__ void gemm_phase(PG8_LAS unsigned char* lds, const Gemm g, const Sched& S, const Epi& E) {
    const int tid = threadIdx.x, wid = __builtin_amdgcn_readfirstlane(tid >> 6), lane = tid & 63, wr = wid >> 2, wc = wid & 3, fr = lane & 15, fq = lane >> 4;
    const int K = g.K, nt = K / BK;
    unsigned voffA[2], voffB[2];
#pragma unroll
    for (int i = 0; i < 2; ++i) { int R, C; stage_rc(tid * 16 + i * 8192, R, C); const int Rb = Epi::PERM ? ((R & ~31) + perm32(R & 31)) : R;
        voffA[i] = (unsigned)(R * K + C) * 2u; voffB[i] = (unsigned)(Rb * K + C) * 2u; }
    const size_t kstep = (size_t)(BK * 2);
    const size_t hstep = (size_t)HALF * K * 2;
    const size_t tstep = 2 * hstep;
    const unsigned ldsw = (unsigned)wid * 1024u;
    const int aoff = lds_byte(wr * 64 + fr, fq * 8), boff = lds_byte(wc * 32 + fr, fq * 8);
#define PG8_SA(b, h) (((b) * 2 + (h)) * HTB)
#define PG8_SB(b, h) ((4 + (b) * 2 + (h)) * HTB)
#define PG8_STAGE(bufoff, gbase, voff) do { _Pragma("unroll") for (int _i = 0; _i < 2; ++_i) \
        __builtin_amdgcn_global_load_lds((const unsigned*)((const char*)(gbase) + (voff)[_i]), (PG8_LAS unsigned*)(lds + (bufoff) + ldsw + _i * 8192), 16, 0, 0); } while (0)
#define PG8_LDA(dst, b, h) do { _Pragma("unroll") for (int m = 0; m < 4; ++m) _Pragma("unroll") for (int k = 0; k < 2; ++k) dst[m][k] = *(const PG8_LAS bf16x8*)(lds + PG8_SA(b, h) + aoff + m * 2048 + k * 1024); } while (0)
#define PG8_LDB(dst, b, h) do { _Pragma("unroll") for (int n = 0; n < 2; ++n) _Pragma("unroll") for (int k = 0; k < 2; ++k) dst[n][k] = *(const PG8_LAS bf16x8*)(lds + PG8_SB(b, h) + boff + n * 2048 + k * 1024); } while (0)
#define PG8_MMA(ai, bj, At, Bt) do { __builtin_amdgcn_s_setprio(1); _Pragma("unroll") for (int m = 0; m < 4; ++m) _Pragma("unroll") for (int n = 0; n < 2; ++n) _Pragma("unroll") for (int k = 0; k < 2; ++k) \
        acc[ai][bj][m][n] = __builtin_amdgcn_mfma_f32_16x16x32_bf16(Bt[n][k], At[m][k], acc[ai][bj][m][n], 0, 0, 0); __builtin_amdgcn_s_setprio(0); } while (0)
#define PG8_WAIT_V(n) asm volatile("s_waitcnt vmcnt(" #n ")" ::: "memory")
#define PG8_WAIT_L(n) asm volatile("s_waitcnt lgkmcnt(" #n ")" ::: "memory")
#define PG8_BAR __builtin_amdgcn_s_barrier()
#define PG8_SCHED __builtin_amdgcn_sched_barrier(0)
    Unit cur, nxt; int ui = 0;
    if (!S.next(0, cur)) return;
    f32x4 acc[2][2][4][2];
#pragma unroll
    for (int a = 0; a < 2; ++a)
#pragma unroll
        for (int b = 0; b < 2; ++b)
#pragma unroll
            for (int m = 0; m < 4; ++m)
#pragma unroll
                for (int n = 0; n < 2; ++n) acc[a][b][m][n] = (f32x4){0.f, 0.f, 0.f, 0.f};
    bf16x8 At[4][2], B0[2][2], B1[2][2];
    const char* cA = (const char*)g.A + (size_t)cur.pm * tstep; const char* cB = (const char*)g.Bt + (size_t)cur.pn * tstep;
    S.a_ready(cur);
    if constexpr (SP2) {
        PG8_STAGE(PG8_SB(0, 0), cB, voffB); PG8_STAGE(PG8_SB(0, 1), cB + hstep, voffB); PG8_STAGE(PG8_SA(0, 0), cA, voffA); PG8_STAGE(PG8_SA(0, 1), cA + hstep, voffA);
        if (wr == 1) PG8_BAR;
        PG8_WAIT_V(2); PG8_BAR;
        PG8_STAGE(PG8_SB(1, 0), cB + kstep, voffB); PG8_STAGE(PG8_SA(1, 0), cA + kstep, voffA); PG8_STAGE(PG8_SB(1, 1), cB + hstep + kstep, voffB);
        PG8_WAIT_V(6); PG8_BAR;
    } else {
        PG8_STAGE(PG8_SB(0, 0), cB, voffB); PG8_STAGE(PG8_SA(0, 0), cA, voffA); PG8_STAGE(PG8_SB(0, 1), cB + hstep, voffB); PG8_STAGE(PG8_SA(0, 1), cA + hstep, voffA);
        if (wr == 1) PG8_BAR;
        PG8_WAIT_V(4); PG8_BAR;
        PG8_STAGE(PG8_SB(1, 0), cB + kstep, voffB); PG8_STAGE(PG8_SA(1, 0), cA + kstep, voffA); PG8_STAGE(PG8_SB(1, 1), cB + hstep + kstep, voffB);
        PG8_WAIT_V(6); PG8_BAR;
    }
    for (;;) {
        const bool has_next = S.next(ui + 1, nxt);
        const char* nA = has_next ? (const char*)g.A + (size_t)nxt.pm * tstep : cA; const char* nB = has_next ? (const char*)g.Bt + (size_t)nxt.pn * tstep : cB;
        for (int t = 0; t < nt; t += 2) {
            const bool last = (t == nt - 2);
            const char* a1 = cA + (size_t)(t + 1) * kstep;
            const char* a2 = last ? nA : cA + (size_t)(t + 2) * kstep; const char* b2 = last ? nB : cB + (size_t)(t + 2) * kstep;
            const char* a3 = a2 + kstep; const char* b3 = b2 + kstep;
            if (last && has_next) S.a_ready(nxt);
            if constexpr (SP2) {
            PG8_LDB(B0, 0, 0); PG8_LDB(B1, 0, 1); PG8_SCHED; PG8_LDA(At, 0, 0); PG8_STAGE(PG8_SA(1, 1), a1 + hstep, voffA);
            PG8_WAIT_V(8); PG8_WAIT_L(0); PG8_BAR; PG8_MMA(0, 0, At, B0); PG8_MMA(0, 1, At, B1); PG8_BAR; PG8_SCHED;
            PG8_LDA(At, 0, 1); PG8_STAGE(PG8_SB(0, 0), b2, voffB); PG8_STAGE(PG8_SB(0, 1), b2 + hstep, voffB); PG8_STAGE(PG8_SA(0, 0), a2, voffA);
            PG8_WAIT_V(8); PG8_WAIT_L(0); PG8_BAR; PG8_MMA(1, 0, At, B0); PG8_MMA(1, 1, At, B1); PG8_BAR; PG8_SCHED;
            PG8_LDB(B0, 1, 0); PG8_LDB(B1, 1, 1); PG8_SCHED; PG8_LDA(At, 1, 0); PG8_STAGE(PG8_SA(0, 1), a2 + hstep, voffA);
            PG8_WAIT_V(8); PG8_WAIT_L(0); PG8_BAR; PG8_MMA(0, 0, At, B0); PG8_MMA(0, 1, At, B1); PG8_BAR; PG8_SCHED;
            PG8_LDA(At, 1, 1); PG8_STAGE(PG8_SB(1, 0), b3, voffB); PG8_STAGE(PG8_SB(1, 1), b3 + hstep, voffB); PG8_STAGE(PG8_SA(1, 0), a3, voffA);
            PG8_WAIT_V(8); PG8_WAIT_L(0); PG8_BAR; PG8_MMA(1, 0, At, B0); PG8_MMA(1, 1, At, B1); PG8_BAR; PG8_SCHED;
            } else {
            PG8_LDB(B0, 0, 0); PG8_SCHED; PG8_LDA(At, 0, 0); PG8_STAGE(PG8_SA(1, 1), a1 + hstep, voffA);
            PG8_WAIT_L(8); PG8_BAR; PG8_WAIT_L(0); PG8_MMA(0, 0, At, B0); PG8_BAR; PG8_SCHED;
            PG8_LDB(B1, 0, 1); PG8_STAGE(PG8_SB(0, 0), b2, voffB);
            PG8_BAR; PG8_WAIT_L(0); PG8_MMA(0, 1, At, B1); PG8_BAR;
            PG8_LDA(At, 0, 1); PG8_STAGE(PG8_SA(0, 0), a2, voffA);
            PG8_BAR; PG8_WAIT_L(0); PG8_MMA(1, 0, At, B0); PG8_BAR; PG8_SCHED;
            PG8_STAGE(PG8_SB(0, 1), b2 + hstep, voffB);
            PG8_WAIT_V(6); PG8_BAR; PG8_MMA(1, 1, At, B1); PG8_BAR;
            PG8_LDB(B0, 1, 0); PG8_SCHED; PG8_LDA(At, 1, 0); PG8_STAGE(PG8_SA(0, 1), a2 + hstep, voffA);
            PG8_WAIT_L(8); PG8_BAR; PG8_WAIT_L(0); PG8_MMA(0, 0, At, B0); PG8_BAR; PG8_SCHED;
            PG8_LDB(B1, 1, 1); PG8_STAGE(PG8_SB(1, 0), b3, voffB);
            PG8_BAR; PG8_WAIT_L(0); PG8_MMA(0, 1, At, B1); PG8_BAR;
            PG8_LDA(At, 1, 1); PG8_STAGE(PG8_SA(1, 0), a3, voffA);
            PG8_BAR; PG8_WAIT_L(0); PG8_MMA(1, 0, At, B0); PG8_BAR; PG8_SCHED;
            PG8_STAGE(PG8_SB(1, 1), b3 + hstep, voffB);
            PG8_WAIT_V(6); PG8_BAR; PG8_MMA(1, 1, At, B1); PG8_BAR;
            }
        }
        if constexpr (ALIGN_EPI) { if (wr == 0) PG8_BAR; }
        if constexpr (!Epi::AFTER_DRAIN) { E(acc, cur, wr, wc, fr, fq); S.done(cur); }
        if (!has_next) break;
#pragma unroll
        for (int a = 0; a < 2; ++a)
#pragma unroll
            for (int b = 0; b < 2; ++b)
#pragma unroll
                for (int m = 0; m < 4; ++m)
#pragma unroll
                    for (int n = 0; n < 2; ++n) acc[a][b][m][n] = (f32x4){0.f, 0.f, 0.f, 0.f};
        cur = nxt; cA = nA; cB = nB; ++ui;
        if constexpr (ALIGN_EPI) { if (wr == 1) PG8_BAR; }
    }
    PG8_WAIT_V(0);
    if constexpr (!ALIGN_EPI) { if (wr == 0) PG8_BAR; }
    PG8_BAR;
    if constexpr (Epi::AFTER_DRAIN) { E.fused(acc, cur, wr, wc, fr, fq, lds, wid, lane); S.done(cur); }
#undef PG8_SA
#undef PG8_SB
#undef PG8_STAGE
#undef PG8_LDA
#undef PG8_LDB
#undef PG8_MMA
#undef PG8_WAIT_V
#undef PG8_WAIT_L
#undef PG8_BAR
#undef PG8_SCHED
}
}

constexpr int DM = 2048, NB = 2, SEQ = 4096, MROWS = NB * SEQ, DEPTH = 4;
constexpr int LRU_W = 512, RW = 768, MOW = 768, NIN = 7296, NINP = 7424;
constexpr int OFF_XA = 0, OFF_GA = 512, OFF_SB = 1024, OFF_GB = 3456, OFF_QKV = 4224, OFF_GC = 6528;
constexpr int RSTREAM = 2432;
constexpr int NH = 12, HD = 64, NBLK = 16, BLK = 256;

typedef unsigned short bf16;
typedef float f32x4 __attribute__((ext_vector_type(4)));
typedef unsigned u32x4 __attribute__((ext_vector_type(4)));
typedef unsigned u32x2 __attribute__((ext_vector_type(2)));

__device__ __forceinline__ unsigned f2bf(float f) { unsigned u = __builtin_bit_cast(unsigned, f); return (u + 0x7fffu + ((u >> 16) & 1u)) >> 16; }
__device__ __forceinline__ unsigned pk2(float lo, float hi) { return f2bf(lo) | (f2bf(hi) << 16); }
__device__ __forceinline__ float bf2f(unsigned short b) { return __builtin_bit_cast(float, (unsigned)b << 16); }
__device__ __forceinline__ float bflo(unsigned w) { return __builtin_bit_cast(float, w << 16); }
__device__ __forceinline__ float bfhi(unsigned w) { return __builtin_bit_cast(float, w & 0xffff0000u); }
__device__ __forceinline__ float sigmoidf_(float x) { return 1.f / (1.f + __expf(-x)); }
__device__ __forceinline__ float siluf_(float x) { return x / (1.f + __expf(-x)); }
__device__ __forceinline__ float wave_sum(float v) {
#pragma unroll
    for (int o = 1; o < 64; o <<= 1) v += __shfl_xor(v, o);
    return v;
}

__device__ __forceinline__ void transpose_item(const float* W, int K, int N, bf16* WT, float* scr, int item, int lane) {
    const int nblk = N / 32, kb = item / nblk, nb = item % nblk, k0 = 64 * kb, n0 = 32 * nb;
#pragma unroll 8
    for (int i = 0; i < 32; ++i) { const int kk = 2 * i + (lane >> 5); scr[kk * 33 + (lane & 31)] = W[(size_t)(k0 + kk) * N + n0 + (lane & 31)]; }
    __builtin_amdgcn_s_waitcnt(0xc07f); __builtin_amdgcn_wave_barrier();
    const int c = lane & 7;
#pragma unroll
    for (int j = 0; j < 4; ++j) { const int n = (lane >> 3) + 8 * j; const float* s = scr + (8 * c) * 33 + n;
        u32x4 o; o.x = pk2(s[0 * 33], s[1 * 33]); o.y = pk2(s[2 * 33], s[3 * 33]); o.z = pk2(s[4 * 33], s[5 * 33]); o.w = pk2(s[6 * 33], s[7 * 33]);
        *(u32x4*)(WT + (size_t)(n0 + n) * K + k0 + 8 * c) = o; }
    __builtin_amdgcn_s_waitcnt(0xc07f); __builtin_amdgcn_wave_barrier();
}
__global__ void __launch_bounds__(256) prep_weights_kernel(const float* w_in, const float* w_out, bf16* WinT, bf16* WoutT) {
    __shared__ float scr_all[4 * 64 * 33];
    const int lane = threadIdx.x & 63, wave = threadIdx.x >> 6;
    float* scr = scr_all + wave * 64 * 33;
    const int gw = blockIdx.x * 4 + wave, NGW = gridDim.x * 4;
    constexpr int I_IN = (DM / 64) * (NIN / 32), I_OUT = (DM / 64) * (DM / 32);
    constexpr int NITEMS = DEPTH * (I_IN + I_OUT);
    for (int it = gw; it < NITEMS; it += NGW) {
        if (it < DEPTH * I_IN) { const int l = it / I_IN, r = it % I_IN; transpose_item(w_in + (size_t)l * DM * NIN, DM, NIN, WinT + (size_t)l * NINP * DM, scr, r, lane); }
        else { const int r0 = it - DEPTH * I_IN, l = r0 / I_OUT, r = r0 % I_OUT; transpose_item(w_out + (size_t)l * DM * DM, DM, DM, WoutT + (size_t)l * DM * DM, scr, r, lane); }
    }
    const int gt = blockIdx.x * 256 + threadIdx.x, NGT = gridDim.x * 256;
    constexpr int PADV = (NINP - NIN) * DM / 8;
    for (int i = gt; i < DEPTH * PADV; i += NGT) { const int l = i / PADV, r = i % PADV; *(u32x4*)(WinT + (size_t)l * NINP * DM + (size_t)NIN * DM + (size_t)r * 8) = (u32x4){0u, 0u, 0u, 0u}; }
}

template <bool FINAL> __global__ void __launch_bounds__(256) rmsnorm_kernel(const float* x, const float* w, bf16* hb, float* outf) {
    const int lane = threadIdx.x & 63, wave = threadIdx.x >> 6;
    const int row = blockIdx.x * 4 + wave;
    const f32x4* xr = (const f32x4*)(x + (size_t)row * DM) + lane;
    f32x4 v[8]; float s = 0.f;
#pragma unroll
    for (int j = 0; j < 8; ++j) { v[j] = xr[64 * j]; s += (v[j].x * v[j].x + v[j].y * v[j].y) + (v[j].z * v[j].z + v[j].w * v[j].w); }
    const float rstd = rsqrtf(wave_sum(s) * (1.f / DM) + 1e-6f);
    const f32x4* wr = (const f32x4*)w + lane;
#pragma unroll
    for (int j = 0; j < 8; ++j) { const f32x4 ww = wr[64 * j]; const f32x4 o = v[j] * rstd * ww;
        if (FINAL) { ((f32x4*)(outf + (size_t)row * DM) + lane)[64 * j] = o; }
        else { u32x2 pk; pk.x = pk2(o.x, o.y); pk.y = pk2(o.z, o.w); ((u32x2*)(hb + (size_t)row * DM) + lane)[64 * j] = pk; } }
}

struct EpiRes {
    static constexpr bool PERM = false, AFTER_DRAIN = false;
    const float* base; float* out; int ldc;
    __device__ __forceinline__ void operator()(const pg8::f32x4 (&acc)[2][2][4][2], const pg8::Unit& u, int wr, int wc, int fr, int fq) const {
        const int row0 = u.pm * 256 + wr * 64 + fr, col0 = u.pn * 256 + wc * 32 + 4 * fq;
#pragma unroll
        for (int ai = 0; ai < 2; ++ai)
#pragma unroll
            for (int m = 0; m < 4; ++m) { const size_t off = (size_t)(row0 + ai * 128 + m * 16) * ldc + col0;
#pragma unroll
                for (int bj = 0; bj < 2; ++bj)
#pragma unroll
                    for (int n = 0; n < 2; ++n) { const pg8::f32x4 bs = *(const pg8::f32x4*)(base + off + bj * 128 + n * 16); *(pg8::f32x4*)(out + off + bj * 128 + n * 16) = bs + acc[ai][bj][m][n]; } }
    }
};
struct GArgs { const bf16* A; const bf16* Bt; const float* base; void* out; int M, N, K, ldc; };
template <int MODE> __global__ void __launch_bounds__(512, 2) gemm_kernel(GArgs a) {
    extern __shared__ __attribute__((aligned(16))) unsigned char lds[];
    pg8::Gemm g{a.A, a.Bt, a.M, a.N, a.K};
    pg8::StaticOrder S; S.init(g.M, g.N, (int)gridDim.x, (int)blockIdx.x);
    if constexpr (MODE == 0) { pg8::EpiBf16<0> E{(bf16*)a.out, a.ldc, nullptr, 0, 0, 1.f}; pg8::gemm_phase<pg8::EpiBf16<0>, pg8::StaticOrder, true, true>((PG8_LAS unsigned char*)lds, g, S, E); }
    else { EpiRes E{a.base, (float*)a.out, a.ldc}; pg8::gemm_phase<EpiRes, pg8::StaticOrder, true, true>((PG8_LAS unsigned char*)lds, g, S, E); }
}

struct LruP { const float *conv_w, *conv_b, *ga_w, *ga_b, *gx_w, *gx_b, *lam; };
__global__ void __launch_bounds__(256) lru_kernel(const bf16* p, LruP P, bf16* ybuf) {
    __shared__ float sWa[64 * 64], sWx[64 * 64], sXc[64 * 64], sA[64 * 64];
    float* sB = sXc;
    const int b = blockIdx.x >> 3, g = blockIdx.x & 7, tid = threadIdx.x, c = tid & 63, tq = tid >> 6;
    for (int i = tid; i < 4096; i += 256) { sWa[i] = P.ga_w[g * 4096 + i]; sWx[i] = P.gx_w[g * 4096 + i]; }
    const int ch = g * 64 + c;
    const float cw0 = P.conv_w[0 * LRU_W + ch], cw1 = P.conv_w[1 * LRU_W + ch], cw2 = P.conv_w[2 * LRU_W + ch], cw3 = P.conv_w[3 * LRU_W + ch], cb = P.conv_b[ch];
    const float gab = P.ga_b[ch], gxb = P.gx_b[ch];
    const float sp = log1pf(__expf(-P.lam[ch]));
    float hcarry = 0.f;
    __syncthreads();
    for (int t0 = 0; t0 < SEQ; t0 += 64) {
#pragma unroll 4
        for (int i = 0; i < 16; ++i) { const int tt = tq + 4 * i, t = t0 + tt; const bf16* pr = p + (size_t)(b * SEQ + t) * NINP + OFF_XA + ch;
            float x0 = bf2f(pr[0]);
            float x1 = t >= 1 ? bf2f(*(pr - NINP)) : 0.f, x2 = t >= 2 ? bf2f(*(pr - 2 * NINP)) : 0.f, x3 = t >= 3 ? bf2f(*(pr - 3 * NINP)) : 0.f;
            sXc[tt * 64 + c] = cw3 * x0 + cw2 * x1 + cw1 * x2 + cw0 * x3 + cb; }
        __syncthreads();
#pragma unroll 2
        for (int i = 0; i < 16; ++i) { const int tt = tq + 4 * i; float ra = gab, ia = gxb;
#pragma unroll 16
            for (int k = 0; k < 64; ++k) { const float xv = sXc[tt * 64 + k]; ra += xv * sWa[k * 64 + c]; ia += xv * sWx[k * 64 + c]; }
            const float r = sigmoidf_(ra), ig = sigmoidf_(ia);
            const float log_a = -8.f * r * sp; const float a = __expf(log_a);
            const float bb = sqrtf(-expm1f(2.f * log_a)) * (ig * sXc[tt * 64 + c]);
            sA[tt * 64 + c] = a; sB[tt * 64 + c] = bb; }
        __syncthreads();
        if (tid < 64) { float h = hcarry;
#pragma unroll 8
            for (int tt = 0; tt < 64; ++tt) { h = sA[tt * 64 + c] * h + sB[tt * 64 + c]; sB[tt * 64 + c] = h; }
            hcarry = h; }
        __syncthreads();
#pragma unroll 4
        for (int i = 0; i < 16; ++i) { const int tt = tq + 4 * i, t = t0 + tt; const size_t row = (size_t)(b * SEQ + t);
            const float ga = bf2f(p[row * NINP + OFF_GA + ch]);
            ybuf[row * DM + ch] = (bf16)f2bf(sB[tt * 64 + c] * siluf_(ga)); }
        __syncthreads();
    }
}

struct RwkvP { const float *mix, *w0, *w_up, *a0, *a_up, *k_k, *k_a, *r_k, *ln_w, *ln_b; };
__global__ void __launch_bounds__(256) rwkv_prep_kernel(const bf16* p, RwkvP P, float* Wd, float* KK, float* BE, float* KM, float* RR, float* VV) {
    __shared__ float s_wd[64], s_ad[64];
    const int row = blockIdx.x, t = row & (SEQ - 1), tid = threadIdx.x, lane = tid & 63;
    const bf16* cur = p + (size_t)row * NINP + OFF_SB; const bf16* prv = cur - NINP;
    if (tid < 128) { const int cidx = 2304 + tid; const float c0 = bf2f(cur[cidx]), p0 = t > 0 ? bf2f(prv[cidx]) : 0.f; const float s = c0 + P.mix[cidx] * (p0 - c0);
        if (tid < 64) s_wd[tid] = tanhf(s); else s_ad[tid - 64] = s; }
    __syncthreads();
#pragma unroll
    for (int i = 0; i < 3; ++i) { const int c = tid + 256 * i;
        float sv[3];
#pragma unroll
        for (int q = 0; q < 3; ++q) { const int cidx = q * RW + c; const float c0 = bf2f(cur[cidx]), p0 = t > 0 ? bf2f(prv[cidx]) : 0.f; sv[q] = c0 + P.mix[cidx] * (p0 - c0); }
        const float r = sv[0], k = sv[1], v = sv[2];
        float lw = P.w0[c], la = P.a0[c];
#pragma unroll 16
        for (int j = 0; j < 64; ++j) { lw += s_wd[j] * P.w_up[j * RW + c]; la += s_ad[j] * P.a_up[j * RW + c]; }
        const float w = __expf(-0.6065306597126334f * sigmoidf_(lw));
        const float a = sigmoidf_(la);
        float kk = k * P.k_k[c];
        const float nrm = fmaxf(sqrtf(wave_sum(kk * kk)), 1e-12f);
        kk = kk / nrm;
        const float km = k * (1.f + (a - 1.f) * P.k_a[c]);
        const size_t o = (size_t)row * RW + c;
        Wd[o] = w; KK[o] = kk; BE[o] = kk * a; KM[o] = km; RR[o] = r; VV[o] = v; }
}
__global__ void __launch_bounds__(512) rwkv_scan_kernel(const float* __restrict__ Wd, const float* __restrict__ KK, const float* __restrict__ BE, const float* __restrict__ KM, const float* __restrict__ RR, const float* __restrict__ VV, float* __restrict__ Yraw) {
    const int bh = blockIdx.x >> 2, q = blockIdx.x & 3, b = bh / NH, h = bh % NH;
    const int tid = threadIdx.x, lane = tid & 63, wave = tid >> 6;
    const int rowsel = (lane >> 4) & 1, jg = (lane & 15) | ((lane >> 5) << 4);
    const int i = 16 * q + 2 * wave + rowsel;
    const size_t base = (size_t)(b * SEQ) * RW + h * HD;
    float s0 = 0.f, s1 = 0.f;
#pragma unroll 4
    for (int t = 0; t < SEQ; ++t) { const size_t o = base + (size_t)t * RW;
        const float2 w = *(const float2*)(Wd + o + 2 * jg), kk = *(const float2*)(KK + o + 2 * jg), be = *(const float2*)(BE + o + 2 * jg), km = *(const float2*)(KM + o + 2 * jg), r = *(const float2*)(RR + o + 2 * jg);
        const float v = VV[o + i];
        float u = s0 * kk.x + s1 * kk.y;
        u += __shfl_xor(u, 1); u += __shfl_xor(u, 2); u += __shfl_xor(u, 4); u += __shfl_xor(u, 8); u += __shfl_xor(u, 32);
        s0 = s0 * w.x - u * be.x + v * km.x; s1 = s1 * w.y - u * be.y + v * km.y;
        float y = s0 * r.x + s1 * r.y;
        y += __shfl_xor(y, 1); y += __shfl_xor(y, 2); y += __shfl_xor(y, 4); y += __shfl_xor(y, 8); y += __shfl_xor(y, 32);
        if (jg == 0) Yraw[o + i] = y; }
}
__global__ void __launch_bounds__(256) rwkv_post_kernel(const bf16* p, RwkvP P, const float* Yraw, const float* KM, const float* RR, const float* VV, bf16* ybuf) {
    const int lane = threadIdx.x & 63, wave = threadIdx.x >> 6;
    const int item = blockIdx.x * 4 + wave, row = item / NH, h = item % NH, c = h * HD + lane;
    const size_t o = (size_t)row * RW + c;
    const float y = Yraw[o];
    const float mu = wave_sum(y) * (1.f / 64.f); const float d = y - mu; const float var = wave_sum(d * d) * (1.f / 64.f);
    const float yn = d * rsqrtf(var + 64e-5f) * P.ln_w[c] + P.ln_b[c];
    const float bonus = wave_sum(RR[o] * KM[o] * P.r_k[c]) * VV[o];
    const float gb = bf2f(p[(size_t)row * NINP + OFF_GB + c]);
    ybuf[(size_t)row * DM + LRU_W + c] = (bf16)f2bf((yn + bonus) * siluf_(gb));
}

__global__ void __launch_bounds__(64) moba_kmean_kernel(const bf16* p, float* kmean) {
    const int n = blockIdx.x % NBLK, bh = blockIdx.x / NBLK, b = bh / NH, h = bh % NH, d = threadIdx.x;
    const bf16* kp = p + (size_t)(b * SEQ + n * BLK) * NINP + OFF_QKV + MOW + h * HD + d;
    float s = 0.f;
    for (int j = 0; j < BLK; ++j) s += bf2f(kp[(size_t)j * NINP]);
    kmean[((size_t)bh * NBLK + n) * HD + d] = s * (1.f / BLK);
}
__device__ __forceinline__ int rel_bucket_dev(int n) {
    if (n < 16) return n;
    int large = 16 + (int)(logf((float)n / 16.f) / 2.0794415416798357f * 16.f);
    return large < 31 ? large : 31;
}
__global__ void __launch_bounds__(256) moba_attn_kernel(const bf16* p, const float* kmean, const float* rel_bias, bf16* ybuf) {
    __shared__ float s_bias[128];
    const int qb = blockIdx.x % NBLK, bh = blockIdx.x / NBLK, b = bh / NH, h = bh % NH, tid = threadIdx.x;
    if (tid < 128) s_bias[tid] = rel_bias[rel_bucket_dev(tid) * NH + h];
    __syncthreads();
    const int t = qb * BLK + tid; const size_t row = (size_t)(b * SEQ + t);
    float q[64];
    { const u32x4* qp = (const u32x4*)(p + row * NINP + OFF_QKV + h * HD);
#pragma unroll
      for (int i = 0; i < 8; ++i) { const u32x4 w = qp[i]; q[8 * i + 0] = bflo(w.x); q[8 * i + 1] = bfhi(w.x); q[8 * i + 2] = bflo(w.y); q[8 * i + 3] = bfhi(w.y); q[8 * i + 4] = bflo(w.z); q[8 * i + 5] = bfhi(w.z); q[8 * i + 6] = bflo(w.w); q[8 * i + 7] = bfhi(w.w); } }
    int sel0 = -1, sel1 = -1, sel2 = -1; float g0 = -INFINITY, g1 = -INFINITY, g2 = -INFINITY;
    for (int n = 0; n < qb; ++n) { const float* km = kmean + ((size_t)bh * NBLK + n) * HD; float g = 0.f;
#pragma unroll
        for (int d = 0; d < 64; ++d) g += q[d] * km[d];
        if (g > g0) { g2 = g1; sel2 = sel1; g1 = g0; sel1 = sel0; g0 = g; sel0 = n; }
        else if (g > g1) { g2 = g1; sel2 = sel1; g1 = g; sel1 = n; }
        else if (g > g2) { g2 = g; sel2 = n; } }
    float o[64];
#pragma unroll
    for (int d = 0; d < 64; ++d) o[d] = 0.f;
    float mrun = -INFINITY, lrun = 0.f;
    for (int pass = 0; pass < 4; ++pass) {
        const int blk = pass == 0 ? sel0 : pass == 1 ? sel1 : pass == 2 ? sel2 : qb;
        if (blk < 0) continue;
        const int nk = pass == 3 ? tid + 1 : BLK;
        for (int j = 0; j < nk; ++j) { const int kpos = blk * BLK + j; const size_t krow = (size_t)(b * SEQ + kpos);
            const u32x4* kp = (const u32x4*)(p + krow * NINP + OFF_QKV + MOW + h * HD);
            float s = 0.f;
#pragma unroll
            for (int i = 0; i < 8; ++i) { const u32x4 w = kp[i]; s += q[8 * i + 0] * bflo(w.x) + q[8 * i + 1] * bfhi(w.x) + q[8 * i + 2] * bflo(w.y) + q[8 * i + 3] * bfhi(w.y) + q[8 * i + 4] * bflo(w.z) + q[8 * i + 5] * bfhi(w.z) + q[8 * i + 6] * bflo(w.w) + q[8 * i + 7] * bfhi(w.w); }
            const int dist = t - kpos; s = s * 0.125f + s_bias[dist < 127 ? dist : 127];
            const float mn = fmaxf(mrun, s); const float corr = __expf(mrun - mn), pe = __expf(s - mn);
            lrun = lrun * corr + pe; mrun = mn;
            const u32x4* vp = (const u32x4*)(p + krow * NINP + OFF_QKV + 2 * MOW + h * HD);
#pragma unroll
            for (int i = 0; i < 8; ++i) { const u32x4 w = vp[i];
                o[8 * i + 0] = o[8 * i + 0] * corr + pe * bflo(w.x); o[8 * i + 1] = o[8 * i + 1] * corr + pe * bfhi(w.x); o[8 * i + 2] = o[8 * i + 2] * corr + pe * bflo(w.y); o[8 * i + 3] = o[8 * i + 3] * corr + pe * bfhi(w.y);
                o[8 * i + 4] = o[8 * i + 4] * corr + pe * bflo(w.z); o[8 * i + 5] = o[8 * i + 5] * corr + pe * bfhi(w.z); o[8 * i + 6] = o[8 * i + 6] * corr + pe * bflo(w.w); o[8 * i + 7] = o[8 * i + 7] * corr + pe * bfhi(w.w); } }
    }
    const float inv = 1.f / lrun;
    const u32x4* gp = (const u32x4*)(p + row * NINP + OFF_GC + h * HD);
    u32x4* yo = (u32x4*)(ybuf + row * DM + LRU_W + RW + h * HD);
#pragma unroll
    for (int i = 0; i < 8; ++i) { const u32x4 w = gp[i]; u32x4 r;
        r.x = pk2(o[8 * i + 0] * inv * siluf_(bflo(w.x)), o[8 * i + 1] * inv * siluf_(bfhi(w.x))); r.y = pk2(o[8 * i + 2] * inv * siluf_(bflo(w.y)), o[8 * i + 3] * inv * siluf_(bfhi(w.y)));
        r.z = pk2(o[8 * i + 4] * inv * siluf_(bflo(w.z)), o[8 * i + 5] * inv * siluf_(bfhi(w.z))); r.w = pk2(o[8 * i + 6] * inv * siluf_(bflo(w.w)), o[8 * i + 7] * inv * siluf_(bfhi(w.w)));
        yo[i] = r; }
}

constexpr size_t MiB = 1u << 20;
constexpr size_t WS_WINT = 1 * MiB;
constexpr size_t WS_WOUTT = WS_WINT + (size_t)DEPTH * NINP * DM * 2;
constexpr size_t WS_X = WS_WOUTT + (size_t)DEPTH * DM * DM * 2;
constexpr size_t WS_H = WS_X + (size_t)MROWS * DM * 4;
constexpr size_t WS_P = WS_H + (size_t)MROWS * DM * 2;
constexpr size_t WS_Y = WS_P + (size_t)MROWS * NINP * 2;
constexpr size_t WS_RW = WS_Y + (size_t)MROWS * DM * 2;
constexpr size_t RW_ARR = (size_t)MROWS * RW * 4;
constexpr size_t WS_KMEAN = WS_RW + 7 * RW_ARR;
constexpr size_t WS_END = WS_KMEAN + 1 * MiB;

extern "C" void kernel_launch(void* const* d_in, const int* in_sizes, int n_in, void* d_out, int out_size, void* d_ws, size_t ws_size, hipStream_t stream) {
    static int inited = 0;
    if (!inited) {
        if (ws_size < WS_END) { fprintf(stderr, "kernel_launch: workspace too small: %zu < %zu\n", ws_size, (size_t)WS_END); return; }
        (void)hipFuncSetAttribute((const void*)gemm_kernel<0>, hipFuncAttributeMaxDynamicSharedMemorySize, pg8::STAGE_BYTES);
        (void)hipFuncSetAttribute((const void*)gemm_kernel<1>, hipFuncAttributeMaxDynamicSharedMemorySize, pg8::STAGE_BYTES);
        inited = 1;
    }
    const float* x_in = (const float*)d_in[0]; const float* norm_w = (const float*)d_in[1]; const float* w_in = (const float*)d_in[2]; const float* w_out = (const float*)d_in[3];
    unsigned char* ws = (unsigned char*)d_ws;
    bf16* WinT = (bf16*)(ws + WS_WINT); bf16* WoutT = (bf16*)(ws + WS_WOUTT); float* X = (float*)(ws + WS_X); bf16* H = (bf16*)(ws + WS_H); bf16* Pb = (bf16*)(ws + WS_P); bf16* Y = (bf16*)(ws + WS_Y);
    float* RWA[7]; for (int i = 0; i < 7; ++i) RWA[i] = (float*)(ws + WS_RW + i * RW_ARR);
    float* kmean = (float*)(ws + WS_KMEAN);
    prep_weights_kernel<<<1024, 256, 0, stream>>>(w_in, w_out, WinT, WoutT);
    for (int l = 0; l < DEPTH; ++l) {
        const float* xcur = l == 0 ? x_in : X;
        rmsnorm_kernel<false><<<MROWS / 4, 256, 0, stream>>>(xcur, norm_w + (size_t)l * DM, H, nullptr);
        { GArgs g; memset(&g, 0, sizeof(g)); g.A = H; g.Bt = WinT + (size_t)l * NINP * DM; g.base = nullptr; g.out = Pb; g.M = MROWS; g.N = NINP; g.K = DM; g.ldc = NINP;
          gemm_kernel<0><<<256, 512, pg8::STAGE_BYTES, stream>>>(g); }
        { LruP P{(const float*)d_in[4] + (size_t)l * 4 * LRU_W, (const float*)d_in[5] + (size_t)l * LRU_W, (const float*)d_in[6] + (size_t)l * 8 * 4096, (const float*)d_in[7] + (size_t)l * LRU_W,
                 (const float*)d_in[8] + (size_t)l * 8 * 4096, (const float*)d_in[9] + (size_t)l * LRU_W, (const float*)d_in[10] + (size_t)l * LRU_W};
          lru_kernel<<<16, 256, 0, stream>>>(Pb, P, Y); }
        { RwkvP P{(const float*)d_in[11] + (size_t)l * RSTREAM, (const float*)d_in[12] + (size_t)l * RW, (const float*)d_in[13] + (size_t)l * 64 * RW, (const float*)d_in[14] + (size_t)l * RW,
                  (const float*)d_in[15] + (size_t)l * 64 * RW, (const float*)d_in[16] + (size_t)l * RW, (const float*)d_in[17] + (size_t)l * RW, (const float*)d_in[18] + (size_t)l * RW,
                  (const float*)d_in[19] + (size_t)l * RW, (const float*)d_in[20] + (size_t)l * RW};
          rwkv_prep_kernel<<<MROWS, 256, 0, stream>>>(Pb, P, RWA[0], RWA[1], RWA[2], RWA[3], RWA[4], RWA[5]);
          rwkv_scan_kernel<<<NB * NH * 4, 512, 0, stream>>>(RWA[0], RWA[1], RWA[2], RWA[3], RWA[4], RWA[5], RWA[6]);
          rwkv_post_kernel<<<MROWS * NH / 4, 256, 0, stream>>>(Pb, P, RWA[6], RWA[3], RWA[4], RWA[5], Y); }
        moba_kmean_kernel<<<NB * NH * NBLK, 64, 0, stream>>>(Pb, kmean);
        moba_attn_kernel<<<NB * NH * NBLK, 256, 0, stream>>>(Pb, kmean, (const float*)d_in[21], Y);
        { GArgs g; memset(&g, 0, sizeof(g)); g.A = Y; g.Bt = WoutT + (size_t)l * DM * DM; g.base = xcur; g.out = X; g.M = MROWS; g.N = DM; g.K = DM; g.ldc = DM;
          gemm_kernel<1><<<256, 512, pg8::STAGE_BYTES, stream>>>(g); }
    }
    rmsnorm_kernel<true><<<MROWS / 4, 256, 0, stream>>>(X, (const float*)d_in[22], nullptr, (float*)d_out);
}
```

```cpp
#include <hip/hip_runtime.h>
#include <hip/hip_cooperative_groups.h>
#include <hip/hip_bf16.h>
#include <cstdio>
#include <cstdint>
#include <cstring>
#include <cmath>
namespace pg8 {
#define PG8_LAS __attribute__((address_space(3)))
typedef unsigned short bf16_t;
typedef short bf16x8 __attribute__((ext_vector_type(8)));
typedef float f32x4 __attribute__((ext_vector_type(4)));
typedef unsigned u32x4 __attribute__((ext_vector_type(4)));
constexpr int BM = 256, BK = 64, HALF = 128, HTB = HALF * BK * 2  , STAGE_BYTES = 8 * HTB, NXCD = 8, WGM = 8;

__host__ __device__ __forceinline__ int lds_byte(int r, int c) { const int st = (r >> 4) * 2 + (c >> 5), rr = r & 15, cc = c & 31, ob = rr * 64 + cc * 2; return st * 1024 + (ob ^ (((ob >> 9) & 1) << 5)); }
__host__ __device__ __forceinline__ void stage_rc(int b, int& R, int& C) { const int st = b / 1024, sb = b % 1024, swz = sb ^ (((sb >> 9) & 1) << 5); R = (st >> 1) * 16 + swz / 64; C = (st & 1) * 32 + (swz % 64) / 2; }
__host__ __device__ __forceinline__ int perm32(int rho) { const int n = rho >> 4, i = rho & 15; return 8 * (i >> 2) + 4 * n + (i & 3); }

struct Unit { int pm, pn; };
struct Gemm { const bf16_t* A; const bf16_t* Bt; int M, N, K; };

struct StaticOrder {
    int nM, nN, nwg, G, c;
    __host__ __device__ void init(int M, int N, int G_, int c_) { nM = M / BM; nN = N / BM; nwg = nM * nN; G = G_; c = c_; }
    __host__ __device__ bool next(int i, Unit& u) const {
        const long L = (long)i * G + c; if (L >= nwg) return false;
        int wgid = (int)L; { const int q = nwg / NXCD, r = nwg % NXCD, xcd = wgid % NXCD, off = wgid / NXCD; wgid = (xcd < r ? xcd * (q + 1) : r * (q + 1) + (xcd - r) * q) + off; }
        const int nig = WGM * nN, gid = wgid / nig, fm = gid * WGM, gsz = (nM - fm) < WGM ? (nM - fm) : WGM;
        u.pm = fm + ((wgid % nig) % gsz); u.pn = (wgid % nig) / gsz; return true;
    }
    __device__ __forceinline__ void a_ready(const Unit&) const {}
    __device__ __forceinline__ void done(const Unit&) const {}
};

__device__ __forceinline__ unsigned cvt_pk_bf16(float lo, float hi) { unsigned r; asm volatile("v_cvt_pk_bf16_f32 %0, %1, %2" : "=v"(r) : "v"(lo), "v"(hi)); return r; }
typedef float f32x2 __attribute__((ext_vector_type(2)));
__device__ __forceinline__ f32x2 gelu_pk(f32x2 v) {
    const f32x2 av = __builtin_elementwise_abs(v), d = av * 0.2316418882f + 1.0f;
    f32x2 t; t.x = __builtin_amdgcn_rcpf(d.x); t.y = __builtin_amdgcn_rcpf(d.y);
    f32x2 q = t * 0.5307027145f + (-0.7265760135f); q = q * t + 0.7107068705f; q = q * t + (-0.142248368f); q = q * t + 0.127414796f; q = q * t;
    const f32x2 s = (v * v) * (-0.72134752044f);
    f32x2 e; e.x = __builtin_amdgcn_exp2f(s.x); e.y = __builtin_amdgcn_exp2f(s.y);
    const f32x2 m = v * (q * e), r = v - m;
    f32x2 o; o.x = v.x < 0.f ? m.x : r.x; o.y = v.y < 0.f ? m.y : r.y; return o;
}

template <int ACT  > struct EpiBf16 {
    static constexpr bool PERM = true, AFTER_DRAIN = false; static_assert(ACT == 0 || ACT == 1, "EpiBf16: ACT is 0 (none) or 1 (gelu_pk)");
    bf16_t* O; int ldc; const float* bias; int split_cols; size_t split_stride; float scale0;
    __device__ __forceinline__ void operator()(const f32x4 (&acc)[2][2][4][2], const Unit& u, int wr, int wc, int fr, int fq) const {
        const int row0 = u.pm * BM + wr * 64 + fr; int colt = u.pn * BM; bf16_t* base = O;
        float sc = 1.f; if (split_cols) { const int t = colt / split_cols; base += (size_t)t * split_stride; colt -= t * split_cols; if (t == 0) sc = scale0; }
        const int col0 = colt + wc * 32 + 8 * fq, bcol0 = u.pn * BM + wc * 32 + 8 * fq;
        f32x4 bv[2][2];
#pragma unroll
        for (int bj = 0; bj < 2; ++bj)
#pragma unroll
            for (int n = 0; n < 2; ++n) bv[bj][n] = bias ? *(const f32x4*)(bias + bcol0 + bj * HALF + 4 * n) : (f32x4){0.f, 0.f, 0.f, 0.f};
#pragma unroll
        for (int ai = 0; ai < 2; ++ai)
#pragma unroll
            for (int m = 0; m < 4; ++m) { bf16_t* rowp = base + (size_t)(row0 + ai * HALF + m * 16) * ldc + col0;
#pragma unroll
                for (int bj = 0; bj < 2; ++bj) { f32x4 v0 = acc[ai][bj][m][0] + bv[bj][0], v1 = acc[ai][bj][m][1] + bv[bj][1];
                    if (ACT == 1) { f32x2 a = gelu_pk((f32x2){v0[0], v0[1]}), b = gelu_pk((f32x2){v0[2], v0[3]}), c = gelu_pk((f32x2){v1[0], v1[1]}), d = gelu_pk((f32x2){v1[2], v1[3]});
                        v0 = (f32x4){a.x, a.y, b.x, b.y}; v1 = (f32x4){c.x, c.y, d.x, d.y}; }
                    v0 = v0 * sc; v1 = v1 * sc; u32x4 w; w.x = cvt_pk_bf16(v0[0], v0[1]); w.y = cvt_pk_bf16(v0[2], v0[3]); w.z = cvt_pk_bf16(v1[0], v1[1]); w.w = cvt_pk_bf16(v1[2], v1[3]);
                    *(u32x4*)(rowp + bj * HALF) = w; } }
    }
};
template <class Epi, class Sched, bool ALIGN_EPI = false, bool SP2 = false>
__device__ __forceinline__ void gemm_phase(PG8_LAS unsigned char* lds, const Gemm g, const Sched& S, const Epi& E) {
    int tid_ = threadIdx.x; asm volatile("" : "+v"(tid_)); const int tid = tid_, wid = __builtin_amdgcn_readfirstlane(tid >> 6), lane = tid & 63, wr = wid >> 2, wc = wid & 3, fr = lane & 15, fq = lane >> 4;
    const int K = g.K, nt = K / BK;
    unsigned voffA[2], voffB[2];
#pragma unroll
    for (int i = 0; i < 2; ++i) { int R, C; stage_rc(tid * 16 + i * 8192, R, C); const int Rb = Epi::PERM ? ((R & ~31) + perm32(R & 31)) : R;
        voffA[i] = (unsigned)(R * K + C) * 2u; voffB[i] = (unsigned)(Rb * K + C) * 2u; }
    const size_t kstep = (size_t)(BK * 2);
    const size_t hstep = (size_t)HALF * K * 2;
    const size_t tstep = 2 * hstep;
    const unsigned ldsw = (unsigned)wid * 1024u;
    const int aoff = lds_byte(wr * 64 + fr, fq * 8), boff = lds_byte(wc * 32 + fr, fq * 8);
#define PG8_SA(b, h) (((b) * 2 + (h)) * HTB)
#define PG8_SB(b, h) ((4 + (b) * 2 + (h)) * HTB)
#define PG8_STAGE(bufoff, gbase, voff) do { _Pragma("unroll") for (int _i = 0; _i < 2; ++_i) \
        __builtin_amdgcn_global_load_lds((const unsigned*)((const char*)(gbase) + (voff)[_i]), (PG8_LAS unsigned*)(lds + (bufoff) + ldsw + _i * 8192), 16, 0, 0); } while (0)
#define PG8_LDA(dst, b, h) do { _Pragma("unroll") for (int m = 0; m < 4; ++m) _Pragma("unroll") for (int k = 0; k < 2; ++k) dst[m][k] = *(const PG8_LAS bf16x8*)(lds + PG8_SA(b, h) + aoff + m * 2048 + k * 1024); } while (0)
#define PG8_LDB(dst, b, h) do { _Pragma("unroll") for (int n = 0; n < 2; ++n) _Pragma("unroll") for (int k = 0; k < 2; ++k) dst[n][k] = *(const PG8_LAS bf16x8*)(lds + PG8_SB(b, h) + boff + n * 2048 + k * 1024); } while (0)
#define PG8_MMA(ai, bj, At, Bt) do { __builtin_amdgcn_s_setprio(1); _Pragma("unroll") for (int m = 0; m < 4; ++m) _Pragma("unroll") for (int n = 0; n < 2; ++n) _Pragma("unroll") for (int k = 0; k < 2; ++k) \
        acc[ai][bj][m][n] = __builtin_amdgcn_mfma_f32_16x16x32_bf16(Bt[n][k], At[m][k], acc[ai][bj][m][n], 0, 0, 0); __builtin_amdgcn_s_setprio(0); } while (0)
#define PG8_WAIT_V(n) asm volatile("s_waitcnt vmcnt(" #n ")" ::: "memory")
#define PG8_WAIT_L(n) asm volatile("s_waitcnt lgkmcnt(" #n ")" ::: "memory")
#define PG8_BAR __builtin_amdgcn_s_barrier()
#define PG8_SCHED __builtin_amdgcn_sched_barrier(0)
    Unit cur, nxt; int ui = 0;
    if (!S.next(0, cur)) return;
    f32x4 acc[2][2][4][2];
#pragma unroll
    for (int a = 0; a < 2; ++a)
#pragma unroll
        for (int b = 0; b < 2; ++b)
#pragma unroll
            for (int m = 0; m < 4; ++m)
#pragma unroll
                for (int n = 0; n < 2; ++n) acc[a][b][m][n] = (f32x4){0.f, 0.f, 0.f, 0.f};
    bf16x8 At[4][2], B0[2][2], B1[2][2];
    const char* cA = (const char*)g.A + (size_t)cur.pm * tstep; const char* cB = (const char*)g.Bt + (size_t)cur.pn * tstep;
    S.a_ready(cur);
    if constexpr (SP2) {
        PG8_STAGE(PG8_SB(0, 0), cB, voffB); PG8_STAGE(PG8_SB(0, 1), cB + hstep, voffB); PG8_STAGE(PG8_SA(0, 0), cA, voffA); PG8_STAGE(PG8_SA(0, 1), cA + hstep, voffA);
        if (wr == 1) PG8_BAR;
        PG8_WAIT_V(2); PG8_BAR;
        PG8_STAGE(PG8_SB(1, 0), cB + kstep, voffB); PG8_STAGE(PG8_SA(1, 0), cA + kstep, voffA); PG8_STAGE(PG8_SB(1, 1), cB + hstep + kstep, voffB);
        PG8_WAIT_V(6); PG8_BAR;
    } else {
        PG8_STAGE(PG8_SB(0, 0), cB, voffB); PG8_STAGE(PG8_SA(0, 0), cA, voffA); PG8_STAGE(PG8_SB(0, 1), cB + hstep, voffB); PG8_STAGE(PG8_SA(0, 1), cA + hstep, voffA);
        if (wr == 1) PG8_BAR;
        PG8_WAIT_V(4); PG8_BAR;
        PG8_STAGE(PG8_SB(1, 0), cB + kstep, voffB); PG8_STAGE(PG8_SA(1, 0), cA + kstep, voffA); PG8_STAGE(PG8_SB(1, 1), cB + hstep + kstep, voffB);
        PG8_WAIT_V(6); PG8_BAR;
    }
    for (;;) {
        const bool has_next = S.next(ui + 1, nxt);
        const char* nA = has_next ? (const char*)g.A + (size_t)nxt.pm * tstep : cA; const char* nB = has_next ? (const char*)g.Bt + (size_t)nxt.pn * tstep : cB;
        for (int t = 0; t < nt; t += 2) {
            const bool last = (t == nt - 2);
            const char* a1 = cA + (size_t)(t + 1) * kstep;
            const char* a2 = last ? nA : cA + (size_t)(t + 2) * kstep; const char* b2 = last ? nB : cB + (size_t)(t + 2) * kstep;
            const char* a3 = a2 + kstep; const char* b3 = b2 + kstep;
            if (last && has_next) S.a_ready(nxt);
            if constexpr (SP2) {
            PG8_LDB(B0, 0, 0); PG8_LDB(B1, 0, 1); PG8_SCHED; PG8_LDA(At, 0, 0); PG8_STAGE(PG8_SA(1, 1), a1 + hstep, voffA);
            PG8_WAIT_V(8); PG8_WAIT_L(0); PG8_BAR; PG8_MMA(0, 0, At, B0); PG8_MMA(0, 1, At, B1); PG8_BAR; PG8_SCHED;
            PG8_LDA(At, 0, 1); PG8_STAGE(PG8_SB(0, 0), b2, voffB); PG8_STAGE(PG8_SB(0, 1), b2 + hstep, voffB); PG8_STAGE(PG8_SA(0, 0), a2, voffA);
            PG8_WAIT_V(8); PG8_WAIT_L(0); PG8_BAR; PG8_MMA(1, 0, At, B0); PG8_MMA(1, 1, At, B1); PG8_BAR; PG8_SCHED;
            PG8_LDB(B0, 1, 0); PG8_LDB(B1, 1, 1); PG8_SCHED; PG8_LDA(At, 1, 0); PG8_STAGE(PG8_SA(0, 1), a2 + hstep, voffA);
            PG8_WAIT_V(8); PG8_WAIT_L(0); PG8_BAR; PG8_MMA(0, 0, At, B0); PG8_MMA(0, 1, At, B1); PG8_BAR; PG8_SCHED;
            PG8_LDA(At, 1, 1); PG8_STAGE(PG8_SB(1, 0), b3, voffB); PG8_STAGE(PG8_SB(1, 1), b3 + hstep, voffB); PG8_STAGE(PG8_SA(1, 0), a3, voffA);
            PG8_WAIT_V(8); PG8_WAIT_L(0); PG8_BAR; PG8_MMA(1, 0, At, B0); PG8_MMA(1, 1, At, B1); PG8_BAR; PG8_SCHED;
            } else {
            PG8_LDB(B0, 0, 0); PG8_SCHED; PG8_LDA(At, 0, 0); PG8_STAGE(PG8_SA(1, 1), a1 + hstep, voffA);
            PG8_WAIT_L(8); PG8_BAR; PG8_WAIT_L(0); PG8_MMA(0, 0, At, B0); PG8_BAR; PG8_SCHED;
            PG8_LDB(B1, 0, 1); PG8_STAGE(PG8_SB(0, 0), b2, voffB);
            PG8_BAR; PG8_WAIT_L(0); PG8_MMA(0, 1, At, B1); PG8_BAR;
            PG8_LDA(At, 0, 1); PG8_STAGE(PG8_SA(0, 0), a2, voffA);
            PG8_BAR; PG8_WAIT_L(0); PG8_MMA(1, 0, At, B0); PG8_BAR; PG8_SCHED;
            PG8_STAGE(PG8_SB(0, 1), b2 + hstep, voffB);
            PG8_WAIT_V(6); PG8_BAR; PG8_MMA(1, 1, At, B1); PG8_BAR;
            PG8_LDB(B0, 1, 0); PG8_SCHED; PG8_LDA(At, 1, 0); PG8_STAGE(PG8_SA(0, 1), a2 + hstep, voffA);
            PG8_WAIT_L(8); PG8_BAR; PG8_WAIT_L(0); PG8_MMA(0, 0, At, B0); PG8_BAR; PG8_SCHED;
            PG8_LDB(B1, 1, 1); PG8_STAGE(PG8_SB(1, 0), b3, voffB);
            PG8_BAR; PG8_WAIT_L(0); PG8_MMA(0, 1, At, B1); PG8_BAR;
            PG8_LDA(At, 1, 1); PG8_STAGE(PG8_SA(1, 0), a3, voffA);
            PG8_BAR; PG8_WAIT_L(0); PG8_MMA(1, 0, At, B0); PG8_BAR; PG8_SCHED;
            PG8_STAGE(PG8_SB(1, 1), b3 + hstep, voffB);
            PG8_WAIT_V(6); PG8_BAR; PG8_MMA(1, 1, At, B1); PG8_BAR;
            }
        }
        if constexpr (ALIGN_EPI) { if (wr == 0) PG8_BAR; }
        if constexpr (!Epi::AFTER_DRAIN) { E(acc, cur, wr, wc, fr, fq); S.done(cur); }
        if (!has_next) break;
#pragma unroll
        for (int a = 0; a < 2; ++a)
#pragma unroll
            for (int b = 0; b < 2; ++b)
#pragma unroll
                for (int m = 0; m < 4; ++m)
#pragma unroll
                    for (int n = 0; n < 2; ++n) acc[a][b][m][n] = (f32x4){0.f, 0.f, 0.f, 0.f};
        cur = nxt; cA = nA; cB = nB; ++ui;
        if constexpr (ALIGN_EPI) { if (wr == 1) PG8_BAR; }
    }
    PG8_WAIT_V(0);
    if constexpr (!ALIGN_EPI) { if (wr == 0) PG8_BAR; }
    PG8_BAR;
    if constexpr (Epi::AFTER_DRAIN) { E.fused(acc, cur, wr, wc, fr, fq, lds, wid, lane); S.done(cur); }
#undef PG8_SA
#undef PG8_SB
#undef PG8_STAGE
#undef PG8_LDA
#undef PG8_LDB
#undef PG8_MMA
#undef PG8_WAIT_V
#undef PG8_WAIT_L
#undef PG8_BAR
#undef PG8_SCHED
}
}

constexpr int DM = 2048, NB = 2, SEQ = 4096, MROWS = NB * SEQ, DEPTH = 4;
constexpr int LRU_W = 512, RW = 768, MOW = 768, NIN = 7296, NINP = 7424;
constexpr int OFF_XA = 0, OFF_GA = 512, OFF_SB = 1024, OFF_GB = 3456, OFF_QKV = 4224, OFF_GC = 6528;
constexpr int RSTREAM = 2432;
constexpr int NH = 12, HD = 64, NBLK = 16, BLK = 256;

typedef unsigned short bf16;
typedef float f32x4 __attribute__((ext_vector_type(4)));
typedef unsigned u32x4 __attribute__((ext_vector_type(4)));
typedef unsigned u32x2 __attribute__((ext_vector_type(2)));

__device__ __forceinline__ unsigned f2bf(float f) { unsigned u = __builtin_bit_cast(unsigned, f); return (u + 0x7fffu + ((u >> 16) & 1u)) >> 16; }
__device__ __forceinline__ unsigned pk2(float lo, float hi) { return f2bf(lo) | (f2bf(hi) << 16); }
__device__ __forceinline__ float bf2f(unsigned short b) { return __builtin_bit_cast(float, (unsigned)b << 16); }
__device__ __forceinline__ float bflo(unsigned w) { return __builtin_bit_cast(float, w << 16); }
__device__ __forceinline__ float bfhi(unsigned w) { return __builtin_bit_cast(float, w & 0xffff0000u); }
__device__ __forceinline__ float sigmoidf_(float x) { return __builtin_amdgcn_rcpf(1.f + __expf(-x)); }
__device__ __forceinline__ float siluf_(float x) { return x * __builtin_amdgcn_rcpf(1.f + __expf(-x)); }
template <int CTRL, int RMASK> __device__ __forceinline__ float dpp0(float v) { return __builtin_bit_cast(float, __builtin_amdgcn_update_dpp(0, __builtin_bit_cast(int, v), CTRL, RMASK, 0xf, false)); }
__device__ __forceinline__ float wave_sum(float v) {
    v += dpp0<0xB1, 0xf>(v); v += dpp0<0x4E, 0xf>(v); v += dpp0<0x141, 0xf>(v); v += dpp0<0x140, 0xf>(v);
    v += dpp0<0x142, 0xa>(v);
    v += dpp0<0x143, 0xc>(v);
    return __builtin_bit_cast(float, __builtin_amdgcn_readlane(__builtin_bit_cast(int, v), 63));
}

__device__ __forceinline__ void transpose_item(const float* W, int K, int N, bf16* WT, float* scr, int item, int lane, const float* kscale = nullptr) {
    const int nblk = N / 32, kb = item / nblk, nb = item % nblk, k0 = 64 * kb, n0 = 32 * nb;
#pragma unroll 8
    for (int i = 0; i < 32; ++i) { const int kk = 2 * i + (lane >> 5); scr[kk * 33 + (lane & 31)] = W[(size_t)(k0 + kk) * N + n0 + (lane & 31)]; }
    __builtin_amdgcn_s_waitcnt(0xc07f); __builtin_amdgcn_wave_barrier();
    const int c = lane & 7;
    float ks8[8];
#pragma unroll
    for (int e = 0; e < 8; ++e) ks8[e] = kscale ? kscale[k0 + 8 * c + e] : 1.f;
#pragma unroll
    for (int j = 0; j < 4; ++j) { const int n = (lane >> 3) + 8 * j; const float* s = scr + (8 * c) * 33 + n;
        u32x4 o; o.x = pk2(s[0 * 33] * ks8[0], s[1 * 33] * ks8[1]); o.y = pk2(s[2 * 33] * ks8[2], s[3 * 33] * ks8[3]); o.z = pk2(s[4 * 33] * ks8[4], s[5 * 33] * ks8[5]); o.w = pk2(s[6 * 33] * ks8[6], s[7 * 33] * ks8[7]);
        *(u32x4*)(WT + (size_t)(n0 + n) * K + k0 + 8 * c) = o; }
    __builtin_amdgcn_s_waitcnt(0xc07f); __builtin_amdgcn_wave_barrier();
}

constexpr size_t MiB = 1u << 20;
constexpr size_t WS_CTL = 0;
constexpr size_t WS_WINT = 1 * MiB;
constexpr size_t WS_WOUTT = WS_WINT + (size_t)DEPTH * NINP * DM * 2;
constexpr size_t WS_X = WS_WOUTT + (size_t)DEPTH * DM * DM * 2;
constexpr size_t WS_H = WS_X + (size_t)MROWS * DM * 4;
constexpr size_t WS_P = WS_H + (size_t)MROWS * DM * 2;
constexpr size_t WS_Y = WS_P + (size_t)MROWS * NINP * 2;
constexpr size_t WS_RW = WS_Y + (size_t)MROWS * DM * 2;
constexpr size_t RW_ARR = (size_t)MROWS * RW * 4;
constexpr size_t WS_RWST = WS_RW + 104 * MiB;
constexpr size_t WS_KMEAN = WS_RW + 8 * RW_ARR;
constexpr size_t WS_LRU = WS_KMEAN + 1 * MiB;
constexpr size_t WS_O1 = WS_LRU + 2 * (size_t)MROWS * LRU_W * 4 + 1 * MiB;
constexpr size_t WS_LORA = WS_O1 + (size_t)NB * NH * (SEQ / 32) * 12288;
constexpr size_t WS_END = WS_LORA + (size_t)DEPTH * NH * 2 * 64 * 64 * 2;
constexpr int LDS_BYTES = 147456;
constexpr int NTHREADS = 512, NWAVES = 8;

typedef float f32x2e_t __attribute__((ext_vector_type(2))); typedef __bf16 bf16x2e_t __attribute__((ext_vector_type(2)));
__device__ __forceinline__ unsigned cvtpk_e(float lo, float hi) { const f32x2e_t v = {lo, hi}; const bf16x2e_t b = __builtin_convertvector(v, bf16x2e_t); return __builtin_bit_cast(unsigned, b); }
struct EpiRes {
    static constexpr bool PERM = false, AFTER_DRAIN = false;
    const void* base; bf16* out; int ldc; int base_f32; float* lpart;
    __device__ __forceinline__ void operator()(const pg8::f32x4 (&acc)[2][2][4][2], const pg8::Unit& u, int wr, int wc, int fr, int fq) const {
        const int row0 = u.pm * 256 + wr * 64 + fr, col0 = u.pn * 256 + wc * 32 + 4 * fq;
        float ss[2][4];
#pragma unroll
        for (int ai = 0; ai < 2; ++ai)
#pragma unroll
            for (int m = 0; m < 4; ++m) ss[ai][m] = 0.f;
#pragma unroll
        for (int ai = 0; ai < 2; ++ai)
#pragma unroll
            for (int mp = 0; mp < 2; ++mp) { pg8::f32x4 bs[2][2][2];
                if (base_f32) {
#pragma unroll
                    for (int mm = 0; mm < 2; ++mm) { const size_t off = (size_t)(row0 + ai * 128 + (2 * mp + mm) * 16) * ldc + col0;
#pragma unroll
                        for (int bj = 0; bj < 2; ++bj)
#pragma unroll
                            for (int n = 0; n < 2; ++n) bs[mm][bj][n] = *(const pg8::f32x4*)((const float*)base + off + bj * 128 + n * 16); }
                    asm volatile("" : "+v"(bs[0][0][0]), "+v"(bs[0][0][1]), "+v"(bs[0][1][0]), "+v"(bs[0][1][1]), "+v"(bs[1][0][0]), "+v"(bs[1][0][1]), "+v"(bs[1][1][0]), "+v"(bs[1][1][1]));
                } else { u32x2 bw[2][2][2];
#pragma unroll
                    for (int mm = 0; mm < 2; ++mm) { const size_t off = (size_t)(row0 + ai * 128 + (2 * mp + mm) * 16) * ldc + col0;
#pragma unroll
                        for (int bj = 0; bj < 2; ++bj)
#pragma unroll
                            for (int n = 0; n < 2; ++n) bw[mm][bj][n] = *(const u32x2*)((const bf16*)base + off + bj * 128 + n * 16); }
                    asm volatile("" : "+v"(bw[0][0][0]), "+v"(bw[0][0][1]), "+v"(bw[0][1][0]), "+v"(bw[0][1][1]), "+v"(bw[1][0][0]), "+v"(bw[1][0][1]), "+v"(bw[1][1][0]), "+v"(bw[1][1][1]));
#pragma unroll
                    for (int mm = 0; mm < 2; ++mm)
#pragma unroll
                        for (int bj = 0; bj < 2; ++bj)
#pragma unroll
                            for (int n = 0; n < 2; ++n) { const u32x2 w = bw[mm][bj][n]; bs[mm][bj][n] = (pg8::f32x4){__builtin_bit_cast(float, w.x << 16), __builtin_bit_cast(float, w.x & 0xffff0000u), __builtin_bit_cast(float, w.y << 16), __builtin_bit_cast(float, w.y & 0xffff0000u)}; } }
#pragma unroll
                for (int mm = 0; mm < 2; ++mm) { const size_t off = (size_t)(row0 + ai * 128 + (2 * mp + mm) * 16) * ldc + col0;
#pragma unroll
                    for (int bj = 0; bj < 2; ++bj)
#pragma unroll
                        for (int n = 0; n < 2; ++n) { const pg8::f32x4 o = bs[mm][bj][n] + acc[ai][bj][2 * mp + mm][n]; *(u32x2*)(out + off + bj * 128 + n * 16) = (u32x2){cvtpk_e(o.x, o.y), cvtpk_e(o.z, o.w)};
                            ss[ai][2 * mp + mm] += (o.x * o.x + o.y * o.y) + (o.z * o.z + o.w * o.w); } } }
#pragma unroll
        for (int ai = 0; ai < 2; ++ai)
#pragma unroll
            for (int m = 0; m < 4; ++m) { float v = ss[ai][m];
                v += __builtin_bit_cast(float, __builtin_amdgcn_ds_swizzle(__builtin_bit_cast(int, v), 0x401F));
                { float t = v; asm volatile("s_nop 1\n\tv_permlane32_swap_b32 %0, %1" : "+v"(v), "+v"(t)); v = v + t; }
                if (fq == 0) lpart[wc * 256 + wr * 64 + fr + ai * 128 + m * 16] = v; }
    }
};


struct EpiP {
    static constexpr bool PERM = true, AFTER_DRAIN = false;
    bf16* O; int ldc; const float* rstd;
    __device__ __forceinline__ void operator()(const pg8::f32x4 (&acc)[2][2][4][2], const pg8::Unit& u, int wr, int wc, int fr, int fq) const {
        const int row0 = u.pm * 256 + wr * 64 + fr, col0 = u.pn * 256 + wc * 32 + 8 * fq;
        float rs[2][4];
        { pg8::f32x4 pa[2][4], pb[2][4];
#pragma unroll
          for (int ai = 0; ai < 2; ++ai)
#pragma unroll
              for (int m = 0; m < 4; ++m) { const pg8::f32x4* rp = (const pg8::f32x4*)(rstd + (size_t)(row0 + ai * 128 + m * 16) * 8); pa[ai][m] = rp[0]; pb[ai][m] = rp[1]; }
          asm volatile("" : "+v"(pa[0][0]), "+v"(pa[0][1]), "+v"(pa[0][2]), "+v"(pa[0][3]), "+v"(pa[1][0]), "+v"(pa[1][1]), "+v"(pa[1][2]), "+v"(pa[1][3]));
          asm volatile("" : "+v"(pb[0][0]), "+v"(pb[0][1]), "+v"(pb[0][2]), "+v"(pb[0][3]), "+v"(pb[1][0]), "+v"(pb[1][1]), "+v"(pb[1][2]), "+v"(pb[1][3]));
#pragma unroll
          for (int ai = 0; ai < 2; ++ai)
#pragma unroll
              for (int m = 0; m < 4; ++m) { const float t = ((pa[ai][m].x + pa[ai][m].y) + (pa[ai][m].z + pa[ai][m].w)) + ((pb[ai][m].x + pb[ai][m].y) + (pb[ai][m].z + pb[ai][m].w));
                  rs[ai][m] = __builtin_amdgcn_rsqf(t * (1.f / DM) + 1e-6f); } }
#pragma unroll
        for (int ai = 0; ai < 2; ++ai)
#pragma unroll
            for (int m = 0; m < 4; ++m) { bf16* rowp = O + (size_t)(row0 + ai * 128 + m * 16) * ldc + col0;
#pragma unroll
                for (int bj = 0; bj < 2; ++bj) { const int c = col0 + bj * 128; const float sc = ((c >= OFF_QKV && c < OFF_QKV + MOW) ? 0.125f * 1.4426950408889634f : 1.f) * rs[ai][m];
                    const pg8::f32x4 v0 = acc[ai][bj][m][0] * sc, v1 = acc[ai][bj][m][1] * sc;
                    pg8::u32x4 w; w.x = pg8::cvt_pk_bf16(v0[0], v0[1]); w.y = pg8::cvt_pk_bf16(v0[2], v0[3]); w.z = pg8::cvt_pk_bf16(v1[0], v1[1]); w.w = pg8::cvt_pk_bf16(v1[2], v1[3]);
                    *(pg8::u32x4*)(rowp + bj * 128) = w; } }
    }
};
__device__ __forceinline__ int tidx() { int t = threadIdx.x; asm volatile("" : "+v"(t)); return t; }
#ifndef PROBE_PH
#define PROBE_PH 0
#endif
struct Args { const float* in[23]; float* out; unsigned char* ws; };

__device__ __forceinline__ void phase_prep_weights(const Args& a, float* lds_f) {
    const int TID = tidx();
    const int lane = TID & 63, wave = TID >> 6;
    float* scr = lds_f + wave * 64 * 33;
    bf16* WinT = (bf16*)(a.ws + WS_WINT); bf16* WoutT = (bf16*)(a.ws + WS_WOUTT);
    const float* w_in = a.in[2]; const float* w_out = a.in[3];
    const int gw = blockIdx.x * NWAVES + wave, NGW = gridDim.x * NWAVES;
    constexpr int I_IN = (DM / 64) * (NIN / 32), I_OUT = (DM / 64) * (DM / 32);
    constexpr int NITEMS = DEPTH * (I_IN + I_OUT);
    for (int it = gw; it < NITEMS; it += NGW) {
        if (it < DEPTH * I_IN) { const int l = it / I_IN, r = it % I_IN; transpose_item(w_in + (size_t)l * DM * NIN, DM, NIN, WinT + (size_t)l * NINP * DM, scr, r, lane, a.in[1] + (size_t)l * DM); }
        else { const int r0 = it - DEPTH * I_IN, l = r0 / I_OUT, r = r0 % I_OUT; transpose_item(w_out + (size_t)l * DM * DM, DM, DM, WoutT + (size_t)l * DM * DM, scr, r, lane); }
    }
    const int gt = blockIdx.x * NTHREADS + TID, NGT = gridDim.x * NTHREADS;
    { bf16* LO = (bf16*)(a.ws + WS_LORA); const float* wu = a.in[13]; const float* au = a.in[15];
      for (int i = blockIdx.x * NTHREADS + TID; i < DEPTH * NH * 2 * 64 * 8; i += gridDim.x * NTHREADS) { const int c = i & 63, kg = (i >> 6) & 7, m = (i >> 9) & 1, lh = i >> 10, hh_ = lh % NH, l = lh / NH;
          const float* src = (m ? au : wu) + (size_t)l * 64 * RW + (size_t)(8 * kg) * RW + hh_ * 64 + c; float v[8];
#pragma unroll
          for (int e = 0; e < 8; ++e) v[e] = src[(size_t)e * RW];
          *(u32x4*)(LO + ((size_t)(lh * 2 + m) * 64 + c) * 64 + 8 * kg) = (u32x4){pk2(v[0], v[1]), pk2(v[2], v[3]), pk2(v[4], v[5]), pk2(v[6], v[7])}; } }
    constexpr int PADV = (NINP - NIN) * DM / 8;
    for (int i = gt; i < DEPTH * PADV; i += NGT) { const int l = i / PADV, r = i % PADV; *(u32x4*)(WinT + (size_t)l * NINP * DM + (size_t)NIN * DM + (size_t)r * 8) = (u32x4){0u, 0u, 0u, 0u}; }
}
template <bool FINAL> __device__ __forceinline__ void phase_rmsnorm(const void* x, int x_f32, const float* w, bf16* hb, float* outf) {
    const int TID = tidx();
    const int lane = TID & 63, wave = TID >> 6;
    for (int row = blockIdx.x * NWAVES + wave; row < MROWS; row += gridDim.x * NWAVES) {
        f32x4 v[8]; float s = 0.f;
        if (x_f32) { const f32x4* xr = (const f32x4*)((const float*)x + (size_t)row * DM) + lane;
#pragma unroll
            for (int j = 0; j < 8; ++j) v[j] = xr[64 * j]; }
        else { const u32x2* xr = (const u32x2*)((const bf16*)x + (size_t)row * DM) + lane;
#pragma unroll
            for (int j = 0; j < 8; ++j) { const u32x2 w2 = xr[64 * j]; v[j] = (f32x4){__builtin_bit_cast(float, w2.x << 16), __builtin_bit_cast(float, w2.x & 0xffff0000u), __builtin_bit_cast(float, w2.y << 16), __builtin_bit_cast(float, w2.y & 0xffff0000u)}; } }
#pragma unroll
        for (int j = 0; j < 8; ++j) s += (v[j].x * v[j].x + v[j].y * v[j].y) + (v[j].z * v[j].z + v[j].w * v[j].w);
        const float ssum = wave_sum(s); const float rstd = rsqrtf(ssum * (1.f / DM) + 1e-6f);
        if (!FINAL) {
            if (lane < 8) outf[(size_t)row * 8 + lane] = lane == 0 ? ssum : 0.f;
            if (x_f32) {
#pragma unroll
                for (int j = 0; j < 8; ++j) { u32x2 pk; pk.x = pk2(v[j].x, v[j].y); pk.y = pk2(v[j].z, v[j].w); ((u32x2*)(hb + (size_t)row * DM) + lane)[64 * j] = pk; } }
            continue; }
        const f32x4* wr = (const f32x4*)w + lane;
        f32x4 wv[8];
#pragma unroll
        for (int j = 0; j < 8; ++j) wv[j] = wr[64 * j];
        asm volatile("" : "+v"(wv[0]), "+v"(wv[1]), "+v"(wv[2]), "+v"(wv[3]), "+v"(wv[4]), "+v"(wv[5]), "+v"(wv[6]), "+v"(wv[7]));
#pragma unroll
        for (int j = 0; j < 8; ++j) { const f32x4 ww = wv[j]; const f32x4 o = v[j] * rstd * ww;
            if (FINAL) { ((f32x4*)(outf + (size_t)row * DM) + lane)[64 * j] = o; }
            else { u32x2 pk; pk.x = pk2(o.x, o.y); pk.y = pk2(o.z, o.w); ((u32x2*)(hb + (size_t)row * DM) + lane)[64 * j] = pk; } }
    }
}
struct LruP { const float *conv_w, *conv_b, *ga_w, *ga_b, *gx_w, *gx_b, *lam; };
struct LruBuf { float *HL, *AC, *SH, *SA; };
constexpr int LSEG = 256, NSEG = SEQ / LSEG, XSTR = 260;
typedef short lbfx8 __attribute__((ext_vector_type(8))); typedef float lfx16 __attribute__((ext_vector_type(16)));
__device__ __forceinline__ void lru_swap32(float& a, float& b) { asm volatile("s_nop 1\n\tv_permlane32_swap_b32 %0, %1" : "+v"(a), "+v"(b)); }
constexpr int LXS = 72;
__device__ __forceinline__ void lru_local_unit(int unit, const bf16* __restrict__ p, const LruP& P, const LruBuf& L, float* lds_f) {
    const int TID = tidx();
    bf16* sWTa = (bf16*)lds_f; bf16* sWTx = sWTa + 64 * LXS; bf16* sXB = sWTx + 64 * LXS;
    float* sCar = (float*)(sXB + 256 * LXS);
    const int b = unit >> 7, g = (unit >> 4) & 7, seg = unit & 15, c = TID & 63, tg = TID >> 6, t0 = seg * LSEG;
    { float wa[8], wx[8];
#pragma unroll
      for (int j = 0; j < 8; ++j) { wa[j] = P.ga_w[g * 4096 + TID + NTHREADS * j]; wx[j] = P.gx_w[g * 4096 + TID + NTHREADS * j]; }
      asm volatile("" : "+v"(wa[0]), "+v"(wa[1]), "+v"(wa[2]), "+v"(wa[3]), "+v"(wa[4]), "+v"(wa[5]), "+v"(wa[6]), "+v"(wa[7]));
      asm volatile("" : "+v"(wx[0]), "+v"(wx[1]), "+v"(wx[2]), "+v"(wx[3]), "+v"(wx[4]), "+v"(wx[5]), "+v"(wx[6]), "+v"(wx[7]));
#pragma unroll
      for (int j = 0; j < 8; ++j) { const int i = TID + NTHREADS * j, k = i >> 6, cc = i & 63; sWTa[cc * LXS + k] = (bf16)f2bf(wa[j]); sWTx[cc * LXS + k] = (bf16)f2bf(wx[j]); } }
    const int ch = g * 64 + c;
    const float cw0 = P.conv_w[0 * LRU_W + ch], cw1 = P.conv_w[1 * LRU_W + ch], cw2 = P.conv_w[2 * LRU_W + ch], cw3 = P.conv_w[3 * LRU_W + ch], cb = P.conv_b[ch];
    const float sp = log1pf(__expf(-P.lam[ch]));
    float xc[32];
    { const int tb = t0 + tg * 32; const bf16* pr = p + (size_t)(b * SEQ + tb) * NINP + OFF_XA + ch;
      unsigned xu[35];
#pragma unroll
      for (int i = 0; i < 35; ++i) xu[i] = (i >= 3 || tb >= 3 - i) ? (unsigned)pr[(ptrdiff_t)(i - 3) * NINP] : 0u;
#pragma unroll
      for (int gq = 0; gq < 5; ++gq) asm volatile("" : "+v"(xu[7 * gq]), "+v"(xu[7 * gq + 1]), "+v"(xu[7 * gq + 2]), "+v"(xu[7 * gq + 3]), "+v"(xu[7 * gq + 4]), "+v"(xu[7 * gq + 5]), "+v"(xu[7 * gq + 6]));
      float x3 = bf2f((unsigned short)xu[0]), x2 = bf2f((unsigned short)xu[1]), x1 = bf2f((unsigned short)xu[2]);
#pragma unroll
      for (int i = 0; i < 32; ++i) { const float x0 = bf2f((unsigned short)xu[i + 3]); xc[i] = cw3 * x0 + cw2 * x1 + cw1 * x2 + cw0 * x3 + cb; x3 = x2; x2 = x1; x1 = x0; } }
#pragma unroll
    for (int i = 0; i < 32; ++i) sXB[(tg * 32 + i) * LXS + c] = (bf16)f2bf(xc[i]);
    __syncthreads();
    float ra[32], ia[32];
    { const int r = c & 31, h = c >> 5;
      lbfx8 fa[4];
#pragma unroll
      for (int ks = 0; ks < 4; ++ks) fa[ks] = *(const lbfx8*)(sXB + (tg * 32 + r) * LXS + 16 * ks + 8 * h);
#pragma unroll
      for (int gate = 0; gate < 2; ++gate) { const bf16* W = gate ? sWTx : sWTa; const float* bp = (gate ? P.gx_b : P.ga_b) + g * 64;
          const float b0 = bp[r], b1 = bp[32 + r];
          lfx16 acc0 = {}, acc1 = {};
#pragma unroll
          for (int ks = 0; ks < 4; ++ks) { const lbfx8 w0 = *(const lbfx8*)(W + r * LXS + 16 * ks + 8 * h), w1 = *(const lbfx8*)(W + (32 + r) * LXS + 16 * ks + 8 * h);
              acc0 = __builtin_amdgcn_mfma_f32_32x32x16_bf16(fa[ks], w0, acc0, 0, 0, 0); acc1 = __builtin_amdgcn_mfma_f32_32x32x16_bf16(fa[ks], w1, acc1, 0, 0, 0); }
#pragma unroll
          for (int i = 0; i < 16; ++i) { float a0 = acc0[i] + b0, a1 = acc1[i] + b1; lru_swap32(a0, a1); const int t = (i & 3) + 8 * (i >> 2);
              if (gate == 0) { ra[t] = a0; ra[t + 4] = a1; } else { ia[t] = a0; ia[t + 4] = a1; } } } }
    { float h = 0.f, A = 1.f;
#pragma unroll
      for (int i = 0; i < 32; ++i) { const float r = sigmoidf_(ra[i]), ig = sigmoidf_(ia[i]);
          const float log_a = -8.f * r * sp; const float av = __expf(log_a);
          const float x2 = 2.f * log_a; float om = 1.f - av * av; if (x2 > -0.03f) om = -x2 * (1.f + x2 * (0.5f + x2 * (1.f / 6.f)));
          const float bb = __builtin_amdgcn_sqrtf(om) * (ig * xc[i]);
          h = av * h + bb; A *= av; ra[i] = h; ia[i] = A; }
      sCar[(tg * 64 + c) * 2] = h; sCar[(tg * 64 + c) * 2 + 1] = A; }
    __syncthreads();
    float cin = 0.f, Ap = 1.f;
    for (int q = 0; q < tg; ++q) { const float he = sCar[(q * 64 + c) * 2], Ae = sCar[(q * 64 + c) * 2 + 1]; cin = he + Ae * cin; Ap *= Ae; }
    { const size_t o = (size_t)(b * SEQ + t0 + tg * 32) * LRU_W + ch;
#pragma unroll
      for (int i = 0; i < 32; ++i) { const float h = ra[i] + ia[i] * cin, A = ia[i] * Ap; L.HL[o + (size_t)i * LRU_W] = h; L.AC[o + (size_t)i * LRU_W] = A;
          if (i == 31 && tg == 7) { L.SH[(b * NSEG + seg) * LRU_W + ch] = h; L.SA[(b * NSEG + seg) * LRU_W + ch] = A; } } }
    __syncthreads();
}
__device__ __forceinline__ void lru_final_unit(int unit, const bf16* __restrict__ p, const LruBuf& L, bf16* ybuf, float* lds_f) {
    const int TID = tidx();
    const int b = unit >> 7, g = (unit >> 4) & 7, seg = unit & 15, c = TID & 63, tg = TID >> 6, t0 = seg * LSEG, ch = g * 64 + c;
    float cin = 0.f;
    for (int s = 0; s < seg; ++s) cin = L.SH[(b * NSEG + s) * LRU_W + ch] + L.SA[(b * NSEG + s) * LRU_W + ch] * cin;
    const size_t row0 = (size_t)(b * SEQ + t0 + tg * 32);
    for (int i0 = 0; i0 < 32; i0 += 8) { float hl[8], ac[8]; unsigned gu[8];
#pragma unroll
        for (int i = 0; i < 8; ++i) { const size_t row = row0 + i0 + i; hl[i] = L.HL[row * LRU_W + ch]; ac[i] = L.AC[row * LRU_W + ch]; gu[i] = p[row * NINP + OFF_GA + ch]; }
        asm volatile("" : "+v"(hl[0]), "+v"(hl[1]), "+v"(hl[2]), "+v"(hl[3]), "+v"(hl[4]), "+v"(hl[5]), "+v"(hl[6]), "+v"(hl[7]));
        asm volatile("" : "+v"(ac[0]), "+v"(ac[1]), "+v"(ac[2]), "+v"(ac[3]), "+v"(ac[4]), "+v"(ac[5]), "+v"(ac[6]), "+v"(ac[7]));
        asm volatile("" : "+v"(gu[0]), "+v"(gu[1]), "+v"(gu[2]), "+v"(gu[3]), "+v"(gu[4]), "+v"(gu[5]), "+v"(gu[6]), "+v"(gu[7]));
#pragma unroll
        for (int i = 0; i < 8; ++i) { const size_t row = row0 + i0 + i; const float h = hl[i] + ac[i] * cin; const float ga = bf2f((unsigned short)gu[i]);
            ybuf[row * DM + ch] = (bf16)f2bf(h * siluf_(ga)); } }
}
struct RwkvP { const float *mix, *w0, *w_up, *a0, *a_up, *k_k, *k_a, *r_k, *ln_w, *ln_b; const bf16* lora; };
typedef short bfx8 __attribute__((ext_vector_type(8)));
typedef float fx16 __attribute__((ext_vector_type(16)));
#define MFMA32(a, b, c) __builtin_amdgcn_mfma_f32_32x32x16_bf16(a, b, c, 0, 0, 0)
constexpr int RC = 32, NCH = SEQ / RC;
constexpr int CH_AT = 0, CH_BT = 4096, CH_KT = 8192, CH_RT = 12288, CH_BHT = 16384, CH_KHT = 20480, CH_VT = 24576, CH_VR = 28672, CH_ECW = 32768, CH_C3 = 33024, CH_STRIDE = 33280;
constexpr int O_P = 0, O_QT = 4096, O_ARB = 8192, O_ARK = 10240, O_STRIDE = 12288;
constexpr int ST_S0 = 0, ST_UT = 8192, ST_STRIDE = 12288;
struct RwcBuf { unsigned char *CH, *O1, *ST; };
__device__ __forceinline__ int crow16(int reg, int h) { return (reg & 3) + 8 * (reg >> 2) + 4 * h; }
typedef float f32x2c_t __attribute__((ext_vector_type(2))); typedef __bf16 bf16x2c_t __attribute__((ext_vector_type(2)));
__device__ __forceinline__ unsigned cvtpk(float lo, float hi) { const f32x2c_t v = {lo, hi}; const bf16x2c_t b = __builtin_convertvector(v, bf16x2c_t); return __builtin_bit_cast(unsigned, b); }

__device__ __forceinline__ void rwkv_stage1(int item, const RwcBuf& B, unsigned char* wl);
__device__ __forceinline__ void rwkv_phaseA(int unit, const bf16* __restrict__ p, const RwkvP& P, const RwcBuf& B, unsigned char* lds) {
    const int TID = tidx();
    const int wave = TID >> 6;
    bf16* TW = (bf16*)(lds + 132096); bf16* AD = TW + 32 * 64;
    float* LWt = (float*)(lds + wave * 16384); float* LAt = LWt + 64 * 32;
    const int row0 = unit * 32, b = row0 >> 12, tb = row0 & (SEQ - 1), chunk = tb >> 5;
    { unsigned cu[8], pu[8];
      const float mixv = P.mix[2304 + (TID & 127)];
#pragma unroll
      for (int i = 0; i < 8; ++i) { const int idx = TID + 512 * i, tok = idx >> 7, col = idx & 127, cidx = 2304 + col;
          const bf16* cur = p + (size_t)(row0 + tok) * NINP + OFF_SB + cidx;
          cu[i] = cur[0]; pu[i] = (tb + tok) > 0 ? (unsigned)*(cur - NINP) : 0u; }
      asm volatile("" : "+v"(cu[0]), "+v"(cu[1]), "+v"(cu[2]), "+v"(cu[3]), "+v"(cu[4]), "+v"(cu[5]), "+v"(cu[6]), "+v"(cu[7]));
      asm volatile("" : "+v"(pu[0]), "+v"(pu[1]), "+v"(pu[2]), "+v"(pu[3]), "+v"(pu[4]), "+v"(pu[5]), "+v"(pu[6]), "+v"(pu[7]));
#pragma unroll
      for (int i = 0; i < 8; ++i) { const int idx = TID + 512 * i, tok = idx >> 7, col = idx & 127;
          const float c0 = bf2f((unsigned short)cu[i]), p0 = bf2f((unsigned short)pu[i]); const float s = c0 + mixv * (p0 - c0);
          const int cc = col & 63, so = tok * 64 + (((cc >> 3) ^ (tok & 7)) << 3) + (cc & 7);
          if (col < 64) TW[so] = (bf16)f2bf(tanhf(s)); else AD[so] = (bf16)f2bf(s); } }
    __syncthreads();
    for (int pass = 0; pass < 2; ++pass) {
        int tl_ = TID; asm volatile("" : "+v"(tl_));
        const int c = pass * 512 + tl_, lane = tl_ & 63, r = lane & 31, hh = lane >> 5;
        if (c < RW) {
            { bfx8 aW[4], aA[4];
#pragma unroll
              for (int ks = 0; ks < 4; ++ks) { const int so = r * 64 + (((2 * ks + hh) ^ (r & 7)) << 3); aW[ks] = *(const bfx8*)(TW + so); aA[ks] = *(const bfx8*)(AD + so); }
              const int cb = (c & ~63);
#pragma unroll
              for (int n = 0; n < 2; ++n) { fx16 xw = {}, xa = {};
                  const bf16* wfr = P.lora + ((size_t)((cb >> 6) * 2) * 64 + 32 * n + r) * 64 + 8 * hh; const bf16* afr = wfr + 64 * 64;
#pragma unroll
                  for (int ks = 0; ks < 4; ++ks) { const bfx8 bw = *(const bfx8*)(wfr + 16 * ks), ba = *(const bfx8*)(afr + 16 * ks);
                      xw = MFMA32(aW[ks], bw, xw); xa = MFMA32(aA[ks], ba, xa); }
#pragma unroll
                  for (int g = 0; g < 4; ++g) { const int so = (32 * n + r) * 32 + 4 * ((2 * g + hh) ^ (r & 7));
                      *(f32x4*)(LWt + so) = (f32x4){xw[4 * g], xw[4 * g + 1], xw[4 * g + 2], xw[4 * g + 3]};
                      *(f32x4*)(LAt + so) = (f32x4){xa[4 * g], xa[4 * g + 1], xa[4 * g + 2], xa[4 * g + 3]}; } } }
            float lw[32], la[32];
            { const float w0 = P.w0[c], a0 = P.a0[c];
#pragma unroll
              for (int q = 0; q < 8; ++q) { const int so = lane * 32 + 4 * (q ^ (lane & 7)); const f32x4 wv = *(const f32x4*)(LWt + so), av = *(const f32x4*)(LAt + so);
                  lw[4 * q] = wv.x + w0; lw[4 * q + 1] = wv.y + w0; lw[4 * q + 2] = wv.z + w0; lw[4 * q + 3] = wv.w + w0;
                  la[4 * q] = av.x + a0; la[4 * q + 1] = av.y + a0; la[4 * q + 2] = av.z + a0; la[4 * q + 3] = av.w + a0; } }
            float cwC;
            { float cw = 0.f;
#pragma unroll
              for (int i = 0; i < 32; ++i) { cw += -0.6065306597126334f * sigmoidf_(lw[i]); lw[i] = cw; la[i] = sigmoidf_(la[i]); }
              cwC = cw; }
            const float mr = P.mix[c], mk = P.mix[RW + c], mv = P.mix[2 * RW + c], kkw = P.k_k[c], kaw = P.k_a[c], rkw = P.r_k[c];
            const int h = c >> 6, j = c & 63;
            bf16* XS = (bf16*)LWt;
            { const int ln = lane;
              const bf16* src = p + (size_t)(row0 - 1) * NINP + OFF_SB + h * 64 + (ln & 7) * 8;
              u32x4 tv[3][5];
#pragma unroll
              for (int arr = 0; arr < 3; ++arr)
#pragma unroll
                  for (int q = 0; q < 5; ++q) { const int tok = 8 * q + (ln >> 3); tv[arr][q] = (u32x4){0u, 0u, 0u, 0u};
                      if (tok < 33 && (tb + tok) > 0) tv[arr][q] = *(const u32x4*)(src + (size_t)tok * NINP + arr * RW); }
#pragma unroll
              for (int arr = 0; arr < 3; ++arr)
#pragma unroll
                  for (int q = 0; q < 5; ++q) { const int tok = 8 * q + (ln >> 3); if (tok < 33) *(u32x4*)(XS + (tok * 3 + arr) * 64 + (ln & 7) * 8) = tv[arr][q]; } }
            float pr = bf2f(XS[0 * 64 + j]), pk = bf2f(XS[1 * 64 + j]), pv = bf2f(XS[2 * 64 + j]);
            unsigned char* ch = B.CH + (size_t)((b * NH + h) * NCH + chunk) * CH_STRIDE;
            bf16* AT = (bf16*)(ch + CH_AT); bf16* BT = (bf16*)(ch + CH_BT); bf16* KT = (bf16*)(ch + CH_KT); bf16* RT = (bf16*)(ch + CH_RT); bf16* VR = (bf16*)(ch + CH_VR);
            unsigned bhp[16], khp[16], vtp[16];
            float hold_b = 0.f, hold_k = 0.f, hold_v = 0.f;
#pragma unroll
            for (int i = 0; i < 32; ++i) { const float cr = bf2f(XS[(3 * (i + 1) + 0) * 64 + j]), ck = bf2f(XS[(3 * (i + 1) + 1) * 64 + j]), cv = bf2f(XS[(3 * (i + 1) + 2) * 64 + j]);
                const float r = cr + mr * (pr - cr), k = ck + mk * (pk - ck), v = cv + mv * (pv - cv); pr = cr; pk = ck; pv = cv;
                const float av = la[i];
                float kk = k * kkw;
                kk *= __builtin_amdgcn_rcpf(fmaxf(__builtin_amdgcn_sqrtf(wave_sum(kk * kk)), 1e-12f));
                const float km = k * (1.f + (av - 1.f) * kaw);
                const float be = kk * av;
                const float cwi = lw[i], cwp = i > 0 ? lw[i - 1] : 0.f;
                const float em = __expf(-cwi), eh = __expf(cwC - cwi);
                const float c3 = wave_sum(r * km * rkw);
                AT[i * 64 + j] = (bf16)f2bf(-kk * __expf(cwp)); BT[i * 64 + j] = (bf16)f2bf(be * em); KT[i * 64 + j] = (bf16)f2bf(km * em); RT[i * 64 + j] = (bf16)f2bf(r * __expf(cwi)); VR[i * 64 + j] = (bf16)f2bf(v);
                const float bhv = be * eh, khv = km * eh;
                if (i & 1) { bhp[i >> 1] = cvtpk(hold_b, bhv); khp[i >> 1] = cvtpk(hold_k, khv); vtp[i >> 1] = cvtpk(hold_v, v); } else { hold_b = bhv; hold_k = khv; hold_v = v; }
                if (j == 0) ((float*)(ch + CH_C3))[i] = c3; }
            u32x4* BHT = (u32x4*)(ch + CH_BHT + j * 64); u32x4* KHT = (u32x4*)(ch + CH_KHT + j * 64); u32x4* VT = (u32x4*)(ch + CH_VT + j * 64);
#pragma unroll
            for (int q = 0; q < 4; ++q) { BHT[q] = (u32x4){bhp[4 * q], bhp[4 * q + 1], bhp[4 * q + 2], bhp[4 * q + 3]}; KHT[q] = (u32x4){khp[4 * q], khp[4 * q + 1], khp[4 * q + 2], khp[4 * q + 3]};
                VT[q] = (u32x4){vtp[4 * q], vtp[4 * q + 1], vtp[4 * q + 2], vtp[4 * q + 3]}; }
            ((float*)(ch + CH_ECW))[j] = __expf(cwC);
        }
        else {
            asm volatile("s_waitcnt vmcnt(0)" ::: "memory");
            rwkv_stage1((b * NH + (tl_ >> 6)) * NCH + chunk, B, lds + (tl_ >> 6) * 16384);
        }
    }
    asm volatile("s_waitcnt vmcnt(0)" ::: "memory");
    __syncthreads();
}

#define FMAC(acc, a, b) asm("v_fmac_f32 %0, %1, %2" : "+v"(acc) : "v"(a), "v"(b))
template <int N> __device__ __forceinline__ void sub_pin(f32x4* v) {
    if constexpr (N >= 8) { asm volatile("" : "+v"(v[0]), "+v"(v[1]), "+v"(v[2]), "+v"(v[3]), "+v"(v[4]), "+v"(v[5]), "+v"(v[6]), "+v"(v[7]) :: "memory"); sub_pin<N - 8>(v + 8); }
    else if constexpr (N >= 4) { asm volatile("" : "+v"(v[0]), "+v"(v[1]), "+v"(v[2]), "+v"(v[3]) :: "memory"); sub_pin<N - 4>(v + 4); }
    else if constexpr (N >= 2) { asm volatile("" : "+v"(v[0]), "+v"(v[1]) :: "memory"); sub_pin<N - 2>(v + 2); }
    else if constexpr (N == 1) { asm volatile("" : "+v"(v[0]) :: "memory"); }
}
constexpr int sub_nq(int t) { return t <= 31 ? (t + 3) / 4 : 0; }
template <int T0> __device__ __forceinline__ void sub_load(const float* Lf, f32x4 (&l)[16]) {
#pragma unroll
    for (int q = 0; q < sub_nq(T0); ++q) l[q] = *(const f32x4*)(Lf + T0 * 32 + 4 * (q ^ (T0 & 7)));
#pragma unroll
    for (int q = 0; q < sub_nq(T0 + 1); ++q) l[sub_nq(T0) + q] = *(const f32x4*)(Lf + (T0 + 1) * 32 + 4 * (q ^ ((T0 + 1) & 7)));
}
template <int T> __device__ __forceinline__ void sub_row(const f32x4* l, float (&xp)[32], float (&xq)[32]) {
#pragma unroll
    for (int q = 0; q < sub_nq(T); ++q)
#pragma unroll
        for (int e = 0; e < 4; ++e) { const int s = 4 * q + e; if (s < T) { FMAC(xp[T], l[q][e], xp[s]); FMAC(xq[T], l[q][e], xq[s]); } }
}
template <int T0> __device__ __forceinline__ void sub_step(const float* Lf, float (&xp)[32], float (&xq)[32], f32x4 (&cur)[16]) {
    f32x4 nxt[16];
    if constexpr (T0 + 2 <= 31) sub_load<T0 + 2>(Lf, nxt);
    sub_pin<sub_nq(T0) + sub_nq(T0 + 1)>(cur);
    sub_row<T0>(cur, xp, xq);
    if constexpr (T0 + 1 <= 31) sub_row<T0 + 1>(cur + sub_nq(T0), xp, xq);
    if constexpr (T0 + 2 <= 31) sub_step<T0 + 2>(Lf, xp, xq, nxt);
}
__device__ __forceinline__ void rwkv_stage1(int item, const RwcBuf& B, unsigned char* wl  ) {
    const int TID = tidx();
    const int lane = TID & 63, r = lane & 31, h = lane >> 5;
    const unsigned char* ch = B.CH + (size_t)item * CH_STRIDE; unsigned char* o1 = B.O1 + (size_t)item * O_STRIDE;
    float* Lf = (float*)wl;
    bf16* LakB = (bf16*)(wl + 12288);
    float* GT = (float*)(wl + 4096);
    const bf16* AT = (const bf16*)(ch + CH_AT); const bf16* BT = (const bf16*)(ch + CH_BT); const bf16* KT = (const bf16*)(ch + CH_KT); const bf16* RT = (const bf16*)(ch + CH_RT);
    const bf16* VT = (const bf16*)(ch + CH_VT);
    bfx8 fA[4], fB[4], fK[4], fR[4];
#pragma unroll
    for (int ks = 0; ks < 4; ++ks) { const int o = r * 64 + 16 * ks + 8 * h; fA[ks] = *(const bfx8*)(AT + o); fB[ks] = *(const bfx8*)(BT + o); fK[ks] = *(const bfx8*)(KT + o); fR[ks] = *(const bfx8*)(RT + o); }
    bf16* ATs = (bf16*)(wl + 12288);
    u32x4 atv[4];
#pragma unroll
    for (int q = 0; q < 4; ++q) atv[q] = *(const u32x4*)(AT + (lane + 64 * q) * 8);
    const fx16 zero = {};
    { fx16 x = zero;
#pragma unroll
      for (int ks = 0; ks < 4; ++ks) x = MFMA32(fB[ks], fA[ks], x);
#pragma unroll
      for (int g = 0; g < 4; ++g) { f32x4 w;
#pragma unroll
          for (int e = 0; e < 4; ++e) { const int s = 8 * g + 4 * h + e; w[e] = s < r ? x[4 * g + e] : 0.f; }
          *(f32x4*)(Lf + r * 32 + 4 * ((2 * g + h) ^ (r & 7))) = w; } }
    { fx16 x = zero;
#pragma unroll
      for (int ks = 0; ks < 4; ++ks) x = MFMA32(fK[ks], fA[ks], x);
#pragma unroll
      for (int g = 0; g < 4; ++g) { float w[4];
#pragma unroll
          for (int e = 0; e < 4; ++e) { const int s = 8 * g + 4 * h + e; w[e] = s < r ? x[4 * g + e] : 0.f; }
          *(u32x2*)(LakB + r * 32 + 8 * g + 4 * h) = (u32x2){cvtpk(w[0], w[1]), cvtpk(w[2], w[3])}; } }
    { fx16 x = zero, y = zero;
#pragma unroll
      for (int ks = 0; ks < 4; ++ks) { x = MFMA32(fB[ks], fR[ks], x); y = MFMA32(fK[ks], fR[ks], y); }
      bf16* ARB = (bf16*)(o1 + O_ARB); bf16* ARK = (bf16*)(o1 + O_ARK);
#pragma unroll
      for (int g = 0; g < 4; ++g) { float w[4], z[4];
#pragma unroll
          for (int e = 0; e < 4; ++e) { const int s = 8 * g + 4 * h + e; w[e] = s <= r ? x[4 * g + e] : 0.f; z[e] = s <= r ? y[4 * g + e] : 0.f; }
          *(u32x2*)(ARB + r * 32 + 8 * g + 4 * h) = (u32x2){cvtpk(w[0], w[1]), cvtpk(w[2], w[3])}; *(u32x2*)(ARK + r * 32 + 8 * g + 4 * h) = (u32x2){cvtpk(z[0], z[1]), cvtpk(z[2], z[3])}; } }
#pragma unroll
    for (int n = 0; n < 2; ++n) { fx16 x = zero;
#pragma unroll
        for (int ks = 0; ks < 2; ++ks) { const bfx8 a = *(const bfx8*)(LakB + r * 32 + 16 * ks + 8 * h); const bfx8 bb = *(const bfx8*)(VT + (32 * n + r) * 32 + 16 * ks + 8 * h); x = MFMA32(a, bb, x); }
#pragma unroll
        for (int g = 0; g < 4; ++g) *(f32x4*)(GT + (32 * n + r) * 32 + 4 * ((2 * g + h) ^ (r & 7))) = (f32x4){x[4 * g], x[4 * g + 1], x[4 * g + 2], x[4 * g + 3]}; }
#pragma unroll
    for (int q = 0; q < 4; ++q) *(u32x4*)(ATs + (lane + 64 * q) * 8) = atv[q];
    float xp[32], xq[32];
    { unsigned xu[32];
#pragma unroll
      for (int t = 0; t < 32; ++t) xu[t] = ATs[t * 64 + lane];
#pragma unroll
      for (int g = 0; g < 4; ++g) asm volatile("" : "+v"(xu[8 * g]), "+v"(xu[8 * g + 1]), "+v"(xu[8 * g + 2]), "+v"(xu[8 * g + 3]), "+v"(xu[8 * g + 4]), "+v"(xu[8 * g + 5]), "+v"(xu[8 * g + 6]), "+v"(xu[8 * g + 7]));
#pragma unroll
      for (int t = 0; t < 32; ++t) xp[t] = __builtin_bit_cast(float, xu[t] << 16); }
#pragma unroll
    for (int q = 0; q < 8; ++q) { const f32x4 gv = *(const f32x4*)(GT + lane * 32 + 4 * (q ^ (lane & 7))); xq[4 * q] = gv.x; xq[4 * q + 1] = gv.y; xq[4 * q + 2] = gv.z; xq[4 * q + 3] = gv.w; }
    { f32x4 l0[16]; sub_load<1>(Lf, l0); sub_step<1>(Lf, xp, xq, l0); }
    { bf16* Pg = (bf16*)(o1 + O_P);
#pragma unroll
      for (int t = 0; t < 32; ++t) Pg[t * 64 + lane] = (bf16)f2bf(xp[t]);
      u32x4* Qg = (u32x4*)(o1 + O_QT + lane * 64);
#pragma unroll
      for (int q = 0; q < 4; ++q) Qg[q] = (u32x4){cvtpk(xq[8 * q], xq[8 * q + 1]), cvtpk(xq[8 * q + 2], xq[8 * q + 3]), cvtpk(xq[8 * q + 4], xq[8 * q + 5]), cvtpk(xq[8 * q + 6], xq[8 * q + 7])}; }
}

constexpr int S2_P = 0, S2_QT = 4608, S2_BHT = 9728, S2_KHT = 14848, S2_VT = 19968, S2_ECW = 25088, S2_BUF = 25344;
__device__ __forceinline__ void s2_src_dst(int idx, const unsigned char* ch, const unsigned char* o1, const unsigned char*& src, int& dst) {
    if (idx < 256) { src = o1 + O_P + idx * 16; dst = S2_P + (idx >> 3) * 144 + (idx & 7) * 16; }
    else if (idx < 1280) { const int a = (idx - 256) >> 8, j = (idx - 256) & 255;
        src = (a == 0 ? o1 + O_QT : a == 1 ? ch + CH_BHT : a == 2 ? ch + CH_KHT : ch + CH_VT) + j * 16; dst = S2_QT + a * 5120 + (j >> 2) * 80 + (j & 3) * 16; }
    else { src = ch + CH_ECW + (idx - 1280) * 16; dst = S2_ECW + (idx - 1280) * 16; }
}
__device__ __forceinline__ bfx8 cat8(u32x2 lo, u32x2 hi) { return __builtin_bit_cast(bfx8, (u32x4){lo.x, lo.y, hi.x, hi.y}); }
__device__ __forceinline__ void rwkv_stage2(int bh, const RwcBuf& B, unsigned char* ldsb) {
    const int TID = tidx();
    const int lane = TID & 63, wave = TID >> 6, r = lane & 31, h = lane >> 5, n = wave;
    const unsigned char* chb = B.CH + (size_t)bh * NCH * CH_STRIDE; const unsigned char* o1b = B.O1 + (size_t)bh * NCH * O_STRIDE;
    unsigned char* stb = B.ST + (size_t)bh * NCH * ST_STRIDE;
    u32x4 preA[4], preB[4]; preA[0] = preA[1] = preA[2] = preA[3] = preB[0] = preB[1] = preB[2] = preB[3] = (u32x4){0u, 0u, 0u, 0u};
    const int TS = TID - 128;
#define S2_LOAD(R, cc) { _Pragma("unroll") for (int i = 0; i < 4; ++i) { const int idx = TS + 384 * i; if (TS >= 0 && idx < 1296) { const unsigned char* s_; int d_; s2_src_dst(idx, chb + (size_t)(cc) * CH_STRIDE, o1b + (size_t)(cc) * O_STRIDE, s_, d_); R[i] = *(const u32x4*)s_; } } }
#define S2_WRITE(R, bo) { _Pragma("unroll") for (int i = 0; i < 4; ++i) { const int idx = TS + 384 * i; if (TS >= 0 && idx < 1296) { const unsigned char* s_; int d_; s2_src_dst(idx, chb, o1b, s_, d_); *(u32x4*)(ldsb + (bo) + d_) = R[i]; } } }
    S2_LOAD(preA, 0); S2_WRITE(preA, 0);
    S2_LOAD(preB, 1);
    __syncthreads();
    fx16 S[2]; S[0] = fx16{}; S[1] = fx16{};
    int bcur = 0;
    for (int c2 = 0; c2 < NCH; c2 += 2) {
#pragma unroll
        for (int par = 0; par < 2; ++par) { const int c = c2 + par;
        const unsigned char* cur = ldsb + bcur; const int bnxt = bcur == 2 * S2_BUF ? 0 : bcur + S2_BUF;
        if (c + 2 < NCH) { if (par == 0) S2_LOAD(preA, c + 2) else S2_LOAD(preB, c + 2) }
        if (wave < 2) {
            unsigned char* st = stb + (size_t)c * ST_STRIDE;
            bfx8 sb[4];
#pragma unroll
            for (int ks = 0; ks < 4; ++ks) { const fx16& T = S[ks >> 1]; const int o = 8 * (ks & 1);
                sb[ks] = __builtin_bit_cast(bfx8, (u32x4){cvtpk(T[o], T[o + 1]), cvtpk(T[o + 2], T[o + 3]), cvtpk(T[o + 4], T[o + 5]), cvtpk(T[o + 6], T[o + 7])}); }
            { bf16* Sg = (bf16*)(st + ST_S0);
#pragma unroll
              for (int ks = 0; ks < 4; ++ks) { const u32x4 w = __builtin_bit_cast(u32x4, sb[ks]);
                  *(u32x2*)(Sg + (32 * n + r) * 64 + 16 * ks + 4 * h) = (u32x2){w.x, w.y}; *(u32x2*)(Sg + (32 * n + r) * 64 + 16 * ks + 8 + 4 * h) = (u32x2){w.z, w.w}; } }
            fx16 U;
            { const bf16* QTl = (const bf16*)(cur + S2_QT);
#pragma unroll
              for (int g = 0; g < 4; ++g) { const u32x2 q2 = *(const u32x2*)(QTl + (32 * n + r) * 40 + 8 * g + 4 * h); U[4 * g] = bflo(q2.x); U[4 * g + 1] = bfhi(q2.x); U[4 * g + 2] = bflo(q2.y); U[4 * g + 3] = bfhi(q2.y); } }
            { const bf16* Pl = (const bf16*)(cur + S2_P);
#pragma unroll
              for (int ks = 0; ks < 4; ++ks) { const bfx8 pa = cat8(*(const u32x2*)(Pl + r * 72 + 16 * ks + 4 * h), *(const u32x2*)(Pl + r * 72 + 16 * ks + 8 + 4 * h)); U = MFMA32(pa, sb[ks], U); } }
            bfx8 ub[2];
#pragma unroll
            for (int ks = 0; ks < 2; ++ks) { const int o = 8 * ks; ub[ks] = __builtin_bit_cast(bfx8, (u32x4){cvtpk(U[o], U[o + 1]), cvtpk(U[o + 2], U[o + 3]), cvtpk(U[o + 4], U[o + 5]), cvtpk(U[o + 6], U[o + 7])}); }
            { bf16* Ug = (bf16*)(st + ST_UT);
#pragma unroll
              for (int ks = 0; ks < 2; ++ks) { const u32x4 w = __builtin_bit_cast(u32x4, ub[ks]);
                  *(u32x2*)(Ug + (32 * n + r) * 32 + 16 * ks + 4 * h) = (u32x2){w.x, w.y}; *(u32x2*)(Ug + (32 * n + r) * 32 + 16 * ks + 8 + 4 * h) = (u32x2){w.z, w.w}; } }
            const bf16* BHl = (const bf16*)(cur + S2_BHT); const bf16* KHl = (const bf16*)(cur + S2_KHT); const bf16* VTl = (const bf16*)(cur + S2_VT); const float* El = (const float*)(cur + S2_ECW);
            bfx8 vb[2];
#pragma unroll
            for (int ks = 0; ks < 2; ++ks) vb[ks] = *(const bfx8*)(VTl + (32 * n + r) * 40 + 16 * ks + 8 * h);
#pragma unroll
            for (int m = 0; m < 2; ++m) { fx16 acc;
#pragma unroll
                for (int g = 0; g < 4; ++g) { const f32x4 e4 = *(const f32x4*)(El + 32 * m + 8 * g + 4 * h); acc[4 * g] = S[m][4 * g] * e4.x; acc[4 * g + 1] = S[m][4 * g + 1] * e4.y; acc[4 * g + 2] = S[m][4 * g + 2] * e4.z; acc[4 * g + 3] = S[m][4 * g + 3] * e4.w; }
#pragma unroll
                for (int ks = 0; ks < 2; ++ks) { const bfx8 ba = cat8(*(const u32x2*)(BHl + (32 * m + r) * 40 + 16 * ks + 4 * h), *(const u32x2*)(BHl + (32 * m + r) * 40 + 16 * ks + 8 + 4 * h));
                    const bfx8 ka = *(const bfx8*)(KHl + (32 * m + r) * 40 + 16 * ks + 8 * h);
                    acc = MFMA32(ba, ub[ks], acc); acc = MFMA32(ka, vb[ks], acc); }
                S[m] = acc; }
        }
        if (c + 1 < NCH) { if (par == 0) S2_WRITE(preB, bnxt) else S2_WRITE(preA, bnxt) }
        __syncthreads();
        bcur = bnxt; }
    }
#undef S2_LOAD
#undef S2_WRITE
}

__device__ __forceinline__ void rwkv_stage3(int item, const bf16* __restrict__ p, const RwkvP& P, const RwcBuf& B, bf16* ybuf, unsigned char* wl) {
    const int TID = tidx();
    const int lane = TID & 63, r = lane & 31, h = lane >> 5;
    const int bh = item / NCH, chunk = item % NCH, b = bh / NH, hd = bh % NH;
    const unsigned char* ch = B.CH + (size_t)item * CH_STRIDE; const unsigned char* o1 = B.O1 + (size_t)item * O_STRIDE; const unsigned char* st = B.ST + (size_t)item * ST_STRIDE;
    const bf16* Sg = (const bf16*)(st + ST_S0); const bf16* UT = (const bf16*)(st + ST_UT);
    float* Yf = (float*)wl;
    const bf16* ARB = (const bf16*)(o1 + O_ARB); const bf16* ARK = (const bf16*)(o1 + O_ARK);
    const bf16* RT = (const bf16*)(ch + CH_RT); const bf16* VT = (const bf16*)(ch + CH_VT); const bf16* VR = (const bf16*)(ch + CH_VR);
    bfx8 fR[4], fArb[2], fArk[2], sbf[2][4], ubf[2][2], vbf[2][2];
#pragma unroll
    for (int ks = 0; ks < 4; ++ks) fR[ks] = *(const bfx8*)(RT + r * 64 + 16 * ks + 8 * h);
#pragma unroll
    for (int ks = 0; ks < 2; ++ks) { fArb[ks] = *(const bfx8*)(ARB + r * 32 + 16 * ks + 8 * h); fArk[ks] = *(const bfx8*)(ARK + r * 32 + 16 * ks + 8 * h); }
#pragma unroll
    for (int n = 0; n < 2; ++n) {
#pragma unroll
        for (int ks = 0; ks < 4; ++ks) sbf[n][ks] = *(const bfx8*)(Sg + (32 * n + r) * 64 + 16 * ks + 8 * h);
#pragma unroll
        for (int ks = 0; ks < 2; ++ks) { ubf[n][ks] = *(const bfx8*)(UT + (32 * n + r) * 32 + 16 * ks + 8 * h); vbf[n][ks] = *(const bfx8*)(VT + (32 * n + r) * 32 + 16 * ks + 8 * h); } }
#pragma unroll
    for (int n = 0; n < 2; ++n) { fx16 y = {};
#pragma unroll
        for (int ks = 0; ks < 4; ++ks) y = MFMA32(fR[ks], sbf[n][ks], y);
#pragma unroll
        for (int ks = 0; ks < 2; ++ks) { y = MFMA32(fArb[ks], ubf[n][ks], y); y = MFMA32(fArk[ks], vbf[n][ks], y); }
#pragma unroll
        for (int reg = 0; reg < 16; ++reg) Yf[crow16(reg, h) * 68 + 32 * n + r] = y[reg]; }
    { const int t = lane >> 1, hf = lane & 1; const float* yr = Yf + t * 68 + 32 * hf; float yv[32]; float s = 0.f;
#pragma unroll
      for (int q = 0; q < 8; ++q) { const f32x4 v4 = *(const f32x4*)(yr + 4 * q); yv[4 * q] = v4.x; yv[4 * q + 1] = v4.y; yv[4 * q + 2] = v4.z; yv[4 * q + 3] = v4.w; s += (v4.x + v4.y) + (v4.z + v4.w); }
      s += dpp0<0xB1, 0xf>(s); const float mu = s * (1.f / 64.f); float q2 = 0.f;
#pragma unroll
      for (int i = 0; i < 32; ++i) { yv[i] -= mu; q2 += yv[i] * yv[i]; }
      q2 += dpp0<0xB1, 0xf>(q2); const float rstd = rsqrtf(q2 * (1.f / 64.f) + 64e-5f);
      const float c3 = ((const float*)(ch + CH_C3))[t];
      const size_t row = (size_t)(b * SEQ + chunk * RC + t); const int c0 = hd * HD + 32 * hf;
      const u32x4* vr = (const u32x4*)(VR + t * 64 + 32 * hf); const u32x4* gp = (const u32x4*)(p + row * NINP + OFF_GB + c0); u32x4* yo = (u32x4*)(ybuf + row * DM + LRU_W + c0);
      const f32x4* lwp = (const f32x4*)(P.ln_w + c0); const f32x4* lbp = (const f32x4*)(P.ln_b + c0);
      u32x4 vvq[4], ggq[4]; f32x4 lwq[8], lbq[8];
#pragma unroll
      for (int q = 0; q < 4; ++q) { vvq[q] = vr[q]; ggq[q] = gp[q]; lwq[2 * q] = lwp[2 * q]; lwq[2 * q + 1] = lwp[2 * q + 1]; lbq[2 * q] = lbp[2 * q]; lbq[2 * q + 1] = lbp[2 * q + 1]; }
      asm volatile("" : "+v"(vvq[0]), "+v"(vvq[1]), "+v"(vvq[2]), "+v"(vvq[3]), "+v"(ggq[0]), "+v"(ggq[1]), "+v"(ggq[2]), "+v"(ggq[3]));
      asm volatile("" : "+v"(lwq[0]), "+v"(lwq[1]), "+v"(lwq[2]), "+v"(lwq[3]), "+v"(lwq[4]), "+v"(lwq[5]), "+v"(lwq[6]), "+v"(lwq[7]));
      asm volatile("" : "+v"(lbq[0]), "+v"(lbq[1]), "+v"(lbq[2]), "+v"(lbq[3]), "+v"(lbq[4]), "+v"(lbq[5]), "+v"(lbq[6]), "+v"(lbq[7]));
#pragma unroll
      for (int q = 0; q < 4; ++q) { const u32x4 vv = vvq[q], gg = ggq[q]; const f32x4 w0 = lwq[2 * q], w1 = lwq[2 * q + 1], b0 = lbq[2 * q], b1 = lbq[2 * q + 1]; u32x4 o;
          const float wv[8] = {w0.x, w0.y, w0.z, w0.w, w1.x, w1.y, w1.z, w1.w}, bv[8] = {b0.x, b0.y, b0.z, b0.w, b1.x, b1.y, b1.z, b1.w};
#pragma unroll
          for (int e = 0; e < 4; ++e) { const float v0 = bflo(vv[e]), v1 = bfhi(vv[e]), g0 = bflo(gg[e]), g1 = bfhi(gg[e]);
              const float y0 = yv[8 * q + 2 * e] * rstd * wv[2 * e] + bv[2 * e] + c3 * v0, y1 = yv[8 * q + 2 * e + 1] * rstd * wv[2 * e + 1] + bv[2 * e + 1] + c3 * v1;
              o[e] = cvtpk(y0 * siluf_(g0), y1 * siluf_(g1)); }
          yo[q] = o; } }
}


__device__ __forceinline__ void phase_moba_kmean(const bf16* p, float* kmean, int vbid, int vgrid) {
    const int TID = tidx();
    const int lane = TID & 63, wave = TID >> 6;
    for (int item = vbid * NWAVES + wave; item < NB * NH * NBLK; item += vgrid * NWAVES) {
        const int n = item % NBLK, bh = item / NBLK, b = bh / NH, h = bh % NH;
        const bf16* kp = p + (size_t)(b * SEQ + n * BLK + (lane >> 3)) * NINP + OFF_QKV + MOW + h * HD + (lane & 7) * 8;
        float s[8];
#pragma unroll
        for (int e = 0; e < 8; ++e) s[e] = 0.f;
#pragma unroll
        for (int half = 0; half < 2; ++half) { u32x4 v[16];
#pragma unroll
            for (int q = 0; q < 16; ++q) v[q] = *(const u32x4*)(kp + (size_t)(8 * (16 * half + q)) * NINP);
#pragma unroll
            for (int q = 0; q < 16; ++q)
#pragma unroll
                for (int e = 0; e < 4; ++e) { s[2 * e] += bflo(v[q][e]); s[2 * e + 1] += bfhi(v[q][e]); } }
#pragma unroll
        for (int e = 0; e < 8; ++e) { s[e] += dpp0<0x128, 0xf>(s[e]);
            s[e] += __builtin_bit_cast(float, __builtin_amdgcn_ds_swizzle(__builtin_bit_cast(int, s[e]), 0x401F));
            float a_ = s[e], b_ = s[e]; asm volatile("s_nop 1\n\tv_permlane32_swap_b32 %0, %1" : "+v"(a_), "+v"(b_)); s[e] = a_ + b_; }
        if (lane < 8) { float* dst = kmean + ((size_t)bh * NBLK + n) * HD + lane * 8;
            *(f32x4*)dst = (f32x4){s[0], s[1], s[2], s[3]} * (1.f / BLK); *(f32x4*)(dst + 4) = (f32x4){s[4], s[5], s[6], s[7]} * (1.f / BLK); }
    }
}
namespace attn_body {
using bf16=__hip_bfloat16;
using bf16x8=__attribute__((ext_vector_type(8)))short;
using s16x4=__attribute__((ext_vector_type(4)))short;
using f32x16=__attribute__((ext_vector_type(16)))float;
using u32x4=__attribute__((ext_vector_type(4)))unsigned;
using f32x4v=__attribute__((ext_vector_type(4)))float;
constexpr int BATCH=2,NHEAD=12,SEQ=4096,D=64,DM=7424;
constexpr int YP=2048, QCOL=4224, KCOL=4224+768, VCOL=4224+1536, GCOL=6528, YCOL=1280;
constexpr int NW=8,QBLK=32,QB=QBLK*NW,KVBLK=64,NQB=SEQ/QB;
constexpr int ATTN_PITCH=DM, ATTN_UNIT_ROWS=QB;
__device__ __forceinline__ int crow(int r,int hi){return (r&3)+8*(r>>2)+4*hi;}
#define SBAR() __builtin_amdgcn_sched_barrier(0)
__device__ __forceinline__ void moba_hook(f32x16&p0,f32x16&p1,int t,int NT,int qrel,int hi,unsigned selbits,const float*tab){
  const float NEG=-INFINITY;
  asm volatile("":"+v"(qrel));
  const int jb=t-(NT-4);
  if(t>=NT-6){
    const bool keep=jb>=0?true:(((selbits>>(t>>2))&1u)!=0u);
    const int dq=qrel-64*jb-4*hi;
    #pragma unroll
    for(int g=0;g<4;++g){
      #pragma unroll
      for(int rr=0;rr<4;++rr){ const int r=4*g+rr; const int d0=dq-((r&3)+8*(r>>2)), d1=d0-32;
        const int i0=d0<0?0:(d0<127?d0:127), i1=d1<0?0:(d1<127?d1:127);
        const float b0=tab[i0], b1=tab[i1];
        p0[r]=(keep&&d0>=0)?p0[r]+b0:NEG; p1[r]=(keep&&d1>=0)?p1[r]+b1:NEG; }
      asm volatile("":"+v"(p0),"+v"(p1)); SBAR();
    }
  } else {
    const bool keep=(selbits>>(t>>2))&1u;
    #pragma unroll
    for(int r=0;r<16;++r){p0[r]=keep?p0[r]:NEG; p1[r]=keep?p1[r]:NEG;}
  }
}
__device__ __forceinline__ void swap32(float&a,float&b){asm volatile("s_nop 1\n\tv_permlane32_swap_b32 %0, %1":"+v"(a),"+v"(b));}

constexpr int NSLOT=3, SLOTB=8192;
constexpr int LDS_K=0, LDS_V=NSLOT*SLOTB, LDS_WS=2*NSLOT*SLOTB, LDS_OST=LDS_WS+NW*64*4, LDS_TAB=LDS_OST+NW*4096, LDS_BYTES=LDS_TAB+512;
constexpr float C2=0.125f*1.4426950408889634f;
__device__ __forceinline__ void glds16(const void*gsrc,unsigned lds_dst){unsigned keep;
  asm volatile("s_mov_b32 %0, m0\n\ts_mov_b32 m0, %2\n\ts_nop 0\n\tglobal_load_lds_dwordx4 %1, off\n\ts_mov_b32 m0, %0":"=&s"(keep):"v"(gsrc),"s"(lds_dst):"memory");}
__device__ __forceinline__ float max3f(float a,float b,float c){float r;asm("v_max3_f32 %0, %1, %2, %3":"=v"(r):"v"(a),"v"(b),"v"(c));return r;}
__device__ __forceinline__ float max2f(float a,float b){float r;asm("v_max_f32_e32 %0, %1, %2":"=v"(r):"v"(a),"v"(b));return r;}
__device__ __forceinline__ float fadd_s(float a,float b){float r;asm("v_add_f32_e32 %0, %1, %2":"=v"(r):"v"(a),"v"(b));return r;}
__device__ __forceinline__ float fsub_s(float a,float b){float r;asm("v_sub_f32_e32 %0, %1, %2":"=v"(r):"v"(a),"v"(b));return r;}
typedef float f32x2_t __attribute__((ext_vector_type(2))); typedef __bf16 bf16x2_t __attribute__((ext_vector_type(2)));
__device__ __forceinline__ unsigned cvtpk_s(float lo,float hi){f32x2_t v={lo,hi};bf16x2_t b=__builtin_convertvector(v,bf16x2_t);return __builtin_bit_cast(unsigned,b);}
#define WAIT_BAR(N) asm volatile("s_waitcnt vmcnt(" #N ") lgkmcnt(0)\n\ts_barrier":::"memory")

__device__ __forceinline__ void qkt(f32x16&p0,f32x16&p1,const char*Kslot,const bf16x8*qr,const f32x16&negm,int r32,int hi){
  const char*kb=Kslot+hi*1024+r32*16;
  #pragma unroll
  for(int d0=0;d0<4;++d0){
    const bf16x8 b0=*reinterpret_cast<const bf16x8*>(kb+d0*2048);
    const bf16x8 b1=*reinterpret_cast<const bf16x8*>(kb+d0*2048+512);
    if(d0==0){p0=__builtin_amdgcn_mfma_f32_32x32x16_bf16(b0,qr[0],negm,0,0,0);p1=__builtin_amdgcn_mfma_f32_32x32x16_bf16(b1,qr[0],negm,0,0,0);}
    else{p0=__builtin_amdgcn_mfma_f32_32x32x16_bf16(b0,qr[d0],p0,0,0,0);p1=__builtin_amdgcn_mfma_f32_32x32x16_bf16(b1,qr[d0],p1,0,0,0);}}
}
typedef __attribute__((address_space(3))) const char* lds_cptr;
typedef short v4i16_t __attribute__((ext_vector_type(4)));
__device__ __forceinline__ void kload8(bf16x8*kf,lds_cptr kp){
  kf[0]=*(const __attribute__((address_space(3))) bf16x8*)(kp);      kf[1]=*(const __attribute__((address_space(3))) bf16x8*)(kp+512);
  kf[2]=*(const __attribute__((address_space(3))) bf16x8*)(kp+2048); kf[3]=*(const __attribute__((address_space(3))) bf16x8*)(kp+2560);
  kf[4]=*(const __attribute__((address_space(3))) bf16x8*)(kp+4096); kf[5]=*(const __attribute__((address_space(3))) bf16x8*)(kp+4608);
  kf[6]=*(const __attribute__((address_space(3))) bf16x8*)(kp+6144); kf[7]=*(const __attribute__((address_space(3))) bf16x8*)(kp+6656);
}
__device__ __forceinline__ void kload2(bf16x8*kf,lds_cptr kp,int j){ kf[2*j]=*(const __attribute__((address_space(3))) bf16x8*)(kp+j*2048); kf[2*j+1]=*(const __attribute__((address_space(3))) bf16x8*)(kp+j*2048+512); }
__device__ __forceinline__ s16x4 vtr(lds_cptr p){ return __builtin_bit_cast(s16x4,__builtin_amdgcn_ds_read_tr16_b64_v4i16((__attribute__((address_space(3))) v4i16_t*)p)); }
__device__ __forceinline__ float rowmax(const f32x16&p0,const f32x16&p1){
  float a=max3f(p0[0],p0[1],p1[0]),b=max3f(p0[2],p0[3],p1[1]);a=max3f(a,p1[2],p1[3]);
  #pragma unroll
  for(int r=4;r<16;r+=4){a=max3f(a,p0[r],p0[r+1]);b=max3f(b,p0[r+2],p0[r+3]);a=max3f(a,p1[r],p1[r+1]);b=max3f(b,p1[r+2],p1[r+3]);}
  float m=max2f(a,b), m2=m; swap32(m,m2);
  return max2f(m,m2);
}
__device__ __forceinline__ void pv(f32x16*o,int vb,bf16x8 pa0,bf16x8 pa1,bf16x8 pa2,bf16x8 pa3){
  #pragma unroll
  for(int d0=0;d0<2;++d0){s16x4 lo[4],hi[4];
    #pragma unroll
    for(int ks=0;ks<4;++ks){
      asm volatile("ds_read_b64_tr_b16 %0,%1 offset:%c2":"=&v"(lo[ks]):"v"(vb),"i"(d0*4096+ks*1024):"memory");
      asm volatile("ds_read_b64_tr_b16 %0,%1 offset:%c2":"=&v"(hi[ks]):"v"(vb),"i"(d0*4096+ks*1024+512):"memory");}
    asm volatile("s_waitcnt lgkmcnt(0)":::"memory");SBAR();
    #define PK(k) (bf16x8){lo[k][0],lo[k][1],lo[k][2],lo[k][3],hi[k][0],hi[k][1],hi[k][2],hi[k][3]}
    o[d0]=__builtin_amdgcn_mfma_f32_32x32x16_bf16(pa0,PK(0),o[d0],0,0,0);
    o[d0]=__builtin_amdgcn_mfma_f32_32x32x16_bf16(pa1,PK(1),o[d0],0,0,0);
    o[d0]=__builtin_amdgcn_mfma_f32_32x32x16_bf16(pa2,PK(2),o[d0],0,0,0);
    o[d0]=__builtin_amdgcn_mfma_f32_32x32x16_bf16(pa3,PK(3),o[d0],0,0,0);
    #undef PK
  }
}

#ifndef ATTN_STORE16
#define ATTN_STORE16(p,v) (*(u32x4*)(p)=(v))
#endif
template<int THRL> __device__ __forceinline__ void attn_unit(int b,int h,int qb,const bf16*__restrict__ Pq,const float*__restrict__ kmean_bh,const float*__restrict__ rel_bias,bf16*__restrict__ Yo,char*shm){
  int tid_=threadIdx.x; asm volatile("":"+v"(tid_)); const int tid=tid_,lane=tid&63,r32=lane&31,hi=lane>>5; const int wid=__builtin_amdgcn_readfirstlane(tid>>6);
  const long rowbase=(long)b*SEQ; const int q0=qb*QB;
  const bf16*Qw=Pq+(rowbase+q0+wid*QBLK)*DM+QCOL+h*D;
  const bf16*Kh=Pq+rowbase*DM+KCOL+h*D,*Vh=Pq+rowbase*DM+VCOL+h*D;
  float*tab=(float*)(shm+LDS_TAB);
  const unsigned lds0=(unsigned)(uintptr_t)shm;
  float*wsf=(float*)(shm+LDS_WS)+wid*64;
  const bf16*ksrc=Kh+(long)lane*DM+wid*8;
  const bf16*vsrc=Vh+(long)(16*(wid&3)+(lane>>2))*DM+(wid>>2)*32+(lane&3)*8;
  const unsigned kdst=lds0+LDS_K+wid*1024, vdst=lds0+LDS_V+wid*1024;
  #define DMA_K(t,slot) glds16(ksrc+(long)(t)*KVBLK*DM,(unsigned)__builtin_amdgcn_readfirstlane(kdst+(slot)))
  #define DMA_V(t,slot) glds16(vsrc+(long)(t)*KVBLK*DM,(unsigned)__builtin_amdgcn_readfirstlane(vdst+(slot)))
  const int vb0=(int)(lds0+LDS_V)+((lane>>4)&1)*32+(lane&3)*8+(4*hi+((lane&15)>>2))*64;
  const char*Kbase=shm+LDS_K; bf16x8 kf[8];
  const lds_cptr shm3=(lds_cptr)shm; const lds_cptr kp0=shm3+LDS_K+hi*1024+r32*16; const lds_cptr vp0=shm3+LDS_V+((lane>>4)&1)*32+(lane&3)*8+(4*hi+((lane&15)>>2))*64;
  const int NT=(q0+QB)/KVBLK;
  DMA_K(0,0);DMA_V(0,0);DMA_K(1,SLOTB);
  bf16x8 qr[4];
  #pragma unroll
  for(int d0=0;d0<4;++d0)qr[d0]=*reinterpret_cast<const bf16x8*>(&Qw[(long)r32*DM+d0*16+hi*8]);
  if(tid<128){ const int n=tid; int bk=n; if(n>=16){ bk=16+(int)(logf((float)n/16.f)/2.0794415416798357f*16.f); bk=bk<31?bk:31; }
    tab[n]=(rel_bias[bk*NHEAD+h]-rel_bias[31*NHEAD+h])*1.4426950408889634f; }
  unsigned selbits=0u;
  { float qf[32];
    #pragma unroll
    for(int d0=0;d0<4;++d0){
      #pragma unroll
      for(int j=0;j<8;++j)qf[8*d0+j]=__uint_as_float(((unsigned)(unsigned short)qr[d0][j])<<16); }
    int s0=-1,s1=-1,s2=-1; float g0=-INFINITY,g1=-INFINITY,g2=-INFINITY;
    for(int n=0;n<qb;++n){ const float*km=kmean_bh+n*64+8*hi; float g=0.f;
      #pragma unroll
      for(int d0=0;d0<4;++d0){ const f32x4v k0=*(const f32x4v*)(km+16*d0), k1=*(const f32x4v*)(km+16*d0+4);
        g+=qf[8*d0+0]*k0[0]+qf[8*d0+1]*k0[1]+qf[8*d0+2]*k0[2]+qf[8*d0+3]*k0[3]+qf[8*d0+4]*k1[0]+qf[8*d0+5]*k1[1]+qf[8*d0+6]*k1[2]+qf[8*d0+7]*k1[3]; }
      float g_=g; swap32(g,g_); g=g+g_;
      if(g>g0){g2=g1;s2=s1;g1=g0;s1=s0;g0=g;s0=n;} else if(g>g1){g2=g1;s2=s1;g1=g;s1=n;} else if(g>g2){g2=g;s2=n;} }
    if(s0>=0)selbits|=1u<<s0; if(s1>=0)selbits|=1u<<s1; if(s2>=0)selbits|=1u<<s2; }
  float mhat=0.f,l_reg=0.f;f32x16 o[2];o[0]=f32x16{};o[1]=f32x16{};f32x16 negm=f32x16{};asm volatile("":"+v"(negm));
  const int qrel=wid*QBLK+r32;
  #define CMASK(P0,P1,t) moba_hook(P0,P1,t,NT,qrel,hi,selbits,tab)
  bool resc=false;
  #define START(P0,P1) do{ const float rm=rowmax(P0,P1); resc=false; \
    { const float dl=rm<-1e30f?-1024.f:rm; mhat=fadd_s(mhat,dl); \
      _Pragma("unroll") for(int r=0;r<16;++r){P0[r]=fsub_s(P0[r],dl);P1[r]=fsub_s(P1[r],dl);} \
      _Pragma("unroll") for(int r=0;r<16;++r)negm[r]=-mhat; asm volatile("":"+v"(negm)); } \
    _Pragma("unroll") for(int r=0;r<16;++r)P0[r]=__builtin_amdgcn_exp2f(P0[r]); }while(0)
  #define RESC() do{ if(resc){ asm volatile("s_waitcnt lgkmcnt(0)":::"memory"); \
      _Pragma("unroll") for(int d_=0;d_<2;++d_) _Pragma("unroll") for(int r=0;r<16;++r)o[d_][r]*=wsf[crow(r,hi)]; } }while(0)
  f32x16 pA0,pA1,pB0,pB1;
  int sl_prev=0,sl_cur=0,sl_next=SLOTB;
  #define ROT() do{sl_prev=sl_cur;sl_cur=sl_next;sl_next=(sl_next==(NSLOT-1)*SLOTB)?0:sl_next+SLOTB;}while(0)
  DMA_K(2,2*SLOTB);
  WAIT_BAR(3);
  qkt(pA0,pA1,Kbase,qr,negm,r32,hi);asm volatile("s_nop 15\n\ts_nop 7":"+v"(pA0),"+v"(pA1));CMASK(pA0,pA1,0);
  START(pA0,pA1);
  _Pragma("unroll") for(int r=0;r<16;++r)pA1[r]=__builtin_amdgcn_exp2f(pA1[r]);
  WAIT_BAR(0);
  DMA_K(3,0);DMA_V(1,SLOTB);
  ROT();
  kload8(kf,kp0+sl_cur);
  WAIT_BAR(2);
  s16x4 vlo[8],vhi[8]; u32x4 pw0,pw1,pw2,pw3;
  #define PKW(P,B) cvtpk_s(P[B],P[B+1])
  #define PAF(k) __builtin_bit_cast(bf16x8,pw##k)
  #define VFR(i) (bf16x8){vlo[i][0],vlo[i][1],vlo[i][2],vlo[i][3],vhi[i][0],vhi[i][1],vhi[i][2],vhi[i][3]}
  #define PIN(x) asm volatile("":"+v"(x))
  #define MX3(a,b,c) __builtin_fmaxf(__builtin_fmaxf((a),(b)),(c))
  #define GAPA(MF,A0,A1,A2,A3,W0,W1,PW) do{ MF; sacc+=A0; sacc+=A1; sacc+=A2; sacc+=A3; PIN(sacc); W0; W1; PIN(PW); SBAR(); }while(0)
  #define EX(v) __builtin_amdgcn_exp2f(v)
  #define GAPB(MF,X,B) do{ MF; X[B]=EX(X[B]); X[B+1]=EX(X[B+1]); X[B+2]=EX(X[B+2]); X[B+3]=EX(X[B+3]); PIN(X); SBAR(); }while(0)
  #define VRD(i) do{ vlo[i]=vtr(vp_+(((i)>>2)*4096+((i)&3)*1024)); vhi[i]=vtr(vp_+(((i)>>2)*4096+((i)&3)*1024+512)); }while(0)
  #define KRD(G,j) do{ if(G){ kload2(kf,kp0+sl_next,j); SBAR(); } }while(0)
  #define STEP(C0,C1,P0,P1,t,GK,GV,GL) do{ SBAR(); \
    const lds_cptr vp_=vp0+sl_prev; \
    VRD(0); SBAR(); float sacc=(P0[0]+P0[1]); \
    GAPA(C0=__builtin_amdgcn_mfma_f32_32x32x16_bf16(kf[0],qr[0],negm,0,0,0), P0[2],P0[3],P0[4],P0[5],     pw0[0]=PKW(P0,0), pw0[1]=PKW(P0,2), pw0); \
    VRD(4); SBAR(); GAPA(C1=__builtin_amdgcn_mfma_f32_32x32x16_bf16(kf[1],qr[0],negm,0,0,0), P0[6],P0[7],P0[8],P0[9],     pw0[2]=PKW(P0,4), pw0[3]=PKW(P0,6), pw0); \
    VRD(1); SBAR(); GAPA(C0=__builtin_amdgcn_mfma_f32_32x32x16_bf16(kf[2],qr[1],C0,0,0,0),   P0[10],P0[11],P0[12],P0[13], pw1[0]=PKW(P0,8), pw1[1]=PKW(P0,10), pw1); \
    VRD(5); SBAR(); GAPA(C1=__builtin_amdgcn_mfma_f32_32x32x16_bf16(kf[3],qr[1],C1,0,0,0),   P0[14],P0[15],P1[0],P1[1],   pw1[2]=PKW(P0,12),pw1[3]=PKW(P0,14), pw1); \
    VRD(2); SBAR(); GAPA(C0=__builtin_amdgcn_mfma_f32_32x32x16_bf16(kf[4],qr[2],C0,0,0,0),   P1[2],P1[3],P1[4],P1[5],     pw2[0]=PKW(P1,0), pw2[1]=PKW(P1,2), pw2); \
    VRD(6); SBAR(); GAPA(C1=__builtin_amdgcn_mfma_f32_32x32x16_bf16(kf[5],qr[2],C1,0,0,0),   P1[6],P1[7],P1[8],P1[9],     pw2[2]=PKW(P1,4), pw2[3]=PKW(P1,6), pw2); \
    VRD(3); SBAR(); GAPA(C0=__builtin_amdgcn_mfma_f32_32x32x16_bf16(kf[6],qr[3],C0,0,0,0),   P1[10],P1[11],P1[12],P1[13], pw3[0]=PKW(P1,8), pw3[1]=PKW(P1,10), pw3); \
    VRD(7); SBAR(); GAPA(C1=__builtin_amdgcn_mfma_f32_32x32x16_bf16(kf[7],qr[3],C1,0,0,0),   P1[14],P1[15],0.f,0.f,       pw3[2]=PKW(P1,12),pw3[3]=PKW(P1,14), pw3); \
    l_reg+=sacc; \
    if(GK){DMA_K((t)+3,sl_cur);} if(GV){DMA_V((t)+1,sl_next);} \
    CMASK(C0,C1,t); \
    { float a=MX3(C0[0],C0[1],C1[0]),b=MX3(C0[2],C0[3],C1[1]); a=MX3(a,C1[2],C1[3]); \
      _Pragma("unroll") for(int r=4;r<16;r+=4){a=MX3(a,C0[r],C0[r+1]);b=MX3(b,C0[r+2],C0[r+3]);a=MX3(a,C1[r],C1[r+1]);b=MX3(b,C1[r+2],C1[r+3]);} \
      float rm=__builtin_fmaxf(a,b); { float rm2_=rm; swap32(rm,rm2_); rm=__builtin_fmaxf(rm,rm2_); } \
      resc=false; \
      if(__builtin_expect(__any(rm>(float)THRL),0)){ const float dl=__builtin_fmaxf(rm,0.f); mhat+=dl; \
        _Pragma("unroll") for(int r=0;r<16;++r){C0[r]-=dl;C1[r]-=dl;} \
        _Pragma("unroll") for(int r=0;r<16;++r)negm[r]=-mhat; asm volatile("":"+v"(negm)); \
        const float f=__builtin_amdgcn_exp2f(-dl); l_reg*=f; if(hi==0)wsf[r32]=f; resc=true; } } \
    SBAR(); \
    GAPB(o[0]=__builtin_amdgcn_mfma_f32_32x32x16_bf16(PAF(0),VFR(0),o[0],0,0,0), C0,0); \
    GAPB(o[1]=__builtin_amdgcn_mfma_f32_32x32x16_bf16(PAF(0),VFR(4),o[1],0,0,0), C0,4); \
    KRD(GL,0); GAPB(o[0]=__builtin_amdgcn_mfma_f32_32x32x16_bf16(PAF(1),VFR(1),o[0],0,0,0), C0,8); \
    KRD(GL,1); GAPB(o[1]=__builtin_amdgcn_mfma_f32_32x32x16_bf16(PAF(1),VFR(5),o[1],0,0,0), C0,12); \
    KRD(GL,2); GAPB(o[0]=__builtin_amdgcn_mfma_f32_32x32x16_bf16(PAF(2),VFR(2),o[0],0,0,0), C1,0); \
    KRD(GL,3); GAPB(o[1]=__builtin_amdgcn_mfma_f32_32x32x16_bf16(PAF(2),VFR(6),o[1],0,0,0), C1,4); \
    GAPB(o[0]=__builtin_amdgcn_mfma_f32_32x32x16_bf16(PAF(3),VFR(3),o[0],0,0,0), C1,8); \
    GAPB(o[1]=__builtin_amdgcn_mfma_f32_32x32x16_bf16(PAF(3),VFR(7),o[1],0,0,0), C1,12); \
    }while(0)
  int t=1;
  for(;t+5<NT;t+=2){
    STEP(pB0,pB1,pA0,pA1,t,true,true,true);     WAIT_BAR(2); RESC(); ROT();
    STEP(pA0,pA1,pB0,pB1,t+1,true,true,true);   WAIT_BAR(2); RESC(); ROT();
  }
  #define ENDW(tt) do{ if((tt)+3<NT){WAIT_BAR(2);} else if((tt)+2<NT){WAIT_BAR(1);} else {WAIT_BAR(0);} }while(0)
  for(;t+1<NT;t+=2){
    STEP(pB0,pB1,pA0,pA1,t,(t+3<NT),(t+1<NT),(t+1<NT));       ENDW(t);   RESC(); ROT();
    STEP(pA0,pA1,pB0,pB1,t+1,(t+4<NT),(t+2<NT),(t+2<NT));     ENDW(t+1); RESC(); ROT();
  }
  STEP(pB0,pB1,pA0,pA1,NT-1,false,false,false); RESC();
  { float sacc=pB0[0]+pB0[1]; _Pragma("unroll") for(int r=2;r<16;++r)sacc+=pB0[r]; _Pragma("unroll") for(int r=0;r<16;++r)sacc+=pB1[r]; l_reg+=sacc;
    pw0=(u32x4){PKW(pB0,0),PKW(pB0,2),PKW(pB0,4),PKW(pB0,6)};pw1=(u32x4){PKW(pB0,8),PKW(pB0,10),PKW(pB0,12),PKW(pB0,14)};pw2=(u32x4){PKW(pB1,0),PKW(pB1,2),PKW(pB1,4),PKW(pB1,6)};pw3=(u32x4){PKW(pB1,8),PKW(pB1,10),PKW(pB1,12),PKW(pB1,14)};
    SBAR(); pv(o,vb0+sl_cur,PAF(0),PAF(1),PAF(2),PAF(3)); }
  #undef PKW
  #undef PAF
  #undef VFR
  #undef PIN
  #undef MX3
  #undef GAPA
  #undef GAPB
  #undef EX
  #undef VRD
  #undef KRD
  #undef STEP
  #undef ENDW
  { float l2_=l_reg; swap32(l_reg,l2_); l_reg=l_reg+l2_; }
  if(hi==0)wsf[32+r32]=l_reg;asm volatile("s_waitcnt lgkmcnt(0)":::"memory");
  float rli[16];
  #pragma unroll
  for(int r=0;r<16;++r)rli[r]=__builtin_amdgcn_rcpf(wsf[32+crow(r,hi)]);
  bf16*Ow=Yo+(rowbase+q0+wid*QBLK)*YP+YCOL+h*D; const bf16*Gw=Pq+(rowbase+q0+wid*QBLK)*DM+GCOL+h*D;
  { bf16*stg=(bf16*)(shm+LDS_OST)+wid*2048;
    #pragma unroll
    for(int r=0;r<16;++r){const int orow=crow(r,hi);
      #pragma unroll
      for(int d0=0;d0<2;++d0)stg[orow*64+d0*32+r32]=__float2bfloat16(o[d0][r]*rli[r]);}
    asm volatile("s_waitcnt lgkmcnt(0)":::"memory");
    #pragma unroll
    for(int i=0;i<4;++i){const int row=i*8+(lane>>3),ch=lane&7; const u32x4 v=*(const u32x4*)(stg+row*64+ch*8); const u32x4 g=*(const u32x4*)(Gw+(long)row*DM+ch*8); u32x4 w;
      #pragma unroll
      for(int e=0;e<4;++e){ const float a0=__uint_as_float(v[e]<<16),a1=__uint_as_float(v[e]&0xffff0000u),g0=__uint_as_float(g[e]<<16),g1=__uint_as_float(g[e]&0xffff0000u);
        w[e]=cvtpk_s(a0*g0*__builtin_amdgcn_rcpf(1.f+__expf(-g0)),a1*g1*__builtin_amdgcn_rcpf(1.f+__expf(-g1))); }
      ATTN_STORE16(Ow+(long)row*YP+ch*8,w);} }
  asm volatile("s_waitcnt lgkmcnt(0)\n\ts_barrier":::"memory");
  #undef DMA_K
  #undef DMA_V
  #undef CMASK
  #undef START
  #undef RESC
  #undef ROT
}
constexpr int ATTN_LDS_BYTES=LDS_BYTES;
#undef SBAR
#undef WAIT_BAR
}

#define LAS __attribute__((address_space(3)))
#define XB_TMO      128
#define XB_XCNT(j)  (256  + 64 * (j))
#define XB_XSUB(j)  (1280 + 64 * (j))
#define XB_XGEN(j)  (2304 + 64 * (j))
#define XB_TOP      3328
#define XB_TOPGEN   3392
#define XCD_BAR_WORDS 3456
#define XB_SPIN_CAP (1u << 18)

__device__ __forceinline__ unsigned xb_ld(unsigned* p)              { return __hip_atomic_load(p, __ATOMIC_RELAXED, __HIP_MEMORY_SCOPE_AGENT); }
__device__ __forceinline__ unsigned xb_add(unsigned* p, unsigned v) { return __hip_atomic_fetch_add(p, v, __ATOMIC_RELAXED, __HIP_MEMORY_SCOPE_AGENT); }
__device__ __forceinline__ unsigned xb_xcc_id() { return (unsigned)__builtin_amdgcn_s_getreg((3 << 11) | 20) & 0xFu; }
#define XB_SPIN(cond, bar) do { unsigned _sp = 0; while (cond) { __builtin_amdgcn_s_sleep(1); \
    if ((++_sp & 255u) == 0u) { if (xb_ld(&(bar)[XB_TMO])) break; if (_sp > XB_SPIN_CAP) { atomicAdd(&(bar)[XB_TMO], 1u); break; } } } } while (0)

struct XcdBarrier {
    unsigned* bar; unsigned x;
    volatile LAS unsigned* st;
};

__device__ __forceinline__ XcdBarrier xcd_barrier_post(unsigned* bar, volatile LAS unsigned* st) {
    XcdBarrier b; b.bar = bar; b.x = (unsigned)__builtin_amdgcn_readfirstlane((int)xb_xcc_id()); b.st = st;
    if (threadIdx.x == 0) (void)xb_add(&bar[XB_XCNT(b.x)], 1u);
    return b;
}
__device__ __forceinline__ void xcd_barrier_complete(unsigned* bar, unsigned x, unsigned& nloc, unsigned& nx) {
    const unsigned G = gridDim.x * gridDim.y * gridDim.z;
    unsigned sum, cnt, mine, sp = 0u;
    for (;;) {
        sum = 0u; cnt = 0u; mine = 0u;
#pragma unroll
        for (unsigned j = 0; j < 16; ++j) { const unsigned c = xb_ld(&bar[XB_XCNT(j)]); sum += c; cnt += (c > 0u) ? 1u : 0u; mine = (j == x) ? c : mine; }
        if (sum == G) break;
        __builtin_amdgcn_s_sleep(1);
        if ((++sp & 255u) == 0u) { if (xb_ld(&bar[XB_TMO])) break; if (sp > XB_SPIN_CAP) { atomicAdd(&bar[XB_TMO], 1u); break; } }
    }
    nloc = mine > 0u ? mine : 1u; nx = cnt > 0u ? cnt : 1u;
}

__device__ __forceinline__ void xcd_barrier(const XcdBarrier& b) {
    asm volatile("s_waitcnt vmcnt(0)" ::: "memory");
    __syncthreads();
    if (threadIdx.x == 0) {
        unsigned* bar = b.bar; asm volatile("" : "+s"(bar)); unsigned bx = b.x; asm volatile("" : "+s"(bx));
        __builtin_amdgcn_s_waitcnt(0);
        unsigned nloc = b.st[0], nx = b.st[1];
        if (nloc == 0u) { xcd_barrier_complete(bar, bx, nloc, nx); b.st[0] = nloc; b.st[1] = nx; }
        const unsigned old = xb_add(&bar[XB_XSUB(bx)], 1u);
        const unsigned gen = old / nloc;
        if (old + 1u == (gen + 1u) * nloc) {
            __builtin_amdgcn_fence(__ATOMIC_RELEASE, "agent");
            asm volatile("s_waitcnt vmcnt(0)" ::: "memory");
            const unsigned og = xb_add(&bar[XB_TOP], 1u);
            const unsigned tg = og / nx;
            if (og + 1u == (tg + 1u) * nx) xb_add(&bar[XB_TOPGEN], 1u);
            else XB_SPIN(xb_ld(&bar[XB_TOPGEN]) == tg, bar);
            __builtin_amdgcn_fence(__ATOMIC_ACQUIRE, "agent");
            asm volatile("s_waitcnt vmcnt(0)" ::: "memory");
        } else {
            XB_SPIN(xb_ld(&bar[XB_TOPGEN]) == gen, bar);
            __builtin_amdgcn_fence(__ATOMIC_ACQUIRE, "agent");
            asm volatile("s_waitcnt vmcnt(0)" ::: "memory");
        }
    }
    __syncthreads();
}

namespace cg = cooperative_groups;
__global__ void __launch_bounds__(NTHREADS, 2) mega_fwd(Args a) {
    extern __shared__ __attribute__((aligned(16))) unsigned char lds[];
    cg::grid_group grid = cg::this_grid();
    float* lds_f = (float*)lds;
    unsigned char* ws = a.ws;
    bf16* WinT = (bf16*)(ws + WS_WINT); bf16* WoutT = (bf16*)(ws + WS_WOUTT); bf16* X = (bf16*)(ws + WS_X); bf16* H = (bf16*)(ws + WS_H); bf16* Pb = (bf16*)(ws + WS_P); bf16* Y = (bf16*)(ws + WS_Y);
    RwcBuf RB; RB.CH = ws + WS_RW; RB.ST = ws + WS_RWST; RB.O1 = ws + WS_O1;
    float* kmean = (float*)(ws + WS_KMEAN);
    LruBuf LB; LB.HL = (float*)(ws + WS_LRU); LB.AC = LB.HL + (size_t)MROWS * LRU_W; LB.SH = LB.AC + (size_t)MROWS * LRU_W; LB.SA = LB.SH + NB * NSEG * LRU_W;
    const int G = gridDim.x, bid = blockIdx.x;
    volatile LAS unsigned* MISC = (volatile LAS unsigned*)((LAS unsigned char*)lds + 131072 + 320);
    if (threadIdx.x < 64) MISC[threadIdx.x] = 0u;
    __syncthreads();
    grid.sync();
    XcdBarrier bar = xcd_barrier_post((unsigned*)(ws + WS_CTL) + 4096, MISC + 8);
#define GRID_BAR() xcd_barrier(bar)

    phase_prep_weights(a, lds_f);
    for (int l = 0; l < DEPTH; ++l) {
        const void* xcur = l == 0 ? (const void*)a.in[0] : (const void*)X; const int xf32 = l == 0;
        if (l == 0 || G != 256) { phase_rmsnorm<false>(xcur, xf32, a.in[1] + (size_t)l * DM, H, (float*)(ws + WS_CTL + 512 * 1024));
        GRID_BAR(); }
        for (int rep = 0; rep < (PROBE_PH == 2 ? 2 : 1); ++rep) {
        { pg8::Gemm g{l == 0 ? H : X, WinT + (size_t)l * NINP * DM, MROWS, NINP, DM};   pg8::StaticOrder S; S.init(MROWS, NINP, G, bid);
          EpiP E{Pb, NINP, (const float*)(ws + WS_CTL + 512 * 1024)};
          pg8::gemm_phase<EpiP, pg8::StaticOrder, true, true>((PG8_LAS unsigned char*)lds, g, S, E); }
        GRID_BAR(); }
        { RwkvP P{a.in[11] + (size_t)l * RSTREAM, a.in[12] + (size_t)l * RW, a.in[13] + (size_t)l * 64 * RW, a.in[14] + (size_t)l * RW, a.in[15] + (size_t)l * 64 * RW,
                  a.in[16] + (size_t)l * RW, a.in[17] + (size_t)l * RW, a.in[18] + (size_t)l * RW, a.in[19] + (size_t)l * RW, a.in[20] + (size_t)l * RW,
                  (const bf16*)(ws + WS_LORA) + (size_t)l * NH * 2 * 64 * 64};
          { LruP LP{a.in[4] + (size_t)l * 4 * LRU_W, a.in[5] + (size_t)l * LRU_W, a.in[6] + (size_t)l * 8 * 4096, a.in[7] + (size_t)l * LRU_W, a.in[8] + (size_t)l * 8 * 4096, a.in[9] + (size_t)l * LRU_W, a.in[10] + (size_t)l * LRU_W};
            if (PROBE_PH == 31) { for (int u = bid; u < NB * 8 * NSEG; u += G) lru_local_unit(u, Pb, LP, LB, lds_f); GRID_BAR(); } }
          if (PROBE_PH == 34) { for (int u = bid; u < MROWS / 32; u += G) rwkv_phaseA(u, Pb, P, RB, (unsigned char*)lds); GRID_BAR(); }
          if (PROBE_PH == 35) { for (int u = bid; u < MROWS / 32; u += G) { const int bb_ = (u * 32) >> 12, ck_ = ((u * 32) & (SEQ - 1)) >> 5; const int wv_ = tidx() >> 6;
              for (int k = wv_; k < NH; k += NWAVES) rwkv_stage1((bb_ * NH + k) * NCH + ck_, RB, (unsigned char*)lds + wv_ * 16384); } GRID_BAR(); }
          for (int rep = 0; rep < (PROBE_PH == 32 ? 2 : 1); ++rep) { if (PROBE_PH == 32 && rep == 1) GRID_BAR();
          for (int u = bid; u < MROWS / 32; u += G) {
              rwkv_phaseA(u, Pb, P, RB, (unsigned char*)lds);
              const int bb_ = (u * 32) >> 12, ck_ = ((u * 32) & (SEQ - 1)) >> 5; const int wv_ = tidx() >> 6;
              { const int k = wv_ < 4 ? wv_ : wv_ + 4;
                rwkv_stage1((bb_ * NH + k) * NCH + ck_, RB, (unsigned char*)lds + wv_ * 16384); }
              __syncthreads(); } }
          for (int rep = 0; rep < (PROBE_PH == 33 ? 2 : 1); ++rep) { phase_moba_kmean(Pb, kmean, bid, G); if (PROBE_PH == 33) GRID_BAR(); }
          GRID_BAR();
          if (PROBE_PH == 41) { if (bid < NB * NH) rwkv_stage2(bid, RB, (unsigned char*)lds); GRID_BAR(); }
          if (bid < NB * NH) rwkv_stage2(bid, RB, (unsigned char*)lds);
          else { LruP LP{a.in[4] + (size_t)l * 4 * LRU_W, a.in[5] + (size_t)l * LRU_W, a.in[6] + (size_t)l * 8 * 4096, a.in[7] + (size_t)l * LRU_W, a.in[8] + (size_t)l * 8 * 4096, a.in[9] + (size_t)l * LRU_W, a.in[10] + (size_t)l * LRU_W};
              for (int u = bid - NB * NH; u < NB * 8 * NSEG; u += G - NB * NH) lru_local_unit(u, Pb, LP, LB, lds_f); }
          for (int rep = 0; rep < (PROBE_PH == 42 ? 2 : 1); ++rep) { if (PROBE_PH == 42 && rep == 1) GRID_BAR();
          for (;;) {
              __syncthreads();
              if (threadIdx.x == 0) MISC[16] = __hip_atomic_fetch_add((unsigned*)(ws + WS_CTL) + 8192 + 64 * (2 * l + rep), 1u, __ATOMIC_RELAXED, __HIP_MEMORY_SCOPE_AGENT);
              __syncthreads();
              const int idx = (int)MISC[16];
              if (idx >= NB * NH * NBLK) break;
              const int qb = NBLK - 1 - idx / (NB * NH), bh = idx % (NB * NH);
              attn_body::attn_unit<8>(bh / NH, bh % NH, qb, (const attn_body::bf16*)Pb, kmean + (size_t)bh * NBLK * HD, a.in[21], (attn_body::bf16*)Y, (char*)lds);
          } }
          GRID_BAR();
          for (int rep = 0; rep < (PROBE_PH == 5 ? 2 : 1); ++rep) {
          { const int wv_ = tidx() >> 6; for (int it = bid * NWAVES + wv_; it < NB * NH * NCH; it += G * NWAVES) rwkv_stage3(it, Pb, P, RB, Y, (unsigned char*)lds + wv_ * 16384); }
          for (int u = bid; u < NB * 8 * NSEG; u += G) lru_final_unit(u, Pb, LB, Y, lds_f);
          if (PROBE_PH == 5 && rep == 0) GRID_BAR(); }
        }
        GRID_BAR();
        { pg8::Gemm g{Y, WoutT + (size_t)l * DM * DM, MROWS, DM, DM}; pg8::StaticOrder S; S.init(MROWS, DM, G, bid);
          float* lpart = (float*)((unsigned char*)lds + 132096);
          EpiRes E{xcur, X, DM, xf32, lpart};
          pg8::gemm_phase<EpiRes, pg8::StaticOrder, true, true>((PG8_LAS unsigned char*)lds, g, S, E);
          __syncthreads();
          { pg8::Unit u; const int t_ = tidx(); if (G == 256 && S.next(0, u) && t_ < 256) ((float*)(ws + WS_CTL + 512 * 1024))[(size_t)(u.pm * 256 + t_) * 8 + u.pn] = (lpart[t_] + lpart[256 + t_]) + (lpart[512 + t_] + lpart[768 + t_]); } }
        GRID_BAR();
    }
    phase_rmsnorm<true>(X, 0, a.in[22], nullptr, a.out);
}

extern "C" void kernel_launch(void* const* d_in, const int* in_sizes, int n_in, void* d_out, int out_size, void* d_ws, size_t ws_size, hipStream_t stream) {
    static int grid_blocks = 0;
    if (grid_blocks == 0) {
        if (ws_size < WS_END || n_in != 23) { fprintf(stderr, "kernel_launch: bad workspace/inputs: ws %zu need %zu, n_in %d\n", ws_size, (size_t)WS_END, n_in); grid_blocks = -1; return; }
        int dev = 0, cus = 0, per_cu = 0;
        (void)hipGetDevice(&dev); (void)hipDeviceGetAttribute(&cus, hipDeviceAttributeMultiprocessorCount, dev);
        (void)hipFuncSetAttribute((const void*)mega_fwd, hipFuncAttributeMaxDynamicSharedMemorySize, LDS_BYTES);
        (void)hipOccupancyMaxActiveBlocksPerMultiprocessor(&per_cu, (const void*)mega_fwd, NTHREADS, LDS_BYTES);
        if (per_cu < 1) { fprintf(stderr, "kernel_launch: occupancy query says %d blocks per CU\n", per_cu); per_cu = 1; }
        if (cus != 256) fprintf(stderr, "kernel_launch: this build assumes 256 compute units (one GEMM2 tile per workgroup), found %d\n", cus);
        grid_blocks = cus;
        fprintf(stderr, "kernel_launch: cus %d per_cu %d grid %d\n", cus, per_cu, grid_blocks);
    }
    if (grid_blocks < 0) return;
    Args a; memset(&a, 0, sizeof(a));
    for (int i = 0; i < 23; ++i) a.in[i] = (const float*)d_in[i];
    a.out = (float*)d_out; a.ws = (unsigned char*)d_ws;
    (void)hipMemsetAsync((unsigned char*)d_ws + WS_CTL, 0, 1 * MiB, stream);
    void* args[] = {&a};
    hipError_t e = hipLaunchCooperativeKernel((const void*)mega_fwd, dim3(grid_blocks), dim3(NTHREADS), args, LDS_BYTES, stream);
    if (e != hipSuccess) fprintf(stderr, "cooperative launch failed: %s (grid %d)\n", hipGetErrorString(e), grid_blocks);
}
```

```cpp
#include <hip/hip_runtime.h>
#include <hip/hip_cooperative_groups.h>
#include <hip/hip_bf16.h>
#include <cstdio>
#include <cstdint>
#include <cstring>
#include <cmath>
namespace pg8 {
#define PG8_LAS __attribute__((address_space(3)))
typedef unsigned short bf16_t;
typedef short bf16x8 __attribute__((ext_vector_type(8)));
typedef float f32x4 __attribute__((ext_vector_type(4)));
typedef unsigned u32x4 __attribute__((ext_vector_type(4)));
constexpr int BM = 256, BK = 64, HALF = 128, HTB = HALF * BK * 2  , STAGE_BYTES = 8 * HTB, NXCD = 8, WGM = 8;

__host__ __device__ __forceinline__ int lds_byte(int r, int c) { const int st = (r >> 4) * 2 + (c >> 5), rr = r & 15, cc = c & 31, ob = rr * 64 + cc * 2; return st * 1024 + (ob ^ (((ob >> 9) & 1) << 5)); }
__host__ __device__ __forceinline__ void stage_rc(int b, int& R, int& C) { const int st = b / 1024, sb = b % 1024, swz = sb ^ (((sb >> 9) & 1) << 5); R = (st >> 1) * 16 + swz / 64; C = (st & 1) * 32 + (swz % 64) / 2; }
__host__ __device__ __forceinline__ int perm32(int rho) { const int n = rho >> 4, i = rho & 15; return 8 * (i >> 2) + 4 * n + (i & 3); }

struct Unit { int pm, pn; };
struct Gemm { const bf16_t* A; const bf16_t* Bt; int M, N, K; };

struct StaticOrder {
    int nM, nN, nwg, G, c;
    __host__ __device__ void init(int M, int N, int G_, int c_) { nM = M / BM; nN = N / BM; nwg = nM * nN; G = G_; c = c_; }
    __host__ __device__ bool next(int i, Unit& u) const {
        const long L = (long)i * G + c; if (L >= nwg) return false;
        int wgid = (int)L; { const int q = nwg / NXCD, r = nwg % NXCD, xcd = wgid % NXCD, off = wgid / NXCD; wgid = (xcd < r ? xcd * (q + 1) : r * (q + 1) + (xcd - r) * q) + off; }
        const int nig = WGM * nN, gid = wgid / nig, fm = gid * WGM, gsz = (nM - fm) < WGM ? (nM - fm) : WGM;
        u.pm = fm + ((wgid % nig) % gsz); u.pn = (wgid % nig) / gsz; return true;
    }
    __device__ __forceinline__ void a_ready(const Unit&) const {}
    __device__ __forceinline__ void done(const Unit&) const {}
};

__device__ __forceinline__ unsigned cvt_pk_bf16(float lo, float hi) { unsigned r; asm volatile("v_cvt_pk_bf16_f32 %0, %1, %2" : "=v"(r) : "v"(lo), "v"(hi)); return r; }
typedef float f32x2 __attribute__((ext_vector_type(2)));
__device__ __forceinline__ f32x2 gelu_pk(f32x2 v) {
    const f32x2 av = __builtin_elementwise_abs(v), d = av * 0.2316418882f + 1.0f;
    f32x2 t; t.x = __builtin_amdgcn_rcpf(d.x); t.y = __builtin_amdgcn_rcpf(d.y);
    f32x2 q = t * 0.5307027145f + (-0.7265760135f); q = q * t + 0.7107068705f; q = q * t + (-0.142248368f); q = q * t + 0.127414796f; q = q * t;
    const f32x2 s = (v * v) * (-0.72134752044f);
    f32x2 e; e.x = __builtin_amdgcn_exp2f(s.x); e.y = __builtin_amdgcn_exp2f(s.y);
    const f32x2 m = v * (q * e), r = v - m;
    f32x2 o; o.x = v.x < 0.f ? m.x : r.x; o.y = v.y < 0.f ? m.y : r.y; return o;
}

template <int ACT  > struct EpiBf16 {
    static constexpr bool PERM = true, AFTER_DRAIN = false; static_assert(ACT == 0 || ACT == 1, "EpiBf16: ACT is 0 (none) or 1 (gelu_pk)");
    bf16_t* O; int ldc; const float* bias; int split_cols; size_t split_stride; float scale0;
    __device__ __forceinline__ void operator()(const f32x4 (&acc)[2][2][4][2], const Unit& u, int wr, int wc, int fr, int fq) const {
        const int row0 = u.pm * BM + wr * 64 + fr; int colt = u.pn * BM; bf16_t* base = O;
        float sc = 1.f; if (split_cols) { const int t = colt / split_cols; base += (size_t)t * split_stride; colt -= t * split_cols; if (t == 0) sc = scale0; }
        const int col0 = colt + wc * 32 + 8 * fq, bcol0 = u.pn * BM + wc * 32 + 8 * fq;
        f32x4 bv[2][2];
#pragma unroll
        for (int bj = 0; bj < 2; ++bj)
#pragma unroll
            for (int n = 0; n < 2; ++n) bv[bj][n] = bias ? *(const f32x4*)(bias + bcol0 + bj * HALF + 4 * n) : (f32x4){0.f, 0.f, 0.f, 0.f};
#pragma unroll
        for (int ai = 0; ai < 2; ++ai)
#pragma unroll
            for (int m = 0; m < 4; ++m) { bf16_t* rowp = base + (size_t)(row0 + ai * HALF + m * 16) * ldc + col0;
#pragma unroll
                for (int bj = 0; bj < 2; ++bj) { f32x4 v0 = acc[ai][bj][m][0] + bv[bj][0], v1 = acc[ai][bj][m][1] + bv[bj][1];
                    if (ACT == 1) { f32x2 a = gelu_pk((f32x2){v0[0], v0[1]}), b = gelu_pk((f32x2){v0[2], v0[3]}), c = gelu_pk((f32x2){v1[0], v1[1]}), d = gelu_pk((f32x2){v1[2], v1[3]});
                        v0 = (f32x4){a.x, a.y, b.x, b.y}; v1 = (f32x4){c.x, c.y, d.x, d.y}; }
                    v0 = v0 * sc; v1 = v1 * sc; u32x4 w; w.x = cvt_pk_bf16(v0[0], v0[1]); w.y = cvt_pk_bf16(v0[2], v0[3]); w.z = cvt_pk_bf16(v1[0], v1[1]); w.w = cvt_pk_bf16(v1[2], v1[3]);
                    *(u32x4*)(rowp + bj * HALF) = w; } }
    }
};
template <class Epi, class Sched, bool ALIGN_EPI = false, bool SP2 = false>
__device__ __forceinline__ void gemm_phase(PG8_LAS unsigned char* lds, const Gemm g, const Sched& S, const Epi& E) {
    int tid_ = threadIdx.x; asm volatile("" : "+v"(tid_)); const int tid = tid_, wid = __builtin_amdgcn_readfirstlane(tid >> 6), lane = tid & 63, wr = wid >> 2, wc = wid & 3, fr = lane & 15, fq = lane >> 4;
    const int K = g.K, nt = K / BK;
    unsigned voffA[2], voffB[2];
#pragma unroll
    for (int i = 0; i < 2; ++i) { int R, C; stage_rc(tid * 16 + i * 8192, R, C); const int Rb = Epi::PERM ? ((R & ~31) + perm32(R & 31)) : R;
        voffA[i] = (unsigned)(R * K + C) * 2u; voffB[i] = (unsigned)(Rb * K + C) * 2u; }
    const size_t kstep = (size_t)(BK * 2);
    const size_t hstep = (size_t)HALF * K * 2;
    const size_t tstep = 2 * hstep;
    const unsigned ldsw = (unsigned)wid * 1024u;
    const int aoff = lds_byte(wr * 64 + fr, fq * 8), boff = lds_byte(wc * 32 + fr, fq * 8);
#define PG8_SA(b, h) (((b) * 2 + (h)) * HTB)
#define PG8_SB(b, h) ((4 + (b) * 2 + (h)) * HTB)
#define PG8_STAGE(bufoff, gbase, voff) do { _Pragma("unroll") for (int _i = 0; _i < 2; ++_i) \
        __builtin_amdgcn_global_load_lds((const unsigned*)((const char*)(gbase) + (voff)[_i]), (PG8_LAS unsigned*)(lds + (bufoff) + ldsw + _i * 8192), 16, 0, 0); } while (0)
#define PG8_LDA(dst, b, h) do { _Pragma("unroll") for (int m = 0; m < 4; ++m) _Pragma("unroll") for (int k = 0; k < 2; ++k) dst[m][k] = *(const PG8_LAS bf16x8*)(lds + PG8_SA(b, h) + aoff + m * 2048 + k * 1024); } while (0)
#define PG8_LDB(dst, b, h) do { _Pragma("unroll") for (int n = 0; n < 2; ++n) _Pragma("unroll") for (int k = 0; k < 2; ++k) dst[n][k] = *(const PG8_LAS bf16x8*)(lds + PG8_SB(b, h) + boff + n * 2048 + k * 1024); } while (0)
#define PG8_MMA(ai, bj, At, Bt) do { __builtin_amdgcn_s_setprio(1); _Pragma("unroll") for (int m = 0; m < 4; ++m) _Pragma("unroll") for (int n = 0; n < 2; ++n) _Pragma("unroll") for (int k = 0; k < 2; ++k) \
        acc[ai][bj][m][n] = __builtin_amdgcn_mfma_f32_16x16x32_bf16(Bt[n][k], At[m][k], acc[ai][bj][m][n], 0, 0, 0); __builtin_amdgcn_s_setprio(0); } while (0)
#define PG8_WAIT_V(n) asm volatile("s_waitcnt vmcnt(" #n ")" ::: "memory")
#define PG8_WAIT_L(n) asm volatile("s_waitcnt lgkmcnt(" #n ")" ::: "memory")
#define PG8_BAR __builtin_amdgcn_s_barrier()
#define PG8_SCHED __builtin_amdgcn_sched_barrier(0)
    Unit cur, nxt; int ui = 0;
    if (!S.next(0, cur)) return;
    f32x4 acc[2][2][4][2];
#pragma unroll
    for (int a = 0; a < 2; ++a)
#pragma unroll
        for (int b = 0; b < 2; ++b)
#pragma unroll
            for (int m = 0; m < 4; ++m)
#pragma unroll
                for (int n = 0; n < 2; ++n) acc[a][b][m][n] = (f32x4){0.f, 0.f, 0.f, 0.f};
    bf16x8 At[4][2], B0[2][2], B1[2][2];
    const char* cA = (const char*)g.A + (size_t)cur.pm * tstep; const char* cB = (const char*)g.Bt + (size_t)cur.pn * tstep;
    S.a_ready(cur);
    if constexpr (SP2) {
        PG8_STAGE(PG8_SB(0, 0), cB, voffB); PG8_STAGE(PG8_SB(0, 1), cB + hstep, voffB); PG8_STAGE(PG8_SA(0, 0), cA, voffA); PG8_STAGE(PG8_SA(0, 1), cA + hstep, voffA);
        if (wr == 1) PG8_BAR;
        PG8_WAIT_V(2); PG8_BAR;
        PG8_STAGE(PG8_SB(1, 0), cB + kstep, voffB); PG8_STAGE(PG8_SA(1, 0), cA + kstep, voffA); PG8_STAGE(PG8_SB(1, 1), cB + hstep + kstep, voffB);
        PG8_WAIT_V(6); PG8_BAR;
    } else {
        PG8_STAGE(PG8_SB(0, 0), cB, voffB); PG8_STAGE(PG8_SA(0, 0), cA, voffA); PG8_STAGE(PG8_SB(0, 1), cB + hstep, voffB); PG8_STAGE(PG8_SA(0, 1), cA + hstep, voffA);
        if (wr == 1) PG8_BAR;
        PG8_WAIT_V(4); PG8_BAR;
        PG8_STAGE(PG8_SB(1, 0), cB + kstep, voffB); PG8_STAGE(PG8_SA(1, 0), cA + kstep, voffA); PG8_STAGE(PG8_SB(1, 1), cB + hstep + kstep, voffB);
        PG8_WAIT_V(6); PG8_BAR;
    }
    for (;;) {
        const bool has_next = S.next(ui + 1, nxt);
        const char* nA = has_next ? (const char*)g.A + (size_t)nxt.pm * tstep : cA; const char* nB = has_next ? (const char*)g.Bt + (size_t)nxt.pn * tstep : cB;
        for (int t = 0; t < nt; t += 2) {
            const bool last = (t == nt - 2);
            const char* a1 = cA + (size_t)(t + 1) * kstep;
            const char* a2 = last ? nA : cA + (size_t)(t + 2) * kstep; const char* b2 = last ? nB : cB + (size_t)(t + 2) * kstep;
            const char* a3 = a2 + kstep; const char* b3 = b2 + kstep;
            if (last && has_next) S.a_ready(nxt);
            if constexpr (SP2) {
            PG8_LDB(B0, 0, 0); PG8_LDB(B1, 0, 1); PG8_SCHED; PG8_LDA(At, 0, 0); PG8_STAGE(PG8_SA(1, 1), a1 + hstep, voffA);
            PG8_WAIT_V(8); PG8_WAIT_L(0); PG8_BAR; PG8_MMA(0, 0, At, B0); PG8_MMA(0, 1, At, B1); PG8_BAR; PG8_SCHED;
            PG8_LDA(At, 0, 1); PG8_STAGE(PG8_SB(0, 0), b2, voffB); PG8_STAGE(PG8_SB(0, 1), b2 + hstep, voffB); PG8_STAGE(PG8_SA(0, 0), a2, voffA);
            PG8_WAIT_V(8); PG8_WAIT_L(0); PG8_BAR; PG8_MMA(1, 0, At, B0); PG8_MMA(1, 1, At, B1); PG8_BAR; PG8_SCHED;
            PG8_LDB(B0, 1, 0); PG8_LDB(B1, 1, 1); PG8_SCHED; PG8_LDA(At, 1, 0); PG8_STAGE(PG8_SA(0, 1), a2 + hstep, voffA);
            PG8_WAIT_V(8); PG8_WAIT_L(0); PG8_BAR; PG8_MMA(0, 0, At, B0); PG8_MMA(0, 1, At, B1); PG8_BAR; PG8_SCHED;
            PG8_LDA(At, 1, 1); PG8_STAGE(PG8_SB(1, 0), b3, voffB); PG8_STAGE(PG8_SB(1, 1), b3 + hstep, voffB); PG8_STAGE(PG8_SA(1, 0), a3, voffA);
            PG8_WAIT_V(8); PG8_WAIT_L(0); PG8_BAR; PG8_MMA(1, 0, At, B0); PG8_MMA(1, 1, At, B1); PG8_BAR; PG8_SCHED;
            } else {
            PG8_LDB(B0, 0, 0); PG8_SCHED; PG8_LDA(At, 0, 0); PG8_STAGE(PG8_SA(1, 1), a1 + hstep, voffA);
            PG8_WAIT_L(8); PG8_BAR; PG8_WAIT_L(0); PG8_MMA(0, 0, At, B0); PG8_BAR; PG8_SCHED;
            PG8_LDB(B1, 0, 1); PG8_STAGE(PG8_SB(0, 0), b2, voffB);
            PG8_BAR; PG8_WAIT_L(0); PG8_MMA(0, 1, At, B1); PG8_BAR;
            PG8_LDA(At, 0, 1); PG8_STAGE(PG8_SA(0, 0), a2, voffA);
            PG8_BAR; PG8_WAIT_L(0); PG8_MMA(1, 0, At, B0); PG8_BAR; PG8_SCHED;
            PG8_STAGE(PG8_SB(0, 1), b2 + hstep, voffB);
            PG8_WAIT_V(6); PG8_BAR; PG8_MMA(1, 1, At, B1); PG8_BAR;
            PG8_LDB(B0, 1, 0); PG8_SCHED; PG8_LDA(At, 1, 0); PG8_STAGE(PG8_SA(0, 1), a2 + hstep, voffA);
            PG8_WAIT_L(8); PG8_BAR; PG8_WAIT_L(0); PG8_MMA(0, 0, At, B0); PG8_BAR; PG8_SCHED;
            PG8_LDB(B1, 1, 1); PG8_STAGE(PG8_SB(1, 0), b3, voffB);
            PG8_BAR; PG8_WAIT_L(0); PG8_MMA(0, 1, At, B1); PG8_BAR;
            PG8_LDA(At, 1, 1); PG8_STAGE(PG8_SA(1, 0), a3, voffA);
            PG8_BAR; PG8_WAIT_L(0); PG8_MMA(1, 0, At, B0); PG8_BAR; PG8_SCHED;
            PG8_STAGE(PG8_SB(1, 1), b3 + hstep, voffB);
            PG8_WAIT_V(6); PG8_BAR; PG8_MMA(1, 1, At, B1); PG8_BAR;
            }
        }
        if constexpr (ALIGN_EPI) { if (wr == 0) PG8_BAR; }
        if constexpr (!Epi::AFTER_DRAIN) { E(acc, cur, wr, wc, fr, fq); S.done(cur); }
        if (!has_next) break;
#pragma unroll
        for (int a = 0; a < 2; ++a)
#pragma unroll
            for (int b = 0; b < 2; ++b)
#pragma unroll
                for (int m = 0; m < 4; ++m)
#pragma unroll
                    for (int n = 0; n < 2; ++n) acc[a][b][m][n] = (f32x4){0.f, 0.f, 0.f, 0.f};
        cur = nxt; cA = nA; cB = nB; ++ui;
        if constexpr (ALIGN_EPI) { if (wr == 1) PG8_BAR; }
    }
    PG8_WAIT_V(0);
    if constexpr (!ALIGN_EPI) { if (wr == 0) PG8_BAR; }
    PG8_BAR;
    if constexpr (Epi::AFTER_DRAIN) { E.fused(acc, cur, wr, wc, fr, fq, lds, wid, lane); S.done(cur); }
#undef PG8_SA
#undef PG8_SB
#undef PG8_STAGE
#undef PG8_LDA
#undef PG8_LDB
#undef PG8_MMA
#undef PG8_WAIT_V
#undef PG8_WAIT_L
#undef PG8_BAR
#undef PG8_SCHED
}
}

constexpr int DM = 2048, NB = 2, SEQ = 4096, MROWS = NB * SEQ, DEPTH = 4;
constexpr int LRU_W = 512, RW = 768, MOW = 768, NIN = 7296, NINP = 7424;
constexpr int OFF_XA = 0, OFF_GA = 512, OFF_SB = 1024, OFF_GB = 3456, OFF_QKV = 4224, OFF_GC = 6528;
constexpr int RSTREAM = 2432;
constexpr int NH = 12, HD = 64, NBLK = 16, BLK = 256;

typedef unsigned short bf16;
typedef float f32x4 __attribute__((ext_vector_type(4)));
typedef unsigned u32x4 __attribute__((ext_vector_type(4)));
typedef unsigned u32x2 __attribute__((ext_vector_type(2)));

__device__ __forceinline__ unsigned f2bf(float f) { unsigned u = __builtin_bit_cast(unsigned, f); return (u + 0x7fffu + ((u >> 16) & 1u)) >> 16; }
__device__ __forceinline__ unsigned pk2(float lo, float hi) { return f2bf(lo) | (f2bf(hi) << 16); }
__device__ __forceinline__ float bf2f(unsigned short b) { return __builtin_bit_cast(float, (unsigned)b << 16); }
__device__ __forceinline__ float bflo(unsigned w) { return __builtin_bit_cast(float, w << 16); }
__device__ __forceinline__ float bfhi(unsigned w) { return __builtin_bit_cast(float, w & 0xffff0000u); }
__device__ __forceinline__ float sigmoidf_(float x) { return __builtin_amdgcn_rcpf(1.f + __expf(-x)); }
__device__ __forceinline__ float siluf_(float x) { return x * __builtin_amdgcn_rcpf(1.f + __expf(-x)); }
template <int CTRL, int RMASK> __device__ __forceinline__ float dpp0(float v) { return __builtin_bit_cast(float, __builtin_amdgcn_update_dpp(0, __builtin_bit_cast(int, v), CTRL, RMASK, 0xf, false)); }
__device__ __forceinline__ float wave_sum(float v) {
    v += dpp0<0xB1, 0xf>(v); v += dpp0<0x4E, 0xf>(v); v += dpp0<0x141, 0xf>(v); v += dpp0<0x140, 0xf>(v);
    v += dpp0<0x142, 0xa>(v);
    v += dpp0<0x143, 0xc>(v);
    return __builtin_bit_cast(float, __builtin_amdgcn_readlane(__builtin_bit_cast(int, v), 63));
}

__device__ __forceinline__ void transpose_item(const float* W, int K, int N, bf16* WT, float* scr, int item, int lane, const float* kscale = nullptr) {
    const int nblk = N / 32, kb = item / nblk, nb = item % nblk, k0 = 64 * kb, n0 = 32 * nb;
#pragma unroll 8
    for (int i = 0; i < 32; ++i) { const int kk = 2 * i + (lane >> 5); scr[kk * 33 + (lane & 31)] = W[(size_t)(k0 + kk) * N + n0 + (lane & 31)]; }
    __builtin_amdgcn_s_waitcnt(0xc07f); __builtin_amdgcn_wave_barrier();
    const int c = lane & 7;
    float ks8[8];
#pragma unroll
    for (int e = 0; e < 8; ++e) ks8[e] = kscale ? kscale[k0 + 8 * c + e] : 1.f;
#pragma unroll
    for (int j = 0; j < 4; ++j) { const int n = (lane >> 3) + 8 * j; const float* s = scr + (8 * c) * 33 + n;
        u32x4 o; o.x = pk2(s[0 * 33] * ks8[0], s[1 * 33] * ks8[1]); o.y = pk2(s[2 * 33] * ks8[2], s[3 * 33] * ks8[3]); o.z = pk2(s[4 * 33] * ks8[4], s[5 * 33] * ks8[5]); o.w = pk2(s[6 * 33] * ks8[6], s[7 * 33] * ks8[7]);
        *(u32x4*)(WT + (size_t)(n0 + n) * K + k0 + 8 * c) = o; }
    __builtin_amdgcn_s_waitcnt(0xc07f); __builtin_amdgcn_wave_barrier();
}

constexpr size_t MiB = 1u << 20;
constexpr size_t WS_CTL = 0;
constexpr size_t WS_WINT = 1 * MiB;
constexpr size_t WS_WOUTT = WS_WINT + (size_t)DEPTH * NINP * DM * 2;
constexpr size_t WS_X = WS_WOUTT + (size_t)DEPTH * DM * DM * 2;
constexpr size_t WS_H = WS_X + (size_t)MROWS * DM * 4;
constexpr size_t WS_P = WS_H + (size_t)MROWS * DM * 2;
constexpr size_t WS_Y = WS_P + (size_t)MROWS * NINP * 2;
constexpr size_t WS_RW = WS_Y + (size_t)MROWS * DM * 2;
constexpr size_t RW_ARR = (size_t)MROWS * RW * 4;
constexpr size_t WS_RWST = WS_RW + 104 * MiB;
constexpr size_t WS_KMEAN = WS_RW + 8 * RW_ARR;
constexpr size_t WS_LRU = WS_KMEAN + 1 * MiB;
constexpr size_t WS_O1 = WS_LRU + 2 * (size_t)MROWS * LRU_W * 4 + 1 * MiB;
constexpr size_t WS_LORA = WS_O1 + (size_t)NB * NH * (SEQ / 32) * 12288;
constexpr size_t WS_END = WS_LORA + (size_t)DEPTH * NH * 2 * 64 * 64 * 2;
constexpr int LDS_BYTES = 147456;
constexpr int NTHREADS = 512, NWAVES = 8;

typedef float f32x2e_t __attribute__((ext_vector_type(2))); typedef __bf16 bf16x2e_t __attribute__((ext_vector_type(2)));
__device__ __forceinline__ unsigned cvtpk_e(float lo, float hi) { const f32x2e_t v = {lo, hi}; const bf16x2e_t b = __builtin_convertvector(v, bf16x2e_t); return __builtin_bit_cast(unsigned, b); }
struct EpiRes {
    static constexpr bool PERM = false, AFTER_DRAIN = false;
    const void* base; bf16* out; int ldc; int base_f32; float* lpart;
    __device__ __forceinline__ void operator()(const pg8::f32x4 (&acc)[2][2][4][2], const pg8::Unit& u, int wr, int wc, int fr, int fq) const {
        const int row0 = u.pm * 256 + wr * 64 + fr, col0 = u.pn * 256 + wc * 32 + 4 * fq;
        float ss[2][4];
#pragma unroll
        for (int ai = 0; ai < 2; ++ai)
#pragma unroll
            for (int m = 0; m < 4; ++m) ss[ai][m] = 0.f;
#pragma unroll
        for (int ai = 0; ai < 2; ++ai)
#pragma unroll
            for (int mp = 0; mp < 2; ++mp) { pg8::f32x4 bs[2][2][2];
                if (base_f32) {
#pragma unroll
                    for (int mm = 0; mm < 2; ++mm) { const size_t off = (size_t)(row0 + ai * 128 + (2 * mp + mm) * 16) * ldc + col0;
#pragma unroll
                        for (int bj = 0; bj < 2; ++bj)
#pragma unroll
                            for (int n = 0; n < 2; ++n) bs[mm][bj][n] = *(const pg8::f32x4*)((const float*)base + off + bj * 128 + n * 16); }
                    asm volatile("" : "+v"(bs[0][0][0]), "+v"(bs[0][0][1]), "+v"(bs[0][1][0]), "+v"(bs[0][1][1]), "+v"(bs[1][0][0]), "+v"(bs[1][0][1]), "+v"(bs[1][1][0]), "+v"(bs[1][1][1]));
                } else { u32x2 bw[2][2][2];
#pragma unroll
                    for (int mm = 0; mm < 2; ++mm) { const size_t off = (size_t)(row0 + ai * 128 + (2 * mp + mm) * 16) * ldc + col0;
#pragma unroll
                        for (int bj = 0; bj < 2; ++bj)
#pragma unroll
                            for (int n = 0; n < 2; ++n) bw[mm][bj][n] = *(const u32x2*)((const bf16*)base + off + bj * 128 + n * 16); }
                    asm volatile("" : "+v"(bw[0][0][0]), "+v"(bw[0][0][1]), "+v"(bw[0][1][0]), "+v"(bw[0][1][1]), "+v"(bw[1][0][0]), "+v"(bw[1][0][1]), "+v"(bw[1][1][0]), "+v"(bw[1][1][1]));
#pragma unroll
                    for (int mm = 0; mm < 2; ++mm)
#pragma unroll
                        for (int bj = 0; bj < 2; ++bj)
#pragma unroll
                            for (int n = 0; n < 2; ++n) { const u32x2 w = bw[mm][bj][n]; bs[mm][bj][n] = (pg8::f32x4){__builtin_bit_cast(float, w.x << 16), __builtin_bit_cast(float, w.x & 0xffff0000u), __builtin_bit_cast(float, w.y << 16), __builtin_bit_cast(float, w.y & 0xffff0000u)}; } }
#pragma unroll
                for (int mm = 0; mm < 2; ++mm) { const size_t off = (size_t)(row0 + ai * 128 + (2 * mp + mm) * 16) * ldc + col0;
#pragma unroll
                    for (int bj = 0; bj < 2; ++bj)
#pragma unroll
                        for (int n = 0; n < 2; ++n) { const pg8::f32x4 o = bs[mm][bj][n] + acc[ai][bj][2 * mp + mm][n]; *(u32x2*)(out + off + bj * 128 + n * 16) = (u32x2){cvtpk_e(o.x, o.y), cvtpk_e(o.z, o.w)};
                            ss[ai][2 * mp + mm] += (o.x * o.x + o.y * o.y) + (o.z * o.z + o.w * o.w); } } }
#pragma unroll
        for (int ai = 0; ai < 2; ++ai)
#pragma unroll
            for (int m = 0; m < 4; ++m) { float v = ss[ai][m];
                v += __builtin_bit_cast(float, __builtin_amdgcn_ds_swizzle(__builtin_bit_cast(int, v), 0x401F));
                { float t = v; asm volatile("s_nop 1\n\tv_permlane32_swap_b32 %0, %1" : "+v"(v), "+v"(t)); v = v + t; }
                if (fq == 0) lpart[wc * 256 + wr * 64 + fr + ai * 128 + m * 16] = v; }
    }
};


struct EpiP {
    static constexpr bool PERM = true, AFTER_DRAIN = false;
    bf16* O; int ldc; const float* rstd;
    __device__ __forceinline__ void operator()(const pg8::f32x4 (&acc)[2][2][4][2], const pg8::Unit& u, int wr, int wc, int fr, int fq) const {
        const int row0 = u.pm * 256 + wr * 64 + fr, col0 = u.pn * 256 + wc * 32 + 8 * fq;
        float rs[2][4];
        { pg8::f32x4 pa[2][4], pb[2][4];
#pragma unroll
          for (int ai = 0; ai < 2; ++ai)
#pragma unroll
              for (int m = 0; m < 4; ++m) { const pg8::f32x4* rp = (const pg8::f32x4*)(rstd + (size_t)(row0 + ai * 128 + m * 16) * 8); pa[ai][m] = rp[0]; pb[ai][m] = rp[1]; }
          asm volatile("" : "+v"(pa[0][0]), "+v"(pa[0][1]), "+v"(pa[0][2]), "+v"(pa[0][3]), "+v"(pa[1][0]), "+v"(pa[1][1]), "+v"(pa[1][2]), "+v"(pa[1][3]));
          asm volatile("" : "+v"(pb[0][0]), "+v"(pb[0][1]), "+v"(pb[0][2]), "+v"(pb[0][3]), "+v"(pb[1][0]), "+v"(pb[1][1]), "+v"(pb[1][2]), "+v"(pb[1][3]));
#pragma unroll
          for (int ai = 0; ai < 2; ++ai)
#pragma unroll
              for (int m = 0; m < 4; ++m) { const float t = ((pa[ai][m].x + pa[ai][m].y) + (pa[ai][m].z + pa[ai][m].w)) + ((pb[ai][m].x + pb[ai][m].y) + (pb[ai][m].z + pb[ai][m].w));
                  rs[ai][m] = __builtin_amdgcn_rsqf(t * (1.f / DM) + 1e-6f); } }
#pragma unroll
        for (int ai = 0; ai < 2; ++ai)
#pragma unroll
            for (int m = 0; m < 4; ++m) { bf16* rowp = O + (size_t)(row0 + ai * 128 + m * 16) * ldc + col0;
#pragma unroll
                for (int bj = 0; bj < 2; ++bj) { const int c = col0 + bj * 128; const float sc = ((c >= OFF_QKV && c < OFF_QKV + MOW) ? 0.125f * 1.4426950408889634f : 1.f) * rs[ai][m];
                    const pg8::f32x4 v0 = acc[ai][bj][m][0] * sc, v1 = acc[ai][bj][m][1] * sc;
                    pg8::u32x4 w; w.x = pg8::cvt_pk_bf16(v0[0], v0[1]); w.y = pg8::cvt_pk_bf16(v0[2], v0[3]); w.z = pg8::cvt_pk_bf16(v1[0], v1[1]); w.w = pg8::cvt_pk_bf16(v1[2], v1[3]);
                    *(pg8::u32x4*)(rowp + bj * 128) = w; } }
    }
};
__device__ __forceinline__ int tidx() { int t = threadIdx.x; asm volatile("" : "+v"(t)); return t; }
#ifndef PROBE_PH
#define PROBE_PH 0
#endif
struct Args { const float* in[23]; float* out; unsigned char* ws; };

__device__ __forceinline__ void phase_prep_weights(const Args& a, float* lds_f) {
    const int TID = tidx();
    const int lane = TID & 63, wave = TID >> 6;
    float* scr = lds_f + wave * 64 * 33;
    bf16* WinT = (bf16*)(a.ws + WS_WINT); bf16* WoutT = (bf16*)(a.ws + WS_WOUTT);
    const float* w_in = a.in[2]; const float* w_out = a.in[3];
    const int gw = blockIdx.x * NWAVES + wave, NGW = gridDim.x * NWAVES;
    constexpr int I_IN = (DM / 64) * (NIN / 32), I_OUT = (DM / 64) * (DM / 32);
    constexpr int NITEMS = DEPTH * (I_IN + I_OUT);
    for (int it = gw; it < NITEMS; it += NGW) {
        if (it < DEPTH * I_IN) { const int l = it / I_IN, r = it % I_IN; transpose_item(w_in + (size_t)l * DM * NIN, DM, NIN, WinT + (size_t)l * NINP * DM, scr, r, lane, a.in[1] + (size_t)l * DM); }
        else { const int r0 = it - DEPTH * I_IN, l = r0 / I_OUT, r = r0 % I_OUT; transpose_item(w_out + (size_t)l * DM * DM, DM, DM, WoutT + (size_t)l * DM * DM, scr, r, lane); }
    }
    const int gt = blockIdx.x * NTHREADS + TID, NGT = gridDim.x * NTHREADS;
    { bf16* LO = (bf16*)(a.ws + WS_LORA); const float* wu = a.in[13]; const float* au = a.in[15];
      for (int i = blockIdx.x * NTHREADS + TID; i < DEPTH * NH * 2 * 64 * 8; i += gridDim.x * NTHREADS) { const int c = i & 63, kg = (i >> 6) & 7, m = (i >> 9) & 1, lh = i >> 10, hh_ = lh % NH, l = lh / NH;
          const float* src = (m ? au : wu) + (size_t)l * 64 * RW + (size_t)(8 * kg) * RW + hh_ * 64 + c; float v[8];
#pragma unroll
          for (int e = 0; e < 8; ++e) v[e] = src[(size_t)e * RW];
          *(u32x4*)(LO + ((size_t)(lh * 2 + m) * 64 + c) * 64 + 8 * kg) = (u32x4){pk2(v[0], v[1]), pk2(v[2], v[3]), pk2(v[4], v[5]), pk2(v[6], v[7])}; } }
    constexpr int PADV = (NINP - NIN) * DM / 8;
    for (int i = gt; i < DEPTH * PADV; i += NGT) { const int l = i / PADV, r = i % PADV; *(u32x4*)(WinT + (size_t)l * NINP * DM + (size_t)NIN * DM + (size_t)r * 8) = (u32x4){0u, 0u, 0u, 0u}; }
}
template <bool FINAL> __device__ __forceinline__ void phase_rmsnorm(const void* x, int x_f32, const float* w, bf16* hb, float* outf) {
    const int TID = tidx();
    const int lane = TID & 63, wave = TID >> 6;
    for (int row = blockIdx.x * NWAVES + wave; row < MROWS; row += gridDim.x * NWAVES) {
        f32x4 v[8]; float s = 0.f;
        if (x_f32) { const f32x4* xr = (const f32x4*)((const float*)x + (size_t)row * DM) + lane;
#pragma unroll
            for (int j = 0; j < 8; ++j) v[j] = xr[64 * j]; }
        else { const u32x2* xr = (const u32x2*)((const bf16*)x + (size_t)row * DM) + lane;
#pragma unroll
            for (int j = 0; j < 8; ++j) { const u32x2 w2 = xr[64 * j]; v[j] = (f32x4){__builtin_bit_cast(float, w2.x << 16), __builtin_bit_cast(float, w2.x & 0xffff0000u), __builtin_bit_cast(float, w2.y << 16), __builtin_bit_cast(float, w2.y & 0xffff0000u)}; } }
#pragma unroll
        for (int j = 0; j < 8; ++j) s += (v[j].x * v[j].x + v[j].y * v[j].y) + (v[j].z * v[j].z + v[j].w * v[j].w);
        const float ssum = wave_sum(s); const float rstd = rsqrtf(ssum * (1.f / DM) + 1e-6f);
        if (!FINAL) {
            if (lane < 8) outf[(size_t)row * 8 + lane] = lane == 0 ? ssum : 0.f;
            if (x_f32) {
#pragma unroll
                for (int j = 0; j < 8; ++j) { u32x2 pk; pk.x = pk2(v[j].x, v[j].y); pk.y = pk2(v[j].z, v[j].w); ((u32x2*)(hb + (size_t)row * DM) + lane)[64 * j] = pk; } }
            continue; }
        const f32x4* wr = (const f32x4*)w + lane;
        f32x4 wv[8];
#pragma unroll
        for (int j = 0; j < 8; ++j) wv[j] = wr[64 * j];
        asm volatile("" : "+v"(wv[0]), "+v"(wv[1]), "+v"(wv[2]), "+v"(wv[3]), "+v"(wv[4]), "+v"(wv[5]), "+v"(wv[6]), "+v"(wv[7]));
#pragma unroll
        for (int j = 0; j < 8; ++j) { const f32x4 ww = wv[j]; const f32x4 o = v[j] * rstd * ww;
            if (FINAL) { ((f32x4*)(outf + (size_t)row * DM) + lane)[64 * j] = o; }
            else { u32x2 pk; pk.x = pk2(o.x, o.y); pk.y = pk2(o.z, o.w); ((u32x2*)(hb + (size_t)row * DM) + lane)[64 * j] = pk; } }
    }
}
struct LruP { const float *conv_w, *conv_b, *ga_w, *ga_b, *gx_w, *gx_b, *lam; };
struct LruBuf { float *HL, *AC, *SH, *SA; };
constexpr int LSEG = 256, NSEG = SEQ / LSEG, XSTR = 260;
typedef short lbfx8 __attribute__((ext_vector_type(8))); typedef float lfx16 __attribute__((ext_vector_type(16)));
__device__ __forceinline__ void lru_swap32(float& a, float& b) { asm volatile("s_nop 1\n\tv_permlane32_swap_b32 %0, %1" : "+v"(a), "+v"(b)); }
constexpr int LXS = 72;
__device__ __forceinline__ void lru_local_unit(int unit, const bf16* __restrict__ p, const LruP& P, const LruBuf& L, float* lds_f) {
    const int TID = tidx();
    bf16* sWTa = (bf16*)lds_f; bf16* sWTx = sWTa + 64 * LXS; bf16* sXB = sWTx + 64 * LXS;
    float* sCar = (float*)(sXB + 256 * LXS);
    const int b = unit >> 7, g = (unit >> 4) & 7, seg = unit & 15, c = TID & 63, tg = TID >> 6, t0 = seg * LSEG;
    { float wa[8], wx[8];
#pragma unroll
      for (int j = 0; j < 8; ++j) { wa[j] = P.ga_w[g * 4096 + TID + NTHREADS * j]; wx[j] = P.gx_w[g * 4096 + TID + NTHREADS * j]; }
      asm volatile("" : "+v"(wa[0]), "+v"(wa[1]), "+v"(wa[2]), "+v"(wa[3]), "+v"(wa[4]), "+v"(wa[5]), "+v"(wa[6]), "+v"(wa[7]));
      asm volatile("" : "+v"(wx[0]), "+v"(wx[1]), "+v"(wx[2]), "+v"(wx[3]), "+v"(wx[4]), "+v"(wx[5]), "+v"(wx[6]), "+v"(wx[7]));
#pragma unroll
      for (int j = 0; j < 8; ++j) { const int i = TID + NTHREADS * j, k = i >> 6, cc = i & 63; sWTa[cc * LXS + k] = (bf16)f2bf(wa[j]); sWTx[cc * LXS + k] = (bf16)f2bf(wx[j]); } }
    const int ch = g * 64 + c;
    const float cw0 = P.conv_w[0 * LRU_W + ch], cw1 = P.conv_w[1 * LRU_W + ch], cw2 = P.conv_w[2 * LRU_W + ch], cw3 = P.conv_w[3 * LRU_W + ch], cb = P.conv_b[ch];
    const float sp = log1pf(__expf(-P.lam[ch]));
    float xc[32];
    { const int tb = t0 + tg * 32; const bf16* pr = p + (size_t)(b * SEQ + tb) * NINP + OFF_XA + ch;
      unsigned xu[35];
#pragma unroll
      for (int i = 0; i < 35; ++i) xu[i] = (i >= 3 || tb >= 3 - i) ? (unsigned)pr[(ptrdiff_t)(i - 3) * NINP] : 0u;
#pragma unroll
      for (int gq = 0; gq < 5; ++gq) asm volatile("" : "+v"(xu[7 * gq]), "+v"(xu[7 * gq + 1]), "+v"(xu[7 * gq + 2]), "+v"(xu[7 * gq + 3]), "+v"(xu[7 * gq + 4]), "+v"(xu[7 * gq + 5]), "+v"(xu[7 * gq + 6]));
      float x3 = bf2f((unsigned short)xu[0]), x2 = bf2f((unsigned short)xu[1]), x1 = bf2f((unsigned short)xu[2]);
#pragma unroll
      for (int i = 0; i < 32; ++i) { const float x0 = bf2f((unsigned short)xu[i + 3]); xc[i] = cw3 * x0 + cw2 * x1 + cw1 * x2 + cw0 * x3 + cb; x3 = x2; x2 = x1; x1 = x0; } }
#pragma unroll
    for (int i = 0; i < 32; ++i) sXB[(tg * 32 + i) * LXS + c] = (bf16)f2bf(xc[i]);
    __syncthreads();
    float ra[32], ia[32];
    { const int r = c & 31, h = c >> 5;
      lbfx8 fa[4];
#pragma unroll
      for (int ks = 0; ks < 4; ++ks) fa[ks] = *(const lbfx8*)(sXB + (tg * 32 + r) * LXS + 16 * ks + 8 * h);
#pragma unroll
      for (int gate = 0; gate < 2; ++gate) { const bf16* W = gate ? sWTx : sWTa; const float* bp = (gate ? P.gx_b : P.ga_b) + g * 64;
          const float b0 = bp[r], b1 = bp[32 + r];
          lfx16 acc0 = {}, acc1 = {};
#pragma unroll
          for (int ks = 0; ks < 4; ++ks) { const lbfx8 w0 = *(const lbfx8*)(W + r * LXS + 16 * ks + 8 * h), w1 = *(const lbfx8*)(W + (32 + r) * LXS + 16 * ks + 8 * h);
              acc0 = __builtin_amdgcn_mfma_f32_32x32x16_bf16(fa[ks], w0, acc0, 0, 0, 0); acc1 = __builtin_amdgcn_mfma_f32_32x32x16_bf16(fa[ks], w1, acc1, 0, 0, 0); }
#pragma unroll
          for (int i = 0; i < 16; ++i) { float a0 = acc0[i] + b0, a1 = acc1[i] + b1; lru_swap32(a0, a1); const int t = (i & 3) + 8 * (i >> 2);
              if (gate == 0) { ra[t] = a0; ra[t + 4] = a1; } else { ia[t] = a0; ia[t + 4] = a1; } } } }
    { float h = 0.f, A = 1.f;
#pragma unroll
      for (int i = 0; i < 32; ++i) { const float r = sigmoidf_(ra[i]), ig = sigmoidf_(ia[i]);
          const float log_a = -8.f * r * sp; const float av = __expf(log_a);
          const float x2 = 2.f * log_a; float om = 1.f - av * av; if (x2 > -0.03f) om = -x2 * (1.f + x2 * (0.5f + x2 * (1.f / 6.f)));
          const float bb = __builtin_amdgcn_sqrtf(om) * (ig * xc[i]);
          h = av * h + bb; A *= av; ra[i] = h; ia[i] = A; }
      sCar[(tg * 64 + c) * 2] = h; sCar[(tg * 64 + c) * 2 + 1] = A; }
    __syncthreads();
    float cin = 0.f, Ap = 1.f;
    for (int q = 0; q < tg; ++q) { const float he = sCar[(q * 64 + c) * 2], Ae = sCar[(q * 64 + c) * 2 + 1]; cin = he + Ae * cin; Ap *= Ae; }
    { const size_t o = (size_t)(b * SEQ + t0 + tg * 32) * LRU_W + ch;
#pragma unroll
      for (int i = 0; i < 32; ++i) { const float h = ra[i] + ia[i] * cin, A = ia[i] * Ap; L.HL[o + (size_t)i * LRU_W] = h; L.AC[o + (size_t)i * LRU_W] = A;
          if (i == 31 && tg == 7) { L.SH[(b * NSEG + seg) * LRU_W + ch] = h; L.SA[(b * NSEG + seg) * LRU_W + ch] = A; } } }
    __syncthreads();
}
__device__ __forceinline__ void lru_final_unit(int unit, const bf16* __restrict__ p, const LruBuf& L, bf16* ybuf, float* lds_f) {
    const int TID = tidx();
    const int b = unit >> 7, g = (unit >> 4) & 7, seg = unit & 15, c = TID & 63, tg = TID >> 6, t0 = seg * LSEG, ch = g * 64 + c;
    float cin = 0.f;
    for (int s = 0; s < seg; ++s) cin = L.SH[(b * NSEG + s) * LRU_W + ch] + L.SA[(b * NSEG + s) * LRU_W + ch] * cin;
    const size_t row0 = (size_t)(b * SEQ + t0 + tg * 32);
    for (int i0 = 0; i0 < 32; i0 += 8) { float hl[8], ac[8]; unsigned gu[8];
#pragma unroll
        for (int i = 0; i < 8; ++i) { const size_t row = row0 + i0 + i; hl[i] = L.HL[row * LRU_W + ch]; ac[i] = L.AC[row * LRU_W + ch]; gu[i] = p[row * NINP + OFF_GA + ch]; }
        asm volatile("" : "+v"(hl[0]), "+v"(hl[1]), "+v"(hl[2]), "+v"(hl[3]), "+v"(hl[4]), "+v"(hl[5]), "+v"(hl[6]), "+v"(hl[7]));
        asm volatile("" : "+v"(ac[0]), "+v"(ac[1]), "+v"(ac[2]), "+v"(ac[3]), "+v"(ac[4]), "+v"(ac[5]), "+v"(ac[6]), "+v"(ac[7]));
        asm volatile("" : "+v"(gu[0]), "+v"(gu[1]), "+v"(gu[2]), "+v"(gu[3]), "+v"(gu[4]), "+v"(gu[5]), "+v"(gu[6]), "+v"(gu[7]));
#pragma unroll
        for (int i = 0; i < 8; ++i) { const size_t row = row0 + i0 + i; const float h = hl[i] + ac[i] * cin; const float ga = bf2f((unsigned short)gu[i]);
            ybuf[row * DM + ch] = (bf16)f2bf(h * siluf_(ga)); } }
}
struct RwkvP { const float *mix, *w0, *w_up, *a0, *a_up, *k_k, *k_a, *r_k, *ln_w, *ln_b; const bf16* lora; };
typedef short bfx8 __attribute__((ext_vector_type(8)));
typedef float fx16 __attribute__((ext_vector_type(16)));
#define MFMA32(a, b, c) __builtin_amdgcn_mfma_f32_32x32x16_bf16(a, b, c, 0, 0, 0)
constexpr int RC = 32, NCH = SEQ / RC;
constexpr int CH_AT = 0, CH_BT = 4096, CH_KT = 8192, CH_RT = 12288, CH_BHT = 16384, CH_KHT = 20480, CH_VT = 24576, CH_VR = 28672, CH_ECW = 32768, CH_C3 = 33024, CH_STRIDE = 33280;
constexpr int O_P = 0, O_QT = 4096, O_ARB = 8192, O_ARK = 10240, O_STRIDE = 12288;
constexpr int ST_S0 = 0, ST_UT = 8192, ST_STRIDE = 12288;
struct RwcBuf { unsigned char *CH, *O1, *ST; };
__device__ __forceinline__ int crow16(int reg, int h) { return (reg & 3) + 8 * (reg >> 2) + 4 * h; }
typedef float f32x2c_t __attribute__((ext_vector_type(2))); typedef __bf16 bf16x2c_t __attribute__((ext_vector_type(2)));
__device__ __forceinline__ unsigned cvtpk(float lo, float hi) { const f32x2c_t v = {lo, hi}; const bf16x2c_t b = __builtin_convertvector(v, bf16x2c_t); return __builtin_bit_cast(unsigned, b); }

__device__ __forceinline__ void rwkv_stage1(int item, const RwcBuf& B, unsigned char* wl);
__device__ __forceinline__ void rwkv_phaseA(int unit, const bf16* __restrict__ p, const RwkvP& P, const RwcBuf& B, unsigned char* lds) {
    const int TID = tidx();
    const int wave = TID >> 6;
    bf16* TW = (bf16*)(lds + 132096); bf16* AD = TW + 32 * 64;
    float* LWt = (float*)(lds + wave * 16384); float* LAt = LWt + 64 * 32;
    const int row0 = unit * 32, b = row0 >> 12, tb = row0 & (SEQ - 1), chunk = tb >> 5;
    { unsigned cu[8], pu[8];
      const float mixv = P.mix[2304 + (TID & 127)];
#pragma unroll
      for (int i = 0; i < 8; ++i) { const int idx = TID + 512 * i, tok = idx >> 7, col = idx & 127, cidx = 2304 + col;
          const bf16* cur = p + (size_t)(row0 + tok) * NINP + OFF_SB + cidx;
          cu[i] = cur[0]; pu[i] = (tb + tok) > 0 ? (unsigned)*(cur - NINP) : 0u; }
      asm volatile("" : "+v"(cu[0]), "+v"(cu[1]), "+v"(cu[2]), "+v"(cu[3]), "+v"(cu[4]), "+v"(cu[5]), "+v"(cu[6]), "+v"(cu[7]));
      asm volatile("" : "+v"(pu[0]), "+v"(pu[1]), "+v"(pu[2]), "+v"(pu[3]), "+v"(pu[4]), "+v"(pu[5]), "+v"(pu[6]), "+v"(pu[7]));
#pragma unroll
      for (int i = 0; i < 8; ++i) { const int idx = TID + 512 * i, tok = idx >> 7, col = idx & 127;
          const float c0 = bf2f((unsigned short)cu[i]), p0 = bf2f((unsigned short)pu[i]); const float s = c0 + mixv * (p0 - c0);
          const int cc = col & 63, so = tok * 64 + (((cc >> 3) ^ (tok & 7)) << 3) + (cc & 7);
          if (col < 64) TW[so] = (bf16)f2bf(tanhf(s)); else AD[so] = (bf16)f2bf(s); } }
    __syncthreads();
    for (int pass = 0; pass < 2; ++pass) {
        int tl_ = TID; asm volatile("" : "+v"(tl_));
        const int c = pass * 512 + tl_, lane = tl_ & 63, r = lane & 31, hh = lane >> 5;
        if (c < RW) {
            { bfx8 aW[4], aA[4];
#pragma unroll
              for (int ks = 0; ks < 4; ++ks) { const int so = r * 64 + (((2 * ks + hh) ^ (r & 7)) << 3); aW[ks] = *(const bfx8*)(TW + so); aA[ks] = *(const bfx8*)(AD + so); }
              const int cb = (c & ~63);
#pragma unroll
              for (int n = 0; n < 2; ++n) { fx16 xw = {}, xa = {};
                  const bf16* wfr = P.lora + ((size_t)((cb >> 6) * 2) * 64 + 32 * n + r) * 64 + 8 * hh; const bf16* afr = wfr + 64 * 64;
#pragma unroll
                  for (int ks = 0; ks < 4; ++ks) { const bfx8 bw = *(const bfx8*)(wfr + 16 * ks), ba = *(const bfx8*)(afr + 16 * ks);
                      xw = MFMA32(aW[ks], bw, xw); xa = MFMA32(aA[ks], ba, xa); }
#pragma unroll
                  for (int g = 0; g < 4; ++g) { const int so = (32 * n + r) * 32 + 4 * ((2 * g + hh) ^ (r & 7));
                      *(f32x4*)(LWt + so) = (f32x4){xw[4 * g], xw[4 * g + 1], xw[4 * g + 2], xw[4 * g + 3]};
                      *(f32x4*)(LAt + so) = (f32x4){xa[4 * g], xa[4 * g + 1], xa[4 * g + 2], xa[4 * g + 3]}; } } }
            float lw[32], la[32];
            { const float w0 = P.w0[c], a0 = P.a0[c];
#pragma unroll
              for (int q = 0; q < 8; ++q) { const int so = lane * 32 + 4 * (q ^ (lane & 7)); const f32x4 wv = *(const f32x4*)(LWt + so), av = *(const f32x4*)(LAt + so);
                  lw[4 * q] = wv.x + w0; lw[4 * q + 1] = wv.y + w0; lw[4 * q + 2] = wv.z + w0; lw[4 * q + 3] = wv.w + w0;
                  la[4 * q] = av.x + a0; la[4 * q + 1] = av.y + a0; la[4 * q + 2] = av.z + a0; la[4 * q + 3] = av.w + a0; } }
            float cwC;
            { float cw = 0.f;
#pragma unroll
              for (int i = 0; i < 32; ++i) { cw += -0.6065306597126334f * sigmoidf_(lw[i]); lw[i] = cw; la[i] = sigmoidf_(la[i]); }
              cwC = cw; }
            const float mr = P.mix[c], mk = P.mix[RW + c], mv = P.mix[2 * RW + c], kkw = P.k_k[c], kaw = P.k_a[c], rkw = P.r_k[c];
            const int h = c >> 6, j = c & 63;
            bf16* XS = (bf16*)LWt;
            { const int ln = lane;
              const bf16* src = p + (size_t)(row0 - 1) * NINP + OFF_SB + h * 64 + (ln & 7) * 8;
              u32x4 tv[3][5];
#pragma unroll
              for (int arr = 0; arr < 3; ++arr)
#pragma unroll
                  for (int q = 0; q < 5; ++q) { const int tok = 8 * q + (ln >> 3); tv[arr][q] = (u32x4){0u, 0u, 0u, 0u};
                      if (tok < 33 && (tb + tok) > 0) tv[arr][q] = *(const u32x4*)(src + (size_t)tok * NINP + arr * RW); }
#pragma unroll
              for (int arr = 0; arr < 3; ++arr)
#pragma unroll
                  for (int q = 0; q < 5; ++q) { const int tok = 8 * q + (ln >> 3); if (tok < 33) *(u32x4*)(XS + (tok * 3 + arr) * 64 + (ln & 7) * 8) = tv[arr][q]; } }
            float pr = bf2f(XS[0 * 64 + j]), pk = bf2f(XS[1 * 64 + j]), pv = bf2f(XS[2 * 64 + j]);
            unsigned char* ch = B.CH + (size_t)((b * NH + h) * NCH + chunk) * CH_STRIDE;
            bf16* AT = (bf16*)(ch + CH_AT); bf16* BT = (bf16*)(ch + CH_BT); bf16* KT = (bf16*)(ch + CH_KT); bf16* RT = (bf16*)(ch + CH_RT); bf16* VR = (bf16*)(ch + CH_VR);
            unsigned bhp[16], khp[16], vtp[16];
            float hold_b = 0.f, hold_k = 0.f, hold_v = 0.f;
#pragma unroll
            for (int i = 0; i < 32; ++i) { const float cr = bf2f(XS[(3 * (i + 1) + 0) * 64 + j]), ck = bf2f(XS[(3 * (i + 1) + 1) * 64 + j]), cv = bf2f(XS[(3 * (i + 1) + 2) * 64 + j]);
                const float r = cr + mr * (pr - cr), k = ck + mk * (pk - ck), v = cv + mv * (pv - cv); pr = cr; pk = ck; pv = cv;
                const float av = la[i];
                float kk = k * kkw;
                kk *= __builtin_amdgcn_rcpf(fmaxf(__builtin_amdgcn_sqrtf(wave_sum(kk * kk)), 1e-12f));
                const float km = k * (1.f + (av - 1.f) * kaw);
                const float be = kk * av;
                const float cwi = lw[i], cwp = i > 0 ? lw[i - 1] : 0.f;
                const float em = __expf(-cwi), eh = __expf(cwC - cwi);
                const float c3 = wave_sum(r * km * rkw);
                AT[i * 64 + j] = (bf16)f2bf(-kk * __expf(cwp)); BT[i * 64 + j] = (bf16)f2bf(be * em); KT[i * 64 + j] = (bf16)f2bf(km * em); RT[i * 64 + j] = (bf16)f2bf(r * __expf(cwi)); VR[i * 64 + j] = (bf16)f2bf(v);
                const float bhv = be * eh, khv = km * eh;
                if (i & 1) { bhp[i >> 1] = cvtpk(hold_b, bhv); khp[i >> 1] = cvtpk(hold_k, khv); vtp[i >> 1] = cvtpk(hold_v, v); } else { hold_b = bhv; hold_k = khv; hold_v = v; }
                if (j == 0) ((float*)(ch + CH_C3))[i] = c3; }
            u32x4* BHT = (u32x4*)(ch + CH_BHT + j * 64); u32x4* KHT = (u32x4*)(ch + CH_KHT + j * 64); u32x4* VT = (u32x4*)(ch + CH_VT + j * 64);
#pragma unroll
            for (int q = 0; q < 4; ++q) { BHT[q] = (u32x4){bhp[4 * q], bhp[4 * q + 1], bhp[4 * q + 2], bhp[4 * q + 3]}; KHT[q] = (u32x4){khp[4 * q], khp[4 * q + 1], khp[4 * q + 2], khp[4 * q + 3]};
                VT[q] = (u32x4){vtp[4 * q], vtp[4 * q + 1], vtp[4 * q + 2], vtp[4 * q + 3]}; }
            ((float*)(ch + CH_ECW))[j] = __expf(cwC);
        }
        else {
            asm volatile("s_waitcnt vmcnt(0)" ::: "memory");
            rwkv_stage1((b * NH + (tl_ >> 6)) * NCH + chunk, B, lds + (tl_ >> 6) * 16384);
        }
    }
    asm volatile("s_waitcnt vmcnt(0)" ::: "memory");
    __syncthreads();
}

#define FMAC(acc, a, b) asm("v_fmac_f32 %0, %1, %2" : "+v"(acc) : "v"(a), "v"(b))
template <int N> __device__ __forceinline__ void sub_pin(f32x4* v) {
    if constexpr (N >= 8) { asm volatile("" : "+v"(v[0]), "+v"(v[1]), "+v"(v[2]), "+v"(v[3]), "+v"(v[4]), "+v"(v[5]), "+v"(v[6]), "+v"(v[7]) :: "memory"); sub_pin<N - 8>(v + 8); }
    else if constexpr (N >= 4) { asm volatile("" : "+v"(v[0]), "+v"(v[1]), "+v"(v[2]), "+v"(v[3]) :: "memory"); sub_pin<N - 4>(v + 4); }
    else if constexpr (N >= 2) { asm volatile("" : "+v"(v[0]), "+v"(v[1]) :: "memory"); sub_pin<N - 2>(v + 2); }
    else if constexpr (N == 1) { asm volatile("" : "+v"(v[0]) :: "memory"); }
}
constexpr int sub_nq(int t) { return t <= 31 ? (t + 3) / 4 : 0; }
template <int T0> __device__ __forceinline__ void sub_load(const float* Lf, f32x4 (&l)[16]) {
#pragma unroll
    for (int q = 0; q < sub_nq(T0); ++q) l[q] = *(const f32x4*)(Lf + T0 * 32 + 4 * (q ^ (T0 & 7)));
#pragma unroll
    for (int q = 0; q < sub_nq(T0 + 1); ++q) l[sub_nq(T0) + q] = *(const f32x4*)(Lf + (T0 + 1) * 32 + 4 * (q ^ ((T0 + 1) & 7)));
}
template <int T> __device__ __forceinline__ void sub_row(const f32x4* l, float (&xp)[32], float (&xq)[32]) {
#pragma unroll
    for (int q = 0; q < sub_nq(T); ++q)
#pragma unroll
        for (int e = 0; e < 4; ++e) { const int s = 4 * q + e; if (s < T) { FMAC(xp[T], l[q][e], xp[s]); FMAC(xq[T], l[q][e], xq[s]); } }
}
template <int T0> __device__ __forceinline__ void sub_step(const float* Lf, float (&xp)[32], float (&xq)[32], f32x4 (&cur)[16]) {
    f32x4 nxt[16];
    if constexpr (T0 + 2 <= 31) sub_load<T0 + 2>(Lf, nxt);
    sub_pin<sub_nq(T0) + sub_nq(T0 + 1)>(cur);
    sub_row<T0>(cur, xp, xq);
    if constexpr (T0 + 1 <= 31) sub_row<T0 + 1>(cur + sub_nq(T0), xp, xq);
    if constexpr (T0 + 2 <= 31) sub_step<T0 + 2>(Lf, xp, xq, nxt);
}
__device__ __forceinline__ void rwkv_stage1(int item, const RwcBuf& B, unsigned char* wl  ) {
    const int TID = tidx();
    const int lane = TID & 63, r = lane & 31, h = lane >> 5;
    const unsigned char* ch = B.CH + (size_t)item * CH_STRIDE; unsigned char* o1 = B.O1 + (size_t)item * O_STRIDE;
    float* Lf = (float*)wl;
    bf16* LakB = (bf16*)(wl + 12288);
    float* GT = (float*)(wl + 4096);
    const bf16* AT = (const bf16*)(ch + CH_AT); const bf16* BT = (const bf16*)(ch + CH_BT); const bf16* KT = (const bf16*)(ch + CH_KT); const bf16* RT = (const bf16*)(ch + CH_RT);
    const bf16* VT = (const bf16*)(ch + CH_VT);
    bfx8 fA[4], fB[4], fK[4], fR[4];
#pragma unroll
    for (int ks = 0; ks < 4; ++ks) { const int o = r * 64 + 16 * ks + 8 * h; fA[ks] = *(const bfx8*)(AT + o); fB[ks] = *(const bfx8*)(BT + o); fK[ks] = *(const bfx8*)(KT + o); fR[ks] = *(const bfx8*)(RT + o); }
    bf16* ATs = (bf16*)(wl + 12288);
    u32x4 atv[4];
#pragma unroll
    for (int q = 0; q < 4; ++q) atv[q] = *(const u32x4*)(AT + (lane + 64 * q) * 8);
    const fx16 zero = {};
    { fx16 x = zero;
#pragma unroll
      for (int ks = 0; ks < 4; ++ks) x = MFMA32(fB[ks], fA[ks], x);
#pragma unroll
      for (int g = 0; g < 4; ++g) { f32x4 w;
#pragma unroll
          for (int e = 0; e < 4; ++e) { const int s = 8 * g + 4 * h + e; w[e] = s < r ? x[4 * g + e] : 0.f; }
          *(f32x4*)(Lf + r * 32 + 4 * ((2 * g + h) ^ (r & 7))) = w; } }
    { fx16 x = zero;
#pragma unroll
      for (int ks = 0; ks < 4; ++ks) x = MFMA32(fK[ks], fA[ks], x);
#pragma unroll
      for (int g = 0; g < 4; ++g) { float w[4];
#pragma unroll
          for (int e = 0; e < 4; ++e) { const int s = 8 * g + 4 * h + e; w[e] = s < r ? x[4 * g + e] : 0.f; }
          *(u32x2*)(LakB + r * 32 + 8 * g + 4 * h) = (u32x2){cvtpk(w[0], w[1]), cvtpk(w[2], w[3])}; } }
    { fx16 x = zero, y = zero;
#pragma unroll
      for (int ks = 0; ks < 4; ++ks) { x = MFMA32(fB[ks], fR[ks], x); y = MFMA32(fK[ks], fR[ks], y); }
      bf16* ARB = (bf16*)(o1 + O_ARB); bf16* ARK = (bf16*)(o1 + O_ARK);
#pragma unroll
      for (int g = 0; g < 4; ++g) { float w[4], z[4];
#pragma unroll
          for (int e = 0; e < 4; ++e) { const int s = 8 * g + 4 * h + e; w[e] = s <= r ? x[4 * g + e] : 0.f; z[e] = s <= r ? y[4 * g + e] : 0.f; }
          *(u32x2*)(ARB + r * 32 + 8 * g + 4 * h) = (u32x2){cvtpk(w[0], w[1]), cvtpk(w[2], w[3])}; *(u32x2*)(ARK + r * 32 + 8 * g + 4 * h) = (u32x2){cvtpk(z[0], z[1]), cvtpk(z[2], z[3])}; } }
#pragma unroll
    for (int n = 0; n < 2; ++n) { fx16 x = zero;
#pragma unroll
        for (int ks = 0; ks < 2; ++ks) { const bfx8 a = *(const bfx8*)(LakB + r * 32 + 16 * ks + 8 * h); const bfx8 bb = *(const bfx8*)(VT + (32 * n + r) * 32 + 16 * ks + 8 * h); x = MFMA32(a, bb, x); }
#pragma unroll
        for (int g = 0; g < 4; ++g) *(f32x4*)(GT + (32 * n + r) * 32 + 4 * ((2 * g + h) ^ (r & 7))) = (f32x4){x[4 * g], x[4 * g + 1], x[4 * g + 2], x[4 * g + 3]}; }
#pragma unroll
    for (int q = 0; q < 4; ++q) *(u32x4*)(ATs + (lane + 64 * q) * 8) = atv[q];
    float xp[32], xq[32];
    { unsigned xu[32];
#pragma unroll
      for (int t = 0; t < 32; ++t) xu[t] = ATs[t * 64 + lane];
#pragma unroll
      for (int g = 0; g < 4; ++g) asm volatile("" : "+v"(xu[8 * g]), "+v"(xu[8 * g + 1]), "+v"(xu[8 * g + 2]), "+v"(xu[8 * g + 3]), "+v"(xu[8 * g + 4]), "+v"(xu[8 * g + 5]), "+v"(xu[8 * g + 6]), "+v"(xu[8 * g + 7]));
#pragma unroll
      for (int t = 0; t < 32; ++t) xp[t] = __builtin_bit_cast(float, xu[t] << 16); }
#pragma unroll
    for (int q = 0; q < 8; ++q) { const f32x4 gv = *(const f32x4*)(GT + lane * 32 + 4 * (q ^ (lane & 7))); xq[4 * q] = gv.x; xq[4 * q + 1] = gv.y; xq[4 * q + 2] = gv.z; xq[4 * q + 3] = gv.w; }
    { f32x4 l0[16]; sub_load<1>(Lf, l0); sub_step<1>(Lf, xp, xq, l0); }
    { bf16* Pg = (bf16*)(o1 + O_P);
#pragma unroll
      for (int t = 0; t < 32; ++t) Pg[t * 64 + lane] = (bf16)f2bf(xp[t]);
      u32x4* Qg = (u32x4*)(o1 + O_QT + lane * 64);
#pragma unroll
      for (int q = 0; q < 4; ++q) Qg[q] = (u32x4){cvtpk(xq[8 * q], xq[8 * q + 1]), cvtpk(xq[8 * q + 2], xq[8 * q + 3]), cvtpk(xq[8 * q + 4], xq[8 * q + 5]), cvtpk(xq[8 * q + 6], xq[8 * q + 7])}; }
}

constexpr int S2_P = 0, S2_QT = 4608, S2_BHT = 9728, S2_KHT = 14848, S2_VT = 19968, S2_ECW = 25088, S2_BUF = 25344;
__device__ __forceinline__ void s2_src_dst(int idx, const unsigned char* ch, const unsigned char* o1, const unsigned char*& src, int& dst) {
    if (idx < 256) { src = o1 + O_P + idx * 16; dst = S2_P + (idx >> 3) * 144 + (idx & 7) * 16; }
    else if (idx < 1280) { const int a = (idx - 256) >> 8, j = (idx - 256) & 255;
        src = (a == 0 ? o1 + O_QT : a == 1 ? ch + CH_BHT : a == 2 ? ch + CH_KHT : ch + CH_VT) + j * 16; dst = S2_QT + a * 5120 + (j >> 2) * 80 + (j & 3) * 16; }
    else { src = ch + CH_ECW + (idx - 1280) * 16; dst = S2_ECW + (idx - 1280) * 16; }
}
__device__ __forceinline__ bfx8 cat8(u32x2 lo, u32x2 hi) { return __builtin_bit_cast(bfx8, (u32x4){lo.x, lo.y, hi.x, hi.y}); }
__device__ __forceinline__ void rwkv_stage2(int bh, const RwcBuf& B, unsigned char* ldsb) {
    const int TID = tidx();
    const int lane = TID & 63, wave = TID >> 6, r = lane & 31, h = lane >> 5, n = wave;
    const unsigned char* chb = B.CH + (size_t)bh * NCH * CH_STRIDE; const unsigned char* o1b = B.O1 + (size_t)bh * NCH * O_STRIDE;
    unsigned char* stb = B.ST + (size_t)bh * NCH * ST_STRIDE;
    u32x4 preA[4], preB[4]; preA[0] = preA[1] = preA[2] = preA[3] = preB[0] = preB[1] = preB[2] = preB[3] = (u32x4){0u, 0u, 0u, 0u};
    const int TS = TID - 128;
#define S2_LOAD(R, cc) { _Pragma("unroll") for (int i = 0; i < 4; ++i) { const int idx = TS + 384 * i; if (TS >= 0 && idx < 1296) { const unsigned char* s_; int d_; s2_src_dst(idx, chb + (size_t)(cc) * CH_STRIDE, o1b + (size_t)(cc) * O_STRIDE, s_, d_); R[i] = *(const u32x4*)s_; } } }
#define S2_WRITE(R, bo) { _Pragma("unroll") for (int i = 0; i < 4; ++i) { const int idx = TS + 384 * i; if (TS >= 0 && idx < 1296) { const unsigned char* s_; int d_; s2_src_dst(idx, chb, o1b, s_, d_); *(u32x4*)(ldsb + (bo) + d_) = R[i]; } } }
    S2_LOAD(preA, 0); S2_WRITE(preA, 0);
    S2_LOAD(preB, 1);
    __syncthreads();
    fx16 S[2]; S[0] = fx16{}; S[1] = fx16{};
    int bcur = 0;
    for (int c2 = 0; c2 < NCH; c2 += 2) {
#pragma unroll
        for (int par = 0; par < 2; ++par) { const int c = c2 + par;
        const unsigned char* cur = ldsb + bcur; const int bnxt = bcur == 2 * S2_BUF ? 0 : bcur + S2_BUF;
        if (c + 2 < NCH) { if (par == 0) S2_LOAD(preA, c + 2) else S2_LOAD(preB, c + 2) }
        if (wave < 2) {
            unsigned char* st = stb + (size_t)c * ST_STRIDE;
            bfx8 sb[4];
#pragma unroll
            for (int ks = 0; ks < 4; ++ks) { const fx16& T = S[ks >> 1]; const int o = 8 * (ks & 1);
                sb[ks] = __builtin_bit_cast(bfx8, (u32x4){cvtpk(T[o], T[o + 1]), cvtpk(T[o + 2], T[o + 3]), cvtpk(T[o + 4], T[o + 5]), cvtpk(T[o + 6], T[o + 7])}); }
            { bf16* Sg = (bf16*)(st + ST_S0);
#pragma unroll
              for (int ks = 0; ks < 4; ++ks) { const u32x4 w = __builtin_bit_cast(u32x4, sb[ks]);
                  *(u32x2*)(Sg + (32 * n + r) * 64 + 16 * ks + 4 * h) = (u32x2){w.x, w.y}; *(u32x2*)(Sg + (32 * n + r) * 64 + 16 * ks + 8 + 4 * h) = (u32x2){w.z, w.w}; } }
            fx16 U;
            { const bf16* QTl = (const bf16*)(cur + S2_QT);
#pragma unroll
              for (int g = 0; g < 4; ++g) { const u32x2 q2 = *(const u32x2*)(QTl + (32 * n + r) * 40 + 8 * g + 4 * h); U[4 * g] = bflo(q2.x); U[4 * g + 1] = bfhi(q2.x); U[4 * g + 2] = bflo(q2.y); U[4 * g + 3] = bfhi(q2.y); } }
            { const bf16* Pl = (const bf16*)(cur + S2_P);
#pragma unroll
              for (int ks = 0; ks < 4; ++ks) { const bfx8 pa = cat8(*(const u32x2*)(Pl + r * 72 + 16 * ks + 4 * h), *(const u32x2*)(Pl + r * 72 + 16 * ks + 8 + 4 * h)); U = MFMA32(pa, sb[ks], U); } }
            bfx8 ub[2];
#pragma unroll
            for (int ks = 0; ks < 2; ++ks) { const int o = 8 * ks; ub[ks] = __builtin_bit_cast(bfx8, (u32x4){cvtpk(U[o], U[o + 1]), cvtpk(U[o + 2], U[o + 3]), cvtpk(U[o + 4], U[o + 5]), cvtpk(U[o + 6], U[o + 7])}); }
            { bf16* Ug = (bf16*)(st + ST_UT);
#pragma unroll
              for (int ks = 0; ks < 2; ++ks) { const u32x4 w = __builtin_bit_cast(u32x4, ub[ks]);
                  *(u32x2*)(Ug + (32 * n + r) * 32 + 16 * ks + 4 * h) = (u32x2){w.x, w.y}; *(u32x2*)(Ug + (32 * n + r) * 32 + 16 * ks + 8 + 4 * h) = (u32x2){w.z, w.w}; } }
            const bf16* BHl = (const bf16*)(cur + S2_BHT); const bf16* KHl = (const bf16*)(cur + S2_KHT); const bf16* VTl = (const bf16*)(cur + S2_VT); const float* El = (const float*)(cur + S2_ECW);
            bfx8 vb[2];
#pragma unroll
            for (int ks = 0; ks < 2; ++ks) vb[ks] = *(const bfx8*)(VTl + (32 * n + r) * 40 + 16 * ks + 8 * h);
#pragma unroll
            for (int m = 0; m < 2; ++m) { fx16 acc;
#pragma unroll
                for (int g = 0; g < 4; ++g) { const f32x4 e4 = *(const f32x4*)(El + 32 * m + 8 * g + 4 * h); acc[4 * g] = S[m][4 * g] * e4.x; acc[4 * g + 1] = S[m][4 * g + 1] * e4.y; acc[4 * g + 2] = S[m][4 * g + 2] * e4.z; acc[4 * g + 3] = S[m][4 * g + 3] * e4.w; }
#pragma unroll
                for (int ks = 0; ks < 2; ++ks) { const bfx8 ba = cat8(*(const u32x2*)(BHl + (32 * m + r) * 40 + 16 * ks + 4 * h), *(const u32x2*)(BHl + (32 * m + r) * 40 + 16 * ks + 8 + 4 * h));
                    const bfx8 ka = *(const bfx8*)(KHl + (32 * m + r) * 40 + 16 * ks + 8 * h);
                    acc = MFMA32(ba, ub[ks], acc); acc = MFMA32(ka, vb[ks], acc); }
                S[m] = acc; }
        }
        if (c + 1 < NCH) { if (par == 0) S2_WRITE(preB, bnxt) else S2_WRITE(preA, bnxt) }
        __syncthreads();
        bcur = bnxt; }
    }
#undef S2_LOAD
#undef S2_WRITE
}

__device__ __forceinline__ void rwkv_stage3(int item, const bf16* __restrict__ p, const RwkvP& P, const RwcBuf& B, bf16* ybuf, unsigned char* wl) {
    const int TID = tidx();
    const int lane = TID & 63, r = lane & 31, h = lane >> 5;
    const int bh = item / NCH, chunk = item % NCH, b = bh / NH, hd = bh % NH;
    const unsigned char* ch = B.CH + (size_t)item * CH_STRIDE; const unsigned char* o1 = B.O1 + (size_t)item * O_STRIDE; const unsigned char* st = B.ST + (size_t)item * ST_STRIDE;
    const bf16* Sg = (const bf16*)(st + ST_S0); const bf16* UT = (const bf16*)(st + ST_UT);
    float* Yf = (float*)wl;
    const bf16* ARB = (const bf16*)(o1 + O_ARB); const bf16* ARK = (const bf16*)(o1 + O_ARK);
    const bf16* RT = (const bf16*)(ch + CH_RT); const bf16* VT = (const bf16*)(ch + CH_VT); const bf16* VR = (const bf16*)(ch + CH_VR);
    bfx8 fR[4], fArb[2], fArk[2], sbf[2][4], ubf[2][2], vbf[2][2];
#pragma unroll
    for (int ks = 0; ks < 4; ++ks) fR[ks] = *(const bfx8*)(RT + r * 64 + 16 * ks + 8 * h);
#pragma unroll
    for (int ks = 0; ks < 2; ++ks) { fArb[ks] = *(const bfx8*)(ARB + r * 32 + 16 * ks + 8 * h); fArk[ks] = *(const bfx8*)(ARK + r * 32 + 16 * ks + 8 * h); }
#pragma unroll
    for (int n = 0; n < 2; ++n) {
#pragma unroll
        for (int ks = 0; ks < 4; ++ks) sbf[n][ks] = *(const bfx8*)(Sg + (32 * n + r) * 64 + 16 * ks + 8 * h);
#pragma unroll
        for (int ks = 0; ks < 2; ++ks) { ubf[n][ks] = *(const bfx8*)(UT + (32 * n + r) * 32 + 16 * ks + 8 * h); vbf[n][ks] = *(const bfx8*)(VT + (32 * n + r) * 32 + 16 * ks + 8 * h); } }
#pragma unroll
    for (int n = 0; n < 2; ++n) { fx16 y = {};
#pragma unroll
        for (int ks = 0; ks < 4; ++ks) y = MFMA32(fR[ks], sbf[n][ks], y);
#pragma unroll
        for (int ks = 0; ks < 2; ++ks) { y = MFMA32(fArb[ks], ubf[n][ks], y); y = MFMA32(fArk[ks], vbf[n][ks], y); }
#pragma unroll
        for (int reg = 0; reg < 16; ++reg) Yf[crow16(reg, h) * 68 + 32 * n + r] = y[reg]; }
    { const int t = lane >> 1, hf = lane & 1; const float* yr = Yf + t * 68 + 32 * hf; float yv[32]; float s = 0.f;
#pragma unroll
      for (int q = 0; q < 8; ++q) { const f32x4 v4 = *(const f32x4*)(yr + 4 * q); yv[4 * q] = v4.x; yv[4 * q + 1] = v4.y; yv[4 * q + 2] = v4.z; yv[4 * q + 3] = v4.w; s += (v4.x + v4.y) + (v4.z + v4.w); }
      s += dpp0<0xB1, 0xf>(s); const float mu = s * (1.f / 64.f); float q2 = 0.f;
#pragma unroll
      for (int i = 0; i < 32; ++i) { yv[i] -= mu; q2 += yv[i] * yv[i]; }
      q2 += dpp0<0xB1, 0xf>(q2); const float rstd = rsqrtf(q2 * (1.f / 64.f) + 64e-5f);
      const float c3 = ((const float*)(ch + CH_C3))[t];
      const size_t row = (size_t)(b * SEQ + chunk * RC + t); const int c0 = hd * HD + 32 * hf;
      const u32x4* vr = (const u32x4*)(VR + t * 64 + 32 * hf); const u32x4* gp = (const u32x4*)(p + row * NINP + OFF_GB + c0); u32x4* yo = (u32x4*)(ybuf + row * DM + LRU_W + c0);
      const f32x4* lwp = (const f32x4*)(P.ln_w + c0); const f32x4* lbp = (const f32x4*)(P.ln_b + c0);
      u32x4 vvq[4], ggq[4]; f32x4 lwq[8], lbq[8];
#pragma unroll
      for (int q = 0; q < 4; ++q) { vvq[q] = vr[q]; ggq[q] = gp[q]; lwq[2 * q] = lwp[2 * q]; lwq[2 * q + 1] = lwp[2 * q + 1]; lbq[2 * q] = lbp[2 * q]; lbq[2 * q + 1] = lbp[2 * q + 1]; }
      asm volatile("" : "+v"(vvq[0]), "+v"(vvq[1]), "+v"(vvq[2]), "+v"(vvq[3]), "+v"(ggq[0]), "+v"(ggq[1]), "+v"(ggq[2]), "+v"(ggq[3]));
      asm volatile("" : "+v"(lwq[0]), "+v"(lwq[1]), "+v"(lwq[2]), "+v"(lwq[3]), "+v"(lwq[4]), "+v"(lwq[5]), "+v"(lwq[6]), "+v"(lwq[7]));
      asm volatile("" : "+v"(lbq[0]), "+v"(lbq[1]), "+v"(lbq[2]), "+v"(lbq[3]), "+v"(lbq[4]), "+v"(lbq[5]), "+v"(lbq[6]), "+v"(lbq[7]));
#pragma unroll
      for (int q = 0; q < 4; ++q) { const u32x4 vv = vvq[q], gg = ggq[q]; const f32x4 w0 = lwq[2 * q], w1 = lwq[2 * q + 1], b0 = lbq[2 * q], b1 = lbq[2 * q + 1]; u32x4 o;
          const float wv[8] = {w0.x, w0.y, w0.z, w0.w, w1.x, w1.y, w1.z, w1.w}, bv[8] = {b0.x, b0.y, b0.z, b0.w, b1.x, b1.y, b1.z, b1.w};
#pragma unroll
          for (int e = 0; e < 4; ++e) { const float v0 = bflo(vv[e]), v1 = bfhi(vv[e]), g0 = bflo(gg[e]), g1 = bfhi(gg[e]);
              const float y0 = yv[8 * q + 2 * e] * rstd * wv[2 * e] + bv[2 * e] + c3 * v0, y1 = yv[8 * q + 2 * e + 1] * rstd * wv[2 * e + 1] + bv[2 * e + 1] + c3 * v1;
              o[e] = cvtpk(y0 * siluf_(g0), y1 * siluf_(g1)); }
          yo[q] = o; } }
}


__device__ __forceinline__ void phase_moba_kmean(const bf16* p, float* kmean, int vbid, int vgrid) {
    const int TID = tidx();
    const int lane = TID & 63, wave = TID >> 6;
    for (int item = vbid * NWAVES + wave; item < NB * NH * NBLK; item += vgrid * NWAVES) {
        const int n = item % NBLK, bh = item / NBLK, b = bh / NH, h = bh % NH;
        const bf16* kp = p + (size_t)(b * SEQ + n * BLK + (lane >> 3)) * NINP + OFF_QKV + MOW + h * HD + (lane & 7) * 8;
        float s[8];
#pragma unroll
        for (int e = 0; e < 8; ++e) s[e] = 0.f;
#pragma unroll
        for (int half = 0; half < 2; ++half) { u32x4 v[16];
#pragma unroll
            for (int q = 0; q < 16; ++q) v[q] = *(const u32x4*)(kp + (size_t)(8 * (16 * half + q)) * NINP);
#pragma unroll
            for (int q = 0; q < 16; ++q)
#pragma unroll
                for (int e = 0; e < 4; ++e) { s[2 * e] += bflo(v[q][e]); s[2 * e + 1] += bfhi(v[q][e]); } }
#pragma unroll
        for (int e = 0; e < 8; ++e) { s[e] += dpp0<0x128, 0xf>(s[e]);
            s[e] += __builtin_bit_cast(float, __builtin_amdgcn_ds_swizzle(__builtin_bit_cast(int, s[e]), 0x401F));
            float a_ = s[e], b_ = s[e]; asm volatile("s_nop 1\n\tv_permlane32_swap_b32 %0, %1" : "+v"(a_), "+v"(b_)); s[e] = a_ + b_; }
        if (lane < 8) { float* dst = kmean + ((size_t)bh * NBLK + n) * HD + lane * 8;
            *(f32x4*)dst = (f32x4){s[0], s[1], s[2], s[3]} * (1.f / BLK); *(f32x4*)(dst + 4) = (f32x4){s[4], s[5], s[6], s[7]} * (1.f / BLK); }
    }
}
namespace attn_body {
using bf16=__hip_bfloat16;
using bf16x8=__attribute__((ext_vector_type(8)))short;
using s16x4=__attribute__((ext_vector_type(4)))short;
using f32x16=__attribute__((ext_vector_type(16)))float;
using u32x4=__attribute__((ext_vector_type(4)))unsigned;
using f32x4v=__attribute__((ext_vector_type(4)))float;
constexpr int BATCH=2,NHEAD=12,SEQ=4096,D=64,DM=7424;
constexpr int YP=2048, QCOL=4224, KCOL=4224+768, VCOL=4224+1536, GCOL=6528, YCOL=1280;
constexpr int NW=8,QBLK=32,QB=QBLK*NW,KVBLK=64,NQB=SEQ/QB;
constexpr int ATTN_PITCH=DM, ATTN_UNIT_ROWS=QB;
__device__ __forceinline__ int crow(int r,int hi){return (r&3)+8*(r>>2)+4*hi;}
#define SBAR() __builtin_amdgcn_sched_barrier(0)
__device__ __forceinline__ void moba_hook(f32x16&p0,f32x16&p1,int t,int NT,int qrel,int hi,unsigned selbits,const float*tab){
  const float NEG=-INFINITY;
  asm volatile("":"+v"(qrel));
  const int jb=t-(NT-4);
  if(t>=NT-6){
    const bool keep=jb>=0?true:(((selbits>>(t>>2))&1u)!=0u);
    const int dq=qrel-64*jb-4*hi;
    #pragma unroll
    for(int g=0;g<4;++g){
      #pragma unroll
      for(int rr=0;rr<4;++rr){ const int r=4*g+rr; const int d0=dq-((r&3)+8*(r>>2)), d1=d0-32;
        const int i0=d0<0?0:(d0<127?d0:127), i1=d1<0?0:(d1<127?d1:127);
        const float b0=tab[i0], b1=tab[i1];
        p0[r]=(keep&&d0>=0)?p0[r]+b0:NEG; p1[r]=(keep&&d1>=0)?p1[r]+b1:NEG; }
      asm volatile("":"+v"(p0),"+v"(p1)); SBAR();
    }
  } else {
    const bool keep=(selbits>>(t>>2))&1u;
    #pragma unroll
    for(int r=0;r<16;++r){p0[r]=keep?p0[r]:NEG; p1[r]=keep?p1[r]:NEG;}
  }
}
__device__ __forceinline__ void swap32(float&a,float&b){asm volatile("s_nop 1\n\tv_permlane32_swap_b32 %0, %1":"+v"(a),"+v"(b));}

constexpr int NSLOT=3, SLOTB=8192;
constexpr int LDS_K=0, LDS_V=NSLOT*SLOTB, LDS_WS=2*NSLOT*SLOTB, LDS_OST=LDS_WS+NW*64*4, LDS_TAB=LDS_OST+NW*4096, LDS_BYTES=LDS_TAB+512;
constexpr float C2=0.125f*1.4426950408889634f;
__device__ __forceinline__ void glds16(const void*gsrc,unsigned lds_dst){unsigned keep;
  asm volatile("s_mov_b32 %0, m0\n\ts_mov_b32 m0, %2\n\ts_nop 0\n\tglobal_load_lds_dwordx4 %1, off\n\ts_mov_b32 m0, %0":"=&s"(keep):"v"(gsrc),"s"(lds_dst):"memory");}
__device__ __forceinline__ float max3f(float a,float b,float c){float r;asm("v_max3_f32 %0, %1, %2, %3":"=v"(r):"v"(a),"v"(b),"v"(c));return r;}
__device__ __forceinline__ float max2f(float a,float b){float r;asm("v_max_f32_e32 %0, %1, %2":"=v"(r):"v"(a),"v"(b));return r;}
__device__ __forceinline__ float fadd_s(float a,float b){float r;asm("v_add_f32_e32 %0, %1, %2":"=v"(r):"v"(a),"v"(b));return r;}
__device__ __forceinline__ float fsub_s(float a,float b){float r;asm("v_sub_f32_e32 %0, %1, %2":"=v"(r):"v"(a),"v"(b));return r;}
typedef float f32x2_t __attribute__((ext_vector_type(2))); typedef __bf16 bf16x2_t __attribute__((ext_vector_type(2)));
__device__ __forceinline__ unsigned cvtpk_s(float lo,float hi){f32x2_t v={lo,hi};bf16x2_t b=__builtin_convertvector(v,bf16x2_t);return __builtin_bit_cast(unsigned,b);}
#define WAIT_BAR(N) asm volatile("s_waitcnt vmcnt(" #N ") lgkmcnt(0)\n\ts_barrier":::"memory")

__device__ __forceinline__ void qkt(f32x16&p0,f32x16&p1,const char*Kslot,const bf16x8*qr,const f32x16&negm,int r32,int hi){
  const char*kb=Kslot+hi*1024+r32*16;
  #pragma unroll
  for(int d0=0;d0<4;++d0){
    const bf16x8 b0=*reinterpret_cast<const bf16x8*>(kb+d0*2048);
    const bf16x8 b1=*reinterpret_cast<const bf16x8*>(kb+d0*2048+512);
    if(d0==0){p0=__builtin_amdgcn_mfma_f32_32x32x16_bf16(b0,qr[0],negm,0,0,0);p1=__builtin_amdgcn_mfma_f32_32x32x16_bf16(b1,qr[0],negm,0,0,0);}
    else{p0=__builtin_amdgcn_mfma_f32_32x32x16_bf16(b0,qr[d0],p0,0,0,0);p1=__builtin_amdgcn_mfma_f32_32x32x16_bf16(b1,qr[d0],p1,0,0,0);}}
}
typedef __attribute__((address_space(3))) const char* lds_cptr;
typedef short v4i16_t __attribute__((ext_vector_type(4)));
__device__ __forceinline__ void kload8(bf16x8*kf,lds_cptr kp){
  kf[0]=*(const __attribute__((address_space(3))) bf16x8*)(kp);      kf[1]=*(const __attribute__((address_space(3))) bf16x8*)(kp+512);
  kf[2]=*(const __attribute__((address_space(3))) bf16x8*)(kp+2048); kf[3]=*(const __attribute__((address_space(3))) bf16x8*)(kp+2560);
  kf[4]=*(const __attribute__((address_space(3))) bf16x8*)(kp+4096); kf[5]=*(const __attribute__((address_space(3))) bf16x8*)(kp+4608);
  kf[6]=*(const __attribute__((address_space(3))) bf16x8*)(kp+6144); kf[7]=*(const __attribute__((address_space(3))) bf16x8*)(kp+6656);
}
__device__ __forceinline__ void kload2(bf16x8*kf,lds_cptr kp,int j){ kf[2*j]=*(const __attribute__((address_space(3))) bf16x8*)(kp+j*2048); kf[2*j+1]=*(const __attribute__((address_space(3))) bf16x8*)(kp+j*2048+512); }
__device__ __forceinline__ s16x4 vtr(lds_cptr p){ return __builtin_bit_cast(s16x4,__builtin_amdgcn_ds_read_tr16_b64_v4i16((__attribute__((address_space(3))) v4i16_t*)p)); }
__device__ __forceinline__ float rowmax(const f32x16&p0,const f32x16&p1){
  float a=max3f(p0[0],p0[1],p1[0]),b=max3f(p0[2],p0[3],p1[1]);a=max3f(a,p1[2],p1[3]);
  #pragma unroll
  for(int r=4;r<16;r+=4){a=max3f(a,p0[r],p0[r+1]);b=max3f(b,p0[r+2],p0[r+3]);a=max3f(a,p1[r],p1[r+1]);b=max3f(b,p1[r+2],p1[r+3]);}
  float m=max2f(a,b), m2=m; swap32(m,m2);
  return max2f(m,m2);
}
__device__ __forceinline__ void pv(f32x16*o,int vb,bf16x8 pa0,bf16x8 pa1,bf16x8 pa2,bf16x8 pa3){
  #pragma unroll
  for(int d0=0;d0<2;++d0){s16x4 lo[4],hi[4];
    #pragma unroll
    for(int ks=0;ks<4;++ks){
      asm volatile("ds_read_b64_tr_b16 %0,%1 offset:%c2":"=&v"(lo[ks]):"v"(vb),"i"(d0*4096+ks*1024):"memory");
      asm volatile("ds_read_b64_tr_b16 %0,%1 offset:%c2":"=&v"(hi[ks]):"v"(vb),"i"(d0*4096+ks*1024+512):"memory");}
    asm volatile("s_waitcnt lgkmcnt(0)":::"memory");SBAR();
    #define PK(k) (bf16x8){lo[k][0],lo[k][1],lo[k][2],lo[k][3],hi[k][0],hi[k][1],hi[k][2],hi[k][3]}
    o[d0]=__builtin_amdgcn_mfma_f32_32x32x16_bf16(pa0,PK(0),o[d0],0,0,0);
    o[d0]=__builtin_amdgcn_mfma_f32_32x32x16_bf16(pa1,PK(1),o[d0],0,0,0);
    o[d0]=__builtin_amdgcn_mfma_f32_32x32x16_bf16(pa2,PK(2),o[d0],0,0,0);
    o[d0]=__builtin_amdgcn_mfma_f32_32x32x16_bf16(pa3,PK(3),o[d0],0,0,0);
    #undef PK
  }
}

#ifndef ATTN_STORE16
#define ATTN_STORE16(p,v) (*(u32x4*)(p)=(v))
#endif
template<int THRL> __device__ __forceinline__ void attn_unit(int b,int h,int qb,const bf16*__restrict__ Pq,const float*__restrict__ kmean_bh,const float*__restrict__ rel_bias,bf16*__restrict__ Yo,char*shm,unsigned*qctr,int nslot){
  int tid_=threadIdx.x; asm volatile("":"+v"(tid_)); const int tid=tid_,lane=tid&63,r32=lane&31,hi=lane>>5; const int wid=__builtin_amdgcn_readfirstlane(tid>>6);
  const long rowbase=(long)b*SEQ; const int q0=qb*QB;
  const bf16*Qw=Pq+(rowbase+q0+wid*QBLK)*DM+QCOL+h*D;
  const bf16*Kh=Pq+rowbase*DM+KCOL+h*D,*Vh=Pq+rowbase*DM+VCOL+h*D;
  float*tab=(float*)(shm+LDS_TAB);
  const unsigned lds0=(unsigned)(uintptr_t)shm;
  float*wsf=(float*)(shm+LDS_WS)+wid*64;
  const bf16*ksrc=Kh+(long)lane*DM+wid*8;
  const bf16*vsrc=Vh+(long)(16*(wid&3)+(lane>>2))*DM+(wid>>2)*32+(lane&3)*8;
  const unsigned kdst=lds0+LDS_K+wid*1024, vdst=lds0+LDS_V+wid*1024;
  #define DMA_K(t,slot) glds16(ksrc+(long)(t)*KVBLK*DM,(unsigned)__builtin_amdgcn_readfirstlane(kdst+(slot)))
  #define DMA_V(t,slot) glds16(vsrc+(long)(t)*KVBLK*DM,(unsigned)__builtin_amdgcn_readfirstlane(vdst+(slot)))
  const int vb0=(int)(lds0+LDS_V)+((lane>>4)&1)*32+(lane&3)*8+(4*hi+((lane&15)>>2))*64;
  const char*Kbase=shm+LDS_K; bf16x8 kf[8];
  const lds_cptr shm3=(lds_cptr)shm; const lds_cptr kp0=shm3+LDS_K+hi*1024+r32*16; const lds_cptr vp0=shm3+LDS_V+((lane>>4)&1)*32+(lane&3)*8+(4*hi+((lane&15)>>2))*64;
  const int NT=(q0+QB)/KVBLK;
  DMA_K(0,0);DMA_V(0,0);DMA_K(1,SLOTB);
  bf16x8 qr[4];
  #pragma unroll
  for(int d0=0;d0<4;++d0)qr[d0]=*reinterpret_cast<const bf16x8*>(&Qw[(long)r32*DM+d0*16+hi*8]);
  if(tid<128){ const int n=tid; int bk=n; if(n>=16){ bk=16+(int)(logf((float)n/16.f)/2.0794415416798357f*16.f); bk=bk<31?bk:31; }
    tab[n]=(rel_bias[bk*NHEAD+h]-rel_bias[31*NHEAD+h])*1.4426950408889634f; }
  unsigned selbits=0u;
  { float qf[32];
    #pragma unroll
    for(int d0=0;d0<4;++d0){
      #pragma unroll
      for(int j=0;j<8;++j)qf[8*d0+j]=__uint_as_float(((unsigned)(unsigned short)qr[d0][j])<<16); }
    int s0=-1,s1=-1,s2=-1; float g0=-INFINITY,g1=-INFINITY,g2=-INFINITY;
    for(int n=0;n<qb;++n){ const float*km=kmean_bh+n*64+8*hi; float g=0.f;
      #pragma unroll
      for(int d0=0;d0<4;++d0){ const f32x4v k0=*(const f32x4v*)(km+16*d0), k1=*(const f32x4v*)(km+16*d0+4);
        g+=qf[8*d0+0]*k0[0]+qf[8*d0+1]*k0[1]+qf[8*d0+2]*k0[2]+qf[8*d0+3]*k0[3]+qf[8*d0+4]*k1[0]+qf[8*d0+5]*k1[1]+qf[8*d0+6]*k1[2]+qf[8*d0+7]*k1[3]; }
      float g_=g; swap32(g,g_); g=g+g_;
      if(g>g0){g2=g1;s2=s1;g1=g0;s1=s0;g0=g;s0=n;} else if(g>g1){g2=g1;s2=s1;g1=g;s1=n;} else if(g>g2){g2=g;s2=n;} }
    if(s0>=0)selbits|=1u<<s0; if(s1>=0)selbits|=1u<<s1; if(s2>=0)selbits|=1u<<s2; }
  float mhat=0.f,l_reg=0.f;f32x16 o[2];o[0]=f32x16{};o[1]=f32x16{};f32x16 negm=f32x16{};asm volatile("":"+v"(negm));
  const int qrel=wid*QBLK+r32;
  #define CMASK(P0,P1,t) moba_hook(P0,P1,t,NT,qrel,hi,selbits,tab)
  bool resc=false;
  #define START(P0,P1) do{ const float rm=rowmax(P0,P1); resc=false; \
    { const float dl=rm<-1e30f?-1024.f:rm; mhat=fadd_s(mhat,dl); \
      _Pragma("unroll") for(int r=0;r<16;++r){P0[r]=fsub_s(P0[r],dl);P1[r]=fsub_s(P1[r],dl);} \
      _Pragma("unroll") for(int r=0;r<16;++r)negm[r]=-mhat; asm volatile("":"+v"(negm)); } \
    _Pragma("unroll") for(int r=0;r<16;++r)P0[r]=__builtin_amdgcn_exp2f(P0[r]); }while(0)
  #define RESC() do{ if(resc){ asm volatile("s_waitcnt lgkmcnt(0)":::"memory"); \
      _Pragma("unroll") for(int d_=0;d_<2;++d_) _Pragma("unroll") for(int r=0;r<16;++r)o[d_][r]*=wsf[crow(r,hi)]; } }while(0)
  f32x16 pA0,pA1,pB0,pB1;
  int sl_prev=0,sl_cur=0,sl_next=SLOTB;
  #define ROT() do{sl_prev=sl_cur;sl_cur=sl_next;sl_next=(sl_next==(NSLOT-1)*SLOTB)?0:sl_next+SLOTB;}while(0)
  DMA_K(2,2*SLOTB);
  if(tid==448){ const unsigned nx_=__hip_atomic_fetch_add(qctr,1u,__ATOMIC_RELAXED,__HIP_MEMORY_SCOPE_AGENT); *(volatile __attribute__((address_space(3))) unsigned*)(lds0+131072u+320u+4u*(unsigned)nslot)=nx_; }
  WAIT_BAR(3);
  qkt(pA0,pA1,Kbase,qr,negm,r32,hi);asm volatile("s_nop 15\n\ts_nop 7":"+v"(pA0),"+v"(pA1));CMASK(pA0,pA1,0);
  START(pA0,pA1);
  _Pragma("unroll") for(int r=0;r<16;++r)pA1[r]=__builtin_amdgcn_exp2f(pA1[r]);
  WAIT_BAR(0);
  DMA_K(3,0);DMA_V(1,SLOTB);
  ROT();
  kload8(kf,kp0+sl_cur);
  WAIT_BAR(2);
  s16x4 vlo[8],vhi[8]; u32x4 pw0,pw1,pw2,pw3;
  #define PKW(P,B) cvtpk_s(P[B],P[B+1])
  #define PAF(k) __builtin_bit_cast(bf16x8,pw##k)
  #define VFR(i) (bf16x8){vlo[i][0],vlo[i][1],vlo[i][2],vlo[i][3],vhi[i][0],vhi[i][1],vhi[i][2],vhi[i][3]}
  #define PIN(x) asm volatile("":"+v"(x))
  #define MX3(a,b,c) __builtin_fmaxf(__builtin_fmaxf((a),(b)),(c))
  #define GAPA(MF,A0,A1,A2,A3,W0,W1,PW) do{ MF; sacc+=A0; sacc+=A1; sacc+=A2; sacc+=A3; PIN(sacc); W0; W1; PIN(PW); SBAR(); }while(0)
  #define EX(v) __builtin_amdgcn_exp2f(v)
  #define GAPB(MF,X,B) do{ MF; X[B]=EX(X[B]); X[B+1]=EX(X[B+1]); X[B+2]=EX(X[B+2]); X[B+3]=EX(X[B+3]); PIN(X); SBAR(); }while(0)
  #define VRD(i) do{ vlo[i]=vtr(vp_+(((i)>>2)*4096+((i)&3)*1024)); vhi[i]=vtr(vp_+(((i)>>2)*4096+((i)&3)*1024+512)); }while(0)
  #define KRD(G,j) do{ if(G){ kload2(kf,kp0+sl_next,j); SBAR(); } }while(0)
  #define STEP(C0,C1,P0,P1,t,GK,GV,GL) do{ SBAR(); \
    const lds_cptr vp_=vp0+sl_prev; \
    VRD(0); SBAR(); float sacc=(P0[0]+P0[1]); \
    GAPA(C0=__builtin_amdgcn_mfma_f32_32x32x16_bf16(kf[0],qr[0],negm,0,0,0), P0[2],P0[3],P0[4],P0[5],     pw0[0]=PKW(P0,0), pw0[1]=PKW(P0,2), pw0); \
    VRD(4); SBAR(); GAPA(C1=__builtin_amdgcn_mfma_f32_32x32x16_bf16(kf[1],qr[0],negm,0,0,0), P0[6],P0[7],P0[8],P0[9],     pw0[2]=PKW(P0,4), pw0[3]=PKW(P0,6), pw0); \
    VRD(1); SBAR(); GAPA(C0=__builtin_amdgcn_mfma_f32_32x32x16_bf16(kf[2],qr[1],C0,0,0,0),   P0[10],P0[11],P0[12],P0[13], pw1[0]=PKW(P0,8), pw1[1]=PKW(P0,10), pw1); \
    VRD(5); SBAR(); GAPA(C1=__builtin_amdgcn_mfma_f32_32x32x16_bf16(kf[3],qr[1],C1,0,0,0),   P0[14],P0[15],P1[0],P1[1],   pw1[2]=PKW(P0,12),pw1[3]=PKW(P0,14), pw1); \
    VRD(2); SBAR(); GAPA(C0=__builtin_amdgcn_mfma_f32_32x32x16_bf16(kf[4],qr[2],C0,0,0,0),   P1[2],P1[3],P1[4],P1[5],     pw2[0]=PKW(P1,0), pw2[1]=PKW(P1,2), pw2); \
    VRD(6); SBAR(); GAPA(C1=__builtin_amdgcn_mfma_f32_32x32x16_bf16(kf[5],qr[2],C1,0,0,0),   P1[6],P1[7],P1[8],P1[9],     pw2[2]=PKW(P1,4), pw2[3]=PKW(P1,6), pw2); \
    VRD(3); SBAR(); GAPA(C0=__builtin_amdgcn_mfma_f32_32x32x16_bf16(kf[6],qr[3],C0,0,0,0),   P1[10],P1[11],P1[12],P1[13], pw3[0]=PKW(P1,8), pw3[1]=PKW(P1,10), pw3); \
    VRD(7); SBAR(); GAPA(C1=__builtin_amdgcn_mfma_f32_32x32x16_bf16(kf[7],qr[3],C1,0,0,0),   P1[14],P1[15],0.f,0.f,       pw3[2]=PKW(P1,12),pw3[3]=PKW(P1,14), pw3); \
    l_reg+=sacc; \
    if(GK){DMA_K((t)+3,sl_cur);} if(GV){DMA_V((t)+1,sl_next);} \
    CMASK(C0,C1,t); \
    { float a=MX3(C0[0],C0[1],C1[0]),b=MX3(C0[2],C0[3],C1[1]); a=MX3(a,C1[2],C1[3]); \
      _Pragma("unroll") for(int r=4;r<16;r+=4){a=MX3(a,C0[r],C0[r+1]);b=MX3(b,C0[r+2],C0[r+3]);a=MX3(a,C1[r],C1[r+1]);b=MX3(b,C1[r+2],C1[r+3]);} \
      float rm=__builtin_fmaxf(a,b); { float rm2_=rm; swap32(rm,rm2_); rm=__builtin_fmaxf(rm,rm2_); } \
      resc=false; \
      if(__builtin_expect(__any(rm>(float)THRL),0)){ const float dl=__builtin_fmaxf(rm,0.f); mhat+=dl; \
        _Pragma("unroll") for(int r=0;r<16;++r){C0[r]-=dl;C1[r]-=dl;} \
        _Pragma("unroll") for(int r=0;r<16;++r)negm[r]=-mhat; asm volatile("":"+v"(negm)); \
        const float f=__builtin_amdgcn_exp2f(-dl); l_reg*=f; if(hi==0)wsf[r32]=f; resc=true; } } \
    SBAR(); \
    GAPB(o[0]=__builtin_amdgcn_mfma_f32_32x32x16_bf16(PAF(0),VFR(0),o[0],0,0,0), C0,0); \
    GAPB(o[1]=__builtin_amdgcn_mfma_f32_32x32x16_bf16(PAF(0),VFR(4),o[1],0,0,0), C0,4); \
    KRD(GL,0); GAPB(o[0]=__builtin_amdgcn_mfma_f32_32x32x16_bf16(PAF(1),VFR(1),o[0],0,0,0), C0,8); \
    KRD(GL,1); GAPB(o[1]=__builtin_amdgcn_mfma_f32_32x32x16_bf16(PAF(1),VFR(5),o[1],0,0,0), C0,12); \
    KRD(GL,2); GAPB(o[0]=__builtin_amdgcn_mfma_f32_32x32x16_bf16(PAF(2),VFR(2),o[0],0,0,0), C1,0); \
    KRD(GL,3); GAPB(o[1]=__builtin_amdgcn_mfma_f32_32x32x16_bf16(PAF(2),VFR(6),o[1],0,0,0), C1,4); \
    GAPB(o[0]=__builtin_amdgcn_mfma_f32_32x32x16_bf16(PAF(3),VFR(3),o[0],0,0,0), C1,8); \
    GAPB(o[1]=__builtin_amdgcn_mfma_f32_32x32x16_bf16(PAF(3),VFR(7),o[1],0,0,0), C1,12); \
    }while(0)
  int t=1;
  for(;t+5<NT;t+=2){
    STEP(pB0,pB1,pA0,pA1,t,true,true,true);     WAIT_BAR(2); RESC(); ROT();
    STEP(pA0,pA1,pB0,pB1,t+1,true,true,true);   WAIT_BAR(2); RESC(); ROT();
  }
  #define ENDW(tt) do{ if((tt)+3<NT){WAIT_BAR(2);} else if((tt)+2<NT){WAIT_BAR(1);} else {WAIT_BAR(0);} }while(0)
  for(;t+1<NT;t+=2){
    STEP(pB0,pB1,pA0,pA1,t,(t+3<NT),(t+1<NT),(t+1<NT));       ENDW(t);   RESC(); ROT();
    STEP(pA0,pA1,pB0,pB1,t+1,(t+4<NT),(t+2<NT),(t+2<NT));     ENDW(t+1); RESC(); ROT();
  }
  STEP(pB0,pB1,pA0,pA1,NT-1,false,false,false); RESC();
  { float sacc=pB0[0]+pB0[1]; _Pragma("unroll") for(int r=2;r<16;++r)sacc+=pB0[r]; _Pragma("unroll") for(int r=0;r<16;++r)sacc+=pB1[r]; l_reg+=sacc;
    pw0=(u32x4){PKW(pB0,0),PKW(pB0,2),PKW(pB0,4),PKW(pB0,6)};pw1=(u32x4){PKW(pB0,8),PKW(pB0,10),PKW(pB0,12),PKW(pB0,14)};pw2=(u32x4){PKW(pB1,0),PKW(pB1,2),PKW(pB1,4),PKW(pB1,6)};pw3=(u32x4){PKW(pB1,8),PKW(pB1,10),PKW(pB1,12),PKW(pB1,14)};
    SBAR(); pv(o,vb0+sl_cur,PAF(0),PAF(1),PAF(2),PAF(3)); }
  #undef PKW
  #undef PAF
  #undef VFR
  #undef PIN
  #undef MX3
  #undef GAPA
  #undef GAPB
  #undef EX
  #undef VRD
  #undef KRD
  #undef STEP
  #undef ENDW
  { float l2_=l_reg; swap32(l_reg,l2_); l_reg=l_reg+l2_; }
  if(hi==0)wsf[32+r32]=l_reg;asm volatile("s_waitcnt lgkmcnt(0)":::"memory");
  float rli[16];
  #pragma unroll
  for(int r=0;r<16;++r)rli[r]=__builtin_amdgcn_rcpf(wsf[32+crow(r,hi)]);
  bf16*Ow=Yo+(rowbase+q0+wid*QBLK)*YP+YCOL+h*D; const bf16*Gw=Pq+(rowbase+q0+wid*QBLK)*DM+GCOL+h*D;
  { bf16*stg=(bf16*)(shm+LDS_OST)+wid*2048;
    #pragma unroll
    for(int r=0;r<16;++r){const int orow=crow(r,hi);
      #pragma unroll
      for(int d0=0;d0<2;++d0)stg[orow*64+d0*32+r32]=__float2bfloat16(o[d0][r]*rli[r]);}
    asm volatile("s_waitcnt lgkmcnt(0)":::"memory");
    #pragma unroll
    for(int i=0;i<4;++i){const int row=i*8+(lane>>3),ch=lane&7; const u32x4 v=*(const u32x4*)(stg+row*64+ch*8); const u32x4 g=*(const u32x4*)(Gw+(long)row*DM+ch*8); u32x4 w;
      #pragma unroll
      for(int e=0;e<4;++e){ const float a0=__uint_as_float(v[e]<<16),a1=__uint_as_float(v[e]&0xffff0000u),g0=__uint_as_float(g[e]<<16),g1=__uint_as_float(g[e]&0xffff0000u);
        w[e]=cvtpk_s(a0*g0*__builtin_amdgcn_rcpf(1.f+__expf(-g0)),a1*g1*__builtin_amdgcn_rcpf(1.f+__expf(-g1))); }
      ATTN_STORE16(Ow+(long)row*YP+ch*8,w);} }
  asm volatile("s_waitcnt lgkmcnt(0)\n\ts_barrier":::"memory");
  #undef DMA_K
  #undef DMA_V
  #undef CMASK
  #undef START
  #undef RESC
  #undef ROT
}
constexpr int ATTN_LDS_BYTES=LDS_BYTES;
#undef SBAR
#undef WAIT_BAR
}

#define LAS __attribute__((address_space(3)))
#define XB_TMO      128
#define XB_XCNT(j)  (256  + 64 * (j))
#define XB_XSUB(j)  (1280 + 64 * (j))
#define XB_XGEN(j)  (2304 + 64 * (j))
#define XB_TOP      3328
#define XB_TOPGEN   3392
#define XCD_BAR_WORDS 3456
#define XB_SPIN_CAP (1u << 18)

__device__ __forceinline__ unsigned xb_ld(unsigned* p)              { return __hip_atomic_load(p, __ATOMIC_RELAXED, __HIP_MEMORY_SCOPE_AGENT); }
__device__ __forceinline__ unsigned xb_add(unsigned* p, unsigned v) { return __hip_atomic_fetch_add(p, v, __ATOMIC_RELAXED, __HIP_MEMORY_SCOPE_AGENT); }
__device__ __forceinline__ unsigned xb_xcc_id() { return (unsigned)__builtin_amdgcn_s_getreg((3 << 11) | 20) & 0xFu; }
#define XB_SPIN(cond, bar) do { unsigned _sp = 0; while (cond) { __builtin_amdgcn_s_sleep(1); \
    if ((++_sp & 255u) == 0u) { if (xb_ld(&(bar)[XB_TMO])) break; if (_sp > XB_SPIN_CAP) { atomicAdd(&(bar)[XB_TMO], 1u); break; } } } } while (0)

struct XcdBarrier {
    unsigned* bar; unsigned x;
    volatile LAS unsigned* st;
};

__device__ __forceinline__ XcdBarrier xcd_barrier_post(unsigned* bar, volatile LAS unsigned* st) {
    XcdBarrier b; b.bar = bar; b.x = (unsigned)__builtin_amdgcn_readfirstlane((int)xb_xcc_id()); b.st = st;
    if (threadIdx.x == 0) (void)xb_add(&bar[XB_XCNT(b.x)], 1u);
    return b;
}
__device__ __forceinline__ void xcd_barrier_complete(unsigned* bar, unsigned x, unsigned& nloc, unsigned& nx) {
    const unsigned G = gridDim.x * gridDim.y * gridDim.z;
    unsigned sum, cnt, mine, sp = 0u;
    for (;;) {
        sum = 0u; cnt = 0u; mine = 0u;
#pragma unroll
        for (unsigned j = 0; j < 16; ++j) { const unsigned c = xb_ld(&bar[XB_XCNT(j)]); sum += c; cnt += (c > 0u) ? 1u : 0u; mine = (j == x) ? c : mine; }
        if (sum == G) break;
        __builtin_amdgcn_s_sleep(1);
        if ((++sp & 255u) == 0u) { if (xb_ld(&bar[XB_TMO])) break; if (sp > XB_SPIN_CAP) { atomicAdd(&bar[XB_TMO], 1u); break; } }
    }
    nloc = mine > 0u ? mine : 1u; nx = cnt > 0u ? cnt : 1u;
}

__device__ __forceinline__ void xcd_barrier(const XcdBarrier& b) {
    asm volatile("s_waitcnt vmcnt(0)" ::: "memory");
    __syncthreads();
    if (threadIdx.x == 0) {
        unsigned* bar = b.bar; asm volatile("" : "+s"(bar)); unsigned bx = b.x; asm volatile("" : "+s"(bx));
        __builtin_amdgcn_s_waitcnt(0);
        unsigned nloc = b.st[0], nx = b.st[1];
        if (nloc == 0u) { xcd_barrier_complete(bar, bx, nloc, nx); b.st[0] = nloc; b.st[1] = nx; }
        const unsigned old = xb_add(&bar[XB_XSUB(bx)], 1u);
        const unsigned gen = old / nloc;
        if (old + 1u == (gen + 1u) * nloc) {
            __builtin_amdgcn_fence(__ATOMIC_RELEASE, "agent");
            asm volatile("s_waitcnt vmcnt(0)" ::: "memory");
            const unsigned og = xb_add(&bar[XB_TOP], 1u);
            const unsigned tg = og / nx;
            if (og + 1u == (tg + 1u) * nx) xb_add(&bar[XB_TOPGEN], 1u);
            else XB_SPIN(xb_ld(&bar[XB_TOPGEN]) == tg, bar);
            __builtin_amdgcn_fence(__ATOMIC_ACQUIRE, "agent");
            asm volatile("s_waitcnt vmcnt(0)" ::: "memory");
        } else {
            XB_SPIN(xb_ld(&bar[XB_TOPGEN]) == gen, bar);
            __builtin_amdgcn_fence(__ATOMIC_ACQUIRE, "agent");
            asm volatile("s_waitcnt vmcnt(0)" ::: "memory");
        }
    }
    __syncthreads();
}

namespace cg = cooperative_groups;
__global__ void __launch_bounds__(NTHREADS, 2) mega_fwd(Args a) {
    extern __shared__ __attribute__((aligned(16))) unsigned char lds[];
    cg::grid_group grid = cg::this_grid();
    float* lds_f = (float*)lds;
    unsigned char* ws = a.ws;
    bf16* WinT = (bf16*)(ws + WS_WINT); bf16* WoutT = (bf16*)(ws + WS_WOUTT); bf16* X = (bf16*)(ws + WS_X); bf16* H = (bf16*)(ws + WS_H); bf16* Pb = (bf16*)(ws + WS_P); bf16* Y = (bf16*)(ws + WS_Y);
    RwcBuf RB; RB.CH = ws + WS_RW; RB.ST = ws + WS_RWST; RB.O1 = ws + WS_O1;
    float* kmean = (float*)(ws + WS_KMEAN);
    LruBuf LB; LB.HL = (float*)(ws + WS_LRU); LB.AC = LB.HL + (size_t)MROWS * LRU_W; LB.SH = LB.AC + (size_t)MROWS * LRU_W; LB.SA = LB.SH + NB * NSEG * LRU_W;
    const int G = gridDim.x, bid = blockIdx.x;
    volatile LAS unsigned* MISC = (volatile LAS unsigned*)((LAS unsigned char*)lds + 131072 + 320);
    if (threadIdx.x < 64) MISC[threadIdx.x] = 0u;
    __syncthreads();
    grid.sync();
    XcdBarrier bar = xcd_barrier_post((unsigned*)(ws + WS_CTL) + 4096, MISC + 8);
#define GRID_BAR() xcd_barrier(bar)

    phase_prep_weights(a, lds_f);
    for (int l = 0; l < DEPTH; ++l) {
        const void* xcur = l == 0 ? (const void*)a.in[0] : (const void*)X; const int xf32 = l == 0;
        if (l == 0 || G != 256) { phase_rmsnorm<false>(xcur, xf32, a.in[1] + (size_t)l * DM, H, (float*)(ws + WS_CTL + 512 * 1024));
        GRID_BAR(); }
        for (int rep = 0; rep < (PROBE_PH == 2 ? 2 : 1); ++rep) {
        { pg8::Gemm g{l == 0 ? H : X, WinT + (size_t)l * NINP * DM, MROWS, NINP, DM};   pg8::StaticOrder S; S.init(MROWS, NINP, G, bid);
          EpiP E{Pb, NINP, (const float*)(ws + WS_CTL + 512 * 1024)};
          pg8::gemm_phase<EpiP, pg8::StaticOrder, true, true>((PG8_LAS unsigned char*)lds, g, S, E); }
        GRID_BAR(); }
        { RwkvP P{a.in[11] + (size_t)l * RSTREAM, a.in[12] + (size_t)l * RW, a.in[13] + (size_t)l * 64 * RW, a.in[14] + (size_t)l * RW, a.in[15] + (size_t)l * 64 * RW,
                  a.in[16] + (size_t)l * RW, a.in[17] + (size_t)l * RW, a.in[18] + (size_t)l * RW, a.in[19] + (size_t)l * RW, a.in[20] + (size_t)l * RW,
                  (const bf16*)(ws + WS_LORA) + (size_t)l * NH * 2 * 64 * 64};
          { LruP LP{a.in[4] + (size_t)l * 4 * LRU_W, a.in[5] + (size_t)l * LRU_W, a.in[6] + (size_t)l * 8 * 4096, a.in[7] + (size_t)l * LRU_W, a.in[8] + (size_t)l * 8 * 4096, a.in[9] + (size_t)l * LRU_W, a.in[10] + (size_t)l * LRU_W};
            if (PROBE_PH == 31) { for (int u = bid; u < NB * 8 * NSEG; u += G) lru_local_unit(u, Pb, LP, LB, lds_f); GRID_BAR(); } }
          if (PROBE_PH == 34) { for (int u = bid; u < MROWS / 32; u += G) rwkv_phaseA(u, Pb, P, RB, (unsigned char*)lds); GRID_BAR(); }
          if (PROBE_PH == 35) { for (int u = bid; u < MROWS / 32; u += G) { const int bb_ = (u * 32) >> 12, ck_ = ((u * 32) & (SEQ - 1)) >> 5; const int wv_ = tidx() >> 6;
              for (int k = wv_; k < NH; k += NWAVES) rwkv_stage1((bb_ * NH + k) * NCH + ck_, RB, (unsigned char*)lds + wv_ * 16384); } GRID_BAR(); }
          for (int rep = 0; rep < (PROBE_PH == 32 ? 2 : 1); ++rep) { if (PROBE_PH == 32 && rep == 1) GRID_BAR();
          for (int u = bid; u < MROWS / 32; u += G) {
              rwkv_phaseA(u, Pb, P, RB, (unsigned char*)lds);
              const int bb_ = (u * 32) >> 12, ck_ = ((u * 32) & (SEQ - 1)) >> 5; const int wv_ = tidx() >> 6;
              { const int k = wv_ < 4 ? wv_ : wv_ + 4;
                rwkv_stage1((bb_ * NH + k) * NCH + ck_, RB, (unsigned char*)lds + wv_ * 16384); }
              __syncthreads(); } }
          for (int rep = 0; rep < (PROBE_PH == 33 ? 2 : 1); ++rep) { phase_moba_kmean(Pb, kmean, bid, G); if (PROBE_PH == 33) GRID_BAR(); }
          GRID_BAR();
          if (PROBE_PH == 41) { if (bid < NB * NH) rwkv_stage2(bid, RB, (unsigned char*)lds); GRID_BAR(); }
          if (bid < NB * NH) rwkv_stage2(bid, RB, (unsigned char*)lds);
          else { LruP LP{a.in[4] + (size_t)l * 4 * LRU_W, a.in[5] + (size_t)l * LRU_W, a.in[6] + (size_t)l * 8 * 4096, a.in[7] + (size_t)l * LRU_W, a.in[8] + (size_t)l * 8 * 4096, a.in[9] + (size_t)l * LRU_W, a.in[10] + (size_t)l * LRU_W};
              for (int u = bid - NB * NH; u < NB * 8 * NSEG; u += G - NB * NH) lru_local_unit(u, Pb, LP, LB, lds_f); }
          {
            unsigned* qc = (unsigned*)(ws + WS_CTL) + 8192 + 64 * (2 * l);
            __syncthreads();
            if (threadIdx.x == 0) MISC[16] = __hip_atomic_fetch_add(qc, 1u, __ATOMIC_RELAXED, __HIP_MEMORY_SCOPE_AGENT);
            __syncthreads();
            int idx = (int)MISC[16], slot = 0;
            while (idx < NB * NH * NBLK) {
                const int qb = NBLK - 1 - idx / (NB * NH), bh = idx % (NB * NH);
                attn_body::attn_unit<8>(bh / NH, bh % NH, qb, (const attn_body::bf16*)Pb, kmean + (size_t)bh * NBLK * HD, a.in[21], (attn_body::bf16*)Y, (char*)lds, qc, 17 + slot);
                idx = (int)MISC[17 + slot]; slot ^= 1; }
          }
          GRID_BAR();
          for (int rep = 0; rep < (PROBE_PH == 5 ? 2 : 1); ++rep) {
          { const int wv_ = tidx() >> 6; for (int it = bid * NWAVES + wv_; it < NB * NH * NCH; it += G * NWAVES) rwkv_stage3(it, Pb, P, RB, Y, (unsigned char*)lds + wv_ * 16384); }
          for (int u = bid; u < NB * 8 * NSEG; u += G) lru_final_unit(u, Pb, LB, Y, lds_f);
          if (PROBE_PH == 5 && rep == 0) GRID_BAR(); }
        }
        GRID_BAR();
        { pg8::Gemm g{Y, WoutT + (size_t)l * DM * DM, MROWS, DM, DM}; pg8::StaticOrder S; S.init(MROWS, DM, G, bid);
          float* lpart = (float*)((unsigned char*)lds + 132096);
          EpiRes E{xcur, X, DM, xf32, lpart};
          pg8::gemm_phase<EpiRes, pg8::StaticOrder, true, true>((PG8_LAS unsigned char*)lds, g, S, E);
          __syncthreads();
          { pg8::Unit u; const int t_ = tidx(); if (G == 256 && S.next(0, u) && t_ < 256) ((float*)(ws + WS_CTL + 512 * 1024))[(size_t)(u.pm * 256 + t_) * 8 + u.pn] = (lpart[t_] + lpart[256 + t_]) + (lpart[512 + t_] + lpart[768 + t_]); } }
        GRID_BAR();
    }
    phase_rmsnorm<true>(X, 0, a.in[22], nullptr, a.out);
}

extern "C" void kernel_launch(void* const* d_in, const int* in_sizes, int n_in, void* d_out, int out_size, void* d_ws, size_t ws_size, hipStream_t stream) {
    static int grid_blocks = 0;
    if (grid_blocks == 0) {
        if (ws_size < WS_END || n_in != 23) { fprintf(stderr, "kernel_launch: bad workspace/inputs: ws %zu need %zu, n_in %d\n", ws_size, (size_t)WS_END, n_in); grid_blocks = -1; return; }
        int dev = 0, cus = 0, per_cu = 0;
        (void)hipGetDevice(&dev); (void)hipDeviceGetAttribute(&cus, hipDeviceAttributeMultiprocessorCount, dev);
        (void)hipFuncSetAttribute((const void*)mega_fwd, hipFuncAttributeMaxDynamicSharedMemorySize, LDS_BYTES);
        (void)hipOccupancyMaxActiveBlocksPerMultiprocessor(&per_cu, (const void*)mega_fwd, NTHREADS, LDS_BYTES);
        if (per_cu < 1) { fprintf(stderr, "kernel_launch: occupancy query says %d blocks per CU\n", per_cu); per_cu = 1; }
        if (cus != 256) fprintf(stderr, "kernel_launch: this build assumes 256 compute units (one GEMM2 tile per workgroup), found %d\n", cus);
        grid_blocks = cus;
        fprintf(stderr, "kernel_launch: cus %d per_cu %d grid %d\n", cus, per_cu, grid_blocks);
    }
    if (grid_blocks < 0) return;
    Args a; memset(&a, 0, sizeof(a));
    for (int i = 0; i < 23; ++i) a.in[i] = (const float*)d_in[i];
    a.out = (float*)d_out; a.ws = (unsigned char*)d_ws;
    (void)hipMemsetAsync((unsigned char*)d_ws + WS_CTL, 0, 1 * MiB, stream);
    void* args[] = {&a};
    hipError_t e = hipLaunchCooperativeKernel((const void*)mega_fwd, dim3(grid_blocks), dim3(NTHREADS), args, LDS_BYTES, stream);
    if (e != hipSuccess) fprintf(stderr, "cooperative launch failed: %s (grid %d)\n", hipGetErrorString(e), grid_blocks);
}
```

```cpp
#include <hip/hip_runtime.h>
#include <hip/hip_cooperative_groups.h>
#include <hip/hip_bf16.h>
#include <cstdio>
#include <cstdint>
#include <cstring>
#include <cmath>
namespace pg8 {
#define PG8_LAS __attribute__((address_space(3)))
typedef unsigned short bf16_t;
typedef short bf16x8 __attribute__((ext_vector_type(8)));
typedef float f32x4 __attribute__((ext_vector_type(4)));
typedef unsigned u32x4 __attribute__((ext_vector_type(4)));
constexpr int BM = 256, BK = 64, HALF = 128, HTB = HALF * BK * 2  , STAGE_BYTES = 8 * HTB, NXCD = 8, WGM = 8;

__host__ __device__ __forceinline__ int lds_byte(int r, int c) { const int st = (r >> 4) * 2 + (c >> 5), rr = r & 15, cc = c & 31, ob = rr * 64 + cc * 2; return st * 1024 + (ob ^ (((ob >> 9) & 1) << 5)); }
__host__ __device__ __forceinline__ void stage_rc(int b, int& R, int& C) { const int st = b / 1024, sb = b % 1024, swz = sb ^ (((sb >> 9) & 1) << 5); R = (st >> 1) * 16 + swz / 64; C = (st & 1) * 32 + (swz % 64) / 2; }
__host__ __device__ __forceinline__ int perm32(int rho) { const int n = rho >> 4, i = rho & 15; return 8 * (i >> 2) + 4 * n + (i & 3); }

struct Unit { int pm, pn; };
struct Gemm { const bf16_t* A; const bf16_t* Bt; int M, N, K; };

struct StaticOrder {
    int nM, nN, nwg, G, c;
    __host__ __device__ void init(int M, int N, int G_, int c_) { nM = M / BM; nN = N / BM; nwg = nM * nN; G = G_; c = c_; }
    __host__ __device__ bool next(int i, Unit& u) const {
        const long L = (long)i * G + c; if (L >= nwg) return false;
        int wgid = (int)L; { const int q = nwg / NXCD, r = nwg % NXCD, xcd = wgid % NXCD, off = wgid / NXCD; wgid = (xcd < r ? xcd * (q + 1) : r * (q + 1) + (xcd - r) * q) + off; }
        const int nig = WGM * nN, gid = wgid / nig, fm = gid * WGM, gsz = (nM - fm) < WGM ? (nM - fm) : WGM;
        u.pm = fm + ((wgid % nig) % gsz); u.pn = (wgid % nig) / gsz; return true;
    }
    __device__ __forceinline__ void a_ready(const Unit&) const {}
    __device__ __forceinline__ void done(const Unit&) const {}
};

__device__ __forceinline__ unsigned cvt_pk_bf16(float lo, float hi) { unsigned r; asm volatile("v_cvt_pk_bf16_f32 %0, %1, %2" : "=v"(r) : "v"(lo), "v"(hi)); return r; }
typedef float f32x2 __attribute__((ext_vector_type(2)));
__device__ __forceinline__ f32x2 gelu_pk(f32x2 v) {
    const f32x2 av = __builtin_elementwise_abs(v), d = av * 0.2316418882f + 1.0f;
    f32x2 t; t.x = __builtin_amdgcn_rcpf(d.x); t.y = __builtin_amdgcn_rcpf(d.y);
    f32x2 q = t * 0.5307027145f + (-0.7265760135f); q = q * t + 0.7107068705f; q = q * t + (-0.142248368f); q = q * t + 0.127414796f; q = q * t;
    const f32x2 s = (v * v) * (-0.72134752044f);
    f32x2 e; e.x = __builtin_amdgcn_exp2f(s.x); e.y = __builtin_amdgcn_exp2f(s.y);
    const f32x2 m = v * (q * e), r = v - m;
    f32x2 o; o.x = v.x < 0.f ? m.x : r.x; o.y = v.y < 0.f ? m.y : r.y; return o;
}

template <int ACT  > struct EpiBf16 {
    static constexpr bool PERM = true, AFTER_DRAIN = false; static_assert(ACT == 0 || ACT == 1, "EpiBf16: ACT is 0 (none) or 1 (gelu_pk)");
    bf16_t* O; int ldc; const float* bias; int split_cols; size_t split_stride; float scale0;
    __device__ __forceinline__ void operator()(const f32x4 (&acc)[2][2][4][2], const Unit& u, int wr, int wc, int fr, int fq) const {
        const int row0 = u.pm * BM + wr * 64 + fr; int colt = u.pn * BM; bf16_t* base = O;
        float sc = 1.f; if (split_cols) { const int t = colt / split_cols; base += (size_t)t * split_stride; colt -= t * split_cols; if (t == 0) sc = scale0; }
        const int col0 = colt + wc * 32 + 8 * fq, bcol0 = u.pn * BM + wc * 32 + 8 * fq;
        f32x4 bv[2][2];
#pragma unroll
        for (int bj = 0; bj < 2; ++bj)
#pragma unroll
            for (int n = 0; n < 2; ++n) bv[bj][n] = bias ? *(const f32x4*)(bias + bcol0 + bj * HALF + 4 * n) : (f32x4){0.f, 0.f, 0.f, 0.f};
#pragma unroll
        for (int ai = 0; ai < 2; ++ai)
#pragma unroll
            for (int m = 0; m < 4; ++m) { bf16_t* rowp = base + (size_t)(row0 + ai * HALF + m * 16) * ldc + col0;
#pragma unroll
                for (int bj = 0; bj < 2; ++bj) { f32x4 v0 = acc[ai][bj][m][0] + bv[bj][0], v1 = acc[ai][bj][m][1] + bv[bj][1];
                    if (ACT == 1) { f32x2 a = gelu_pk((f32x2){v0[0], v0[1]}), b = gelu_pk((f32x2){v0[2], v0[3]}), c = gelu_pk((f32x2){v1[0], v1[1]}), d = gelu_pk((f32x2){v1[2], v1[3]});
                        v0 = (f32x4){a.x, a.y, b.x, b.y}; v1 = (f32x4){c.x, c.y, d.x, d.y}; }
                    v0 = v0 * sc; v1 = v1 * sc; u32x4 w; w.x = cvt_pk_bf16(v0[0], v0[1]); w.y = cvt_pk_bf16(v0[2], v0[3]); w.z = cvt_pk_bf16(v1[0], v1[1]); w.w = cvt_pk_bf16(v1[2], v1[3]);
                    *(u32x4*)(rowp + bj * HALF) = w; } }
    }
};
template <class Epi, class Sched, bool ALIGN_EPI = false, bool SP2 = false>
__device__ __forceinline__ void gemm_phase(PG8_LAS unsigned char* lds, const Gemm g, const Sched& S, const Epi& E) {
    int tid_ = threadIdx.x; asm volatile("" : "+v"(tid_)); const int tid = tid_, wid = __builtin_amdgcn_readfirstlane(tid >> 6), lane = tid & 63, wr = wid >> 2, wc = wid & 3, fr = lane & 15, fq = lane >> 4;
    const int K = g.K, nt = K / BK;
    unsigned voffA[2], voffB[2];
#pragma unroll
    for (int i = 0; i < 2; ++i) { int R, C; stage_rc(tid * 16 + i * 8192, R, C); const int Rb = Epi::PERM ? ((R & ~31) + perm32(R & 31)) : R;
        voffA[i] = (unsigned)(R * K + C) * 2u; voffB[i] = (unsigned)(Rb * K + C) * 2u; }
    const size_t kstep = (size_t)(BK * 2);
    const size_t hstep = (size_t)HALF * K * 2;
    const size_t tstep = 2 * hstep;
    const unsigned ldsw = (unsigned)wid * 1024u;
    const int aoff = lds_byte(wr * 64 + fr, fq * 8), boff = lds_byte(wc * 32 + fr, fq * 8);
#define PG8_SA(b, h) (((b) * 2 + (h)) * HTB)
#define PG8_SB(b, h) ((4 + (b) * 2 + (h)) * HTB)
#define PG8_STAGE(bufoff, gbase, voff) do { _Pragma("unroll") for (int _i = 0; _i < 2; ++_i) \
        __builtin_amdgcn_global_load_lds((const unsigned*)((const char*)(gbase) + (voff)[_i]), (PG8_LAS unsigned*)(lds + (bufoff) + ldsw + _i * 8192), 16, 0, 0); } while (0)
#define PG8_LDA(dst, b, h) do { _Pragma("unroll") for (int m = 0; m < 4; ++m) _Pragma("unroll") for (int k = 0; k < 2; ++k) dst[m][k] = *(const PG8_LAS bf16x8*)(lds + PG8_SA(b, h) + aoff + m * 2048 + k * 1024); } while (0)
#define PG8_LDB(dst, b, h) do { _Pragma("unroll") for (int n = 0; n < 2; ++n) _Pragma("unroll") for (int k = 0; k < 2; ++k) dst[n][k] = *(const PG8_LAS bf16x8*)(lds + PG8_SB(b, h) + boff + n * 2048 + k * 1024); } while (0)
#define PG8_MMA(ai, bj, At, Bt) do { __builtin_amdgcn_s_setprio(1); _Pragma("unroll") for (int m = 0; m < 4; ++m) _Pragma("unroll") for (int n = 0; n < 2; ++n) _Pragma("unroll") for (int k = 0; k < 2; ++k) \
        acc[ai][bj][m][n] = __builtin_amdgcn_mfma_f32_16x16x32_bf16(Bt[n][k], At[m][k], acc[ai][bj][m][n], 0, 0, 0); __builtin_amdgcn_s_setprio(0); } while (0)
#define PG8_WAIT_V(n) asm volatile("s_waitcnt vmcnt(" #n ")" ::: "memory")
#define PG8_WAIT_L(n) asm volatile("s_waitcnt lgkmcnt(" #n ")" ::: "memory")
#define PG8_BAR __builtin_amdgcn_s_barrier()
#define PG8_SCHED __builtin_amdgcn_sched_barrier(0)
    Unit cur, nxt; int ui = 0;
    if (!S.next(0, cur)) return;
    f32x4 acc[2][2][4][2];
#pragma unroll
    for (int a = 0; a < 2; ++a)
#pragma unroll
        for (int b = 0; b < 2; ++b)
#pragma unroll
            for (int m = 0; m < 4; ++m)
#pragma unroll
                for (int n = 0; n < 2; ++n) acc[a][b][m][n] = (f32x4){0.f, 0.f, 0.f, 0.f};
    bf16x8 At[4][2], B0[2][2], B1[2][2];
    const char* cA = (const char*)g.A + (size_t)cur.pm * tstep; const char* cB = (const char*)g.Bt + (size_t)cur.pn * tstep;
    S.a_ready(cur);
    if constexpr (SP2) {
        PG8_STAGE(PG8_SB(0, 0), cB, voffB); PG8_STAGE(PG8_SB(0, 1), cB + hstep, voffB); PG8_STAGE(PG8_SA(0, 0), cA, voffA); PG8_STAGE(PG8_SA(0, 1), cA + hstep, voffA);
        if (wr == 1) PG8_BAR;
        PG8_WAIT_V(2); PG8_BAR;
        PG8_STAGE(PG8_SB(1, 0), cB + kstep, voffB); PG8_STAGE(PG8_SA(1, 0), cA + kstep, voffA); PG8_STAGE(PG8_SB(1, 1), cB + hstep + kstep, voffB);
        PG8_WAIT_V(6); PG8_BAR;
    } else {
        PG8_STAGE(PG8_SB(0, 0), cB, voffB); PG8_STAGE(PG8_SA(0, 0), cA, voffA); PG8_STAGE(PG8_SB(0, 1), cB + hstep, voffB); PG8_STAGE(PG8_SA(0, 1), cA + hstep, voffA);
        if (wr == 1) PG8_BAR;
        PG8_WAIT_V(4); PG8_BAR;
        PG8_STAGE(PG8_SB(1, 0), cB + kstep, voffB); PG8_STAGE(PG8_SA(1, 0), cA + kstep, voffA); PG8_STAGE(PG8_SB(1, 1), cB + hstep + kstep, voffB);
        PG8_WAIT_V(6); PG8_BAR;
    }
    for (;;) {
        const bool has_next = S.next(ui + 1, nxt);
        const char* nA = has_next ? (const char*)g.A + (size_t)nxt.pm * tstep : cA; const char* nB = has_next ? (const char*)g.Bt + (size_t)nxt.pn * tstep : cB;
        for (int t = 0; t < nt; t += 2) {
            const bool last = (t == nt - 2);
            const char* a1 = cA + (size_t)(t + 1) * kstep;
            const char* a2 = last ? nA : cA + (size_t)(t + 2) * kstep; const char* b2 = last ? nB : cB + (size_t)(t + 2) * kstep;
            const char* a3 = a2 + kstep; const char* b3 = b2 + kstep;
            if (last && has_next) S.a_ready(nxt);
            if constexpr (SP2) {
            PG8_LDB(B0, 0, 0); PG8_LDB(B1, 0, 1); PG8_SCHED; PG8_LDA(At, 0, 0); PG8_STAGE(PG8_SA(1, 1), a1 + hstep, voffA);
            PG8_WAIT_V(8); PG8_WAIT_L(0); PG8_BAR; PG8_MMA(0, 0, At, B0); PG8_MMA(0, 1, At, B1); PG8_BAR; PG8_SCHED;
            PG8_LDA(At, 0, 1); PG8_STAGE(PG8_SB(0, 0), b2, voffB); PG8_STAGE(PG8_SB(0, 1), b2 + hstep, voffB); PG8_STAGE(PG8_SA(0, 0), a2, voffA);
            PG8_WAIT_V(8); PG8_WAIT_L(0); PG8_BAR; PG8_MMA(1, 0, At, B0); PG8_MMA(1, 1, At, B1); PG8_BAR; PG8_SCHED;
            PG8_LDB(B0, 1, 0); PG8_LDB(B1, 1, 1); PG8_SCHED; PG8_LDA(At, 1, 0); PG8_STAGE(PG8_SA(0, 1), a2 + hstep, voffA);
            PG8_WAIT_V(8); PG8_WAIT_L(0); PG8_BAR; PG8_MMA(0, 0, At, B0); PG8_MMA(0, 1, At, B1); PG8_BAR; PG8_SCHED;
            PG8_LDA(At, 1, 1); PG8_STAGE(PG8_SB(1, 0), b3, voffB); PG8_STAGE(PG8_SB(1, 1), b3 + hstep, voffB); PG8_STAGE(PG8_SA(1, 0), a3, voffA);
            PG8_WAIT_V(8); PG8_WAIT_L(0); PG8_BAR; PG8_MMA(1, 0, At, B0); PG8_MMA(1, 1, At, B1); PG8_BAR; PG8_SCHED;
            } else {
            PG8_LDB(B0, 0, 0); PG8_SCHED; PG8_LDA(At, 0, 0); PG8_STAGE(PG8_SA(1, 1), a1 + hstep, voffA);
            PG8_WAIT_L(8); PG8_BAR; PG8_WAIT_L(0); PG8_MMA(0, 0, At, B0); PG8_BAR; PG8_SCHED;
            PG8_LDB(B1, 0, 1); PG8_STAGE(PG8_SB(0, 0), b2, voffB);
            PG8_BAR; PG8_WAIT_L(0); PG8_MMA(0, 1, At, B1); PG8_BAR;
            PG8_LDA(At, 0, 1); PG8_STAGE(PG8_SA(0, 0), a2, voffA);
            PG8_BAR; PG8_WAIT_L(0); PG8_MMA(1, 0, At, B0); PG8_BAR; PG8_SCHED;
            PG8_STAGE(PG8_SB(0, 1), b2 + hstep, voffB);
            PG8_WAIT_V(6); PG8_BAR; PG8_MMA(1, 1, At, B1); PG8_BAR;
            PG8_LDB(B0, 1, 0); PG8_SCHED; PG8_LDA(At, 1, 0); PG8_STAGE(PG8_SA(0, 1), a2 + hstep, voffA);
            PG8_WAIT_L(8); PG8_BAR; PG8_WAIT_L(0); PG8_MMA(0, 0, At, B0); PG8_BAR; PG8_SCHED;
            PG8_LDB(B1, 1, 1); PG8_STAGE(PG8_SB(1, 0), b3, voffB);
            PG8_BAR; PG8_WAIT_L(0); PG8_MMA(0, 1, At, B1); PG8_BAR;
            PG8_LDA(At, 1, 1); PG8_STAGE(PG8_SA(1, 0), a3, voffA);
            PG8_BAR; PG8_WAIT_L(0); PG8_MMA(1, 0, At, B0); PG8_BAR; PG8_SCHED;
            PG8_STAGE(PG8_SB(1, 1), b3 + hstep, voffB);
            PG8_WAIT_V(6); PG8_BAR; PG8_MMA(1, 1, At, B1); PG8_BAR;
            }
        }
        if constexpr (ALIGN_EPI) { if (wr == 0) PG8_BAR; }
        if constexpr (!Epi::AFTER_DRAIN) { E(acc, cur, wr, wc, fr, fq); S.done(cur); }
        if (!has_next) break;
#pragma unroll
        for (int a = 0; a < 2; ++a)
#pragma unroll
            for (int b = 0; b < 2; ++b)
#pragma unroll
                for (int m = 0; m < 4; ++m)
#pragma unroll
                    for (int n = 0; n < 2; ++n) acc[a][b][m][n] = (f32x4){0.f, 0.f, 0.f, 0.f};
        cur = nxt; cA = nA; cB = nB; ++ui;
        if constexpr (ALIGN_EPI) { if (wr == 1) PG8_BAR; }
    }
    PG8_WAIT_V(0);
    if constexpr (!ALIGN_EPI) { if (wr == 0) PG8_BAR; }
    PG8_BAR;
    if constexpr (Epi::AFTER_DRAIN) { E.fused(acc, cur, wr, wc, fr, fq, lds, wid, lane); S.done(cur); }
#undef PG8_SA
#undef PG8_SB
#undef PG8_STAGE
#undef PG8_LDA
#undef PG8_LDB
#undef PG8_MMA
#undef PG8_WAIT_V
#undef PG8_WAIT_L
#undef PG8_BAR
#undef PG8_SCHED
}
}

constexpr int DM = 2048, NB = 2, SEQ = 4096, MROWS = NB * SEQ, DEPTH = 4;
constexpr int LRU_W = 512, RW = 768, MOW = 768, NIN = 7296, NINP = 7424;
constexpr int OFF_XA = 0, OFF_GA = 512, OFF_SB = 1024, OFF_GB = 3456, OFF_QKV = 4224, OFF_GC = 6528;
constexpr int RSTREAM = 2432;
constexpr int NH = 12, HD = 64, NBLK = 16, BLK = 256;

typedef unsigned short bf16;
typedef float f32x4 __attribute__((ext_vector_type(4)));
typedef unsigned u32x4 __attribute__((ext_vector_type(4)));
typedef unsigned u32x2 __attribute__((ext_vector_type(2)));

__device__ __forceinline__ unsigned f2bf(float f) { unsigned u = __builtin_bit_cast(unsigned, f); return (u + 0x7fffu + ((u >> 16) & 1u)) >> 16; }
__device__ __forceinline__ unsigned pk2(float lo, float hi) { return f2bf(lo) | (f2bf(hi) << 16); }
__device__ __forceinline__ float bf2f(unsigned short b) { return __builtin_bit_cast(float, (unsigned)b << 16); }
__device__ __forceinline__ float bflo(unsigned w) { return __builtin_bit_cast(float, w << 16); }
__device__ __forceinline__ float bfhi(unsigned w) { return __builtin_bit_cast(float, w & 0xffff0000u); }
__device__ __forceinline__ float sigmoidf_(float x) { return __builtin_amdgcn_rcpf(1.f + __expf(-x)); }
__device__ __forceinline__ float siluf_(float x) { return x * __builtin_amdgcn_rcpf(1.f + __expf(-x)); }
template <int CTRL, int RMASK> __device__ __forceinline__ float dpp0(float v) { return __builtin_bit_cast(float, __builtin_amdgcn_update_dpp(0, __builtin_bit_cast(int, v), CTRL, RMASK, 0xf, false)); }
__device__ __forceinline__ float wave_sum(float v) {
    v += dpp0<0xB1, 0xf>(v); v += dpp0<0x4E, 0xf>(v); v += dpp0<0x141, 0xf>(v); v += dpp0<0x140, 0xf>(v);
    v += dpp0<0x142, 0xa>(v);
    v += dpp0<0x143, 0xc>(v);
    return __builtin_bit_cast(float, __builtin_amdgcn_readlane(__builtin_bit_cast(int, v), 63));
}

__device__ __forceinline__ void transpose_item(const float* W, int K, int N, bf16* WT, float* scr, int item, int lane, const float* kscale = nullptr) {
    const int nblk = N / 32, kb = item / nblk, nb = item % nblk, k0 = 64 * kb, n0 = 32 * nb;
#pragma unroll 8
    for (int i = 0; i < 32; ++i) { const int kk = 2 * i + (lane >> 5); scr[kk * 33 + (lane & 31)] = W[(size_t)(k0 + kk) * N + n0 + (lane & 31)]; }
    __builtin_amdgcn_s_waitcnt(0xc07f); __builtin_amdgcn_wave_barrier();
    const int c = lane & 7;
    float ks8[8];
#pragma unroll
    for (int e = 0; e < 8; ++e) ks8[e] = kscale ? kscale[k0 + 8 * c + e] : 1.f;
#pragma unroll
    for (int j = 0; j < 4; ++j) { const int n = (lane >> 3) + 8 * j; const float* s = scr + (8 * c) * 33 + n;
        u32x4 o; o.x = pk2(s[0 * 33] * ks8[0], s[1 * 33] * ks8[1]); o.y = pk2(s[2 * 33] * ks8[2], s[3 * 33] * ks8[3]); o.z = pk2(s[4 * 33] * ks8[4], s[5 * 33] * ks8[5]); o.w = pk2(s[6 * 33] * ks8[6], s[7 * 33] * ks8[7]);
        *(u32x4*)(WT + (size_t)(n0 + n) * K + k0 + 8 * c) = o; }
    __builtin_amdgcn_s_waitcnt(0xc07f); __builtin_amdgcn_wave_barrier();
}

constexpr size_t MiB = 1u << 20;
constexpr size_t WS_CTL = 0;
constexpr size_t WS_WINT = 1 * MiB;
constexpr size_t WS_WOUTT = WS_WINT + (size_t)DEPTH * NINP * DM * 2;
constexpr size_t WS_X = WS_WOUTT + (size_t)DEPTH * DM * DM * 2;
constexpr size_t WS_H = WS_X + (size_t)MROWS * DM * 4;
constexpr size_t WS_P = WS_H + (size_t)MROWS * DM * 2;
constexpr size_t WS_Y = WS_P + (size_t)MROWS * NINP * 2;
constexpr size_t WS_RW = WS_Y + (size_t)MROWS * DM * 2;
constexpr size_t RW_ARR = (size_t)MROWS * RW * 4;
constexpr size_t WS_RWST = WS_RW + 104 * MiB;
constexpr size_t WS_KMEAN = WS_RW + 8 * RW_ARR;
constexpr size_t WS_LRU = WS_KMEAN + 1 * MiB;
constexpr size_t WS_O1 = WS_LRU + 2 * (size_t)MROWS * LRU_W * 4 + 1 * MiB;
constexpr size_t WS_LORA = WS_O1 + (size_t)NB * NH * (SEQ / 32) * 12288;
constexpr size_t WS_END = WS_LORA + (size_t)DEPTH * NH * 2 * 64 * 64 * 2;
constexpr int LDS_BYTES = 147456;
constexpr int NTHREADS = 512, NWAVES = 8;

typedef float f32x2e_t __attribute__((ext_vector_type(2))); typedef __bf16 bf16x2e_t __attribute__((ext_vector_type(2)));
__device__ __forceinline__ unsigned cvtpk_e(float lo, float hi) { const f32x2e_t v = {lo, hi}; const bf16x2e_t b = __builtin_convertvector(v, bf16x2e_t); return __builtin_bit_cast(unsigned, b); }
struct EpiRes {
    static constexpr bool PERM = false, AFTER_DRAIN = false;
    const void* base; bf16* out; int ldc; int base_f32; float* lpart;
    __device__ __forceinline__ void operator()(const pg8::f32x4 (&acc)[2][2][4][2], const pg8::Unit& u, int wr, int wc, int fr, int fq) const {
        const int row0 = u.pm * 256 + wr * 64 + fr, col0 = u.pn * 256 + wc * 32 + 4 * fq;
        float ss[2][4];
#pragma unroll
        for (int ai = 0; ai < 2; ++ai)
#pragma unroll
            for (int m = 0; m < 4; ++m) ss[ai][m] = 0.f;
#pragma unroll
        for (int ai = 0; ai < 2; ++ai)
#pragma unroll
            for (int mp = 0; mp < 2; ++mp) { pg8::f32x4 bs[2][2][2];
                if (base_f32) {
#pragma unroll
                    for (int mm = 0; mm < 2; ++mm) { const size_t off = (size_t)(row0 + ai * 128 + (2 * mp + mm) * 16) * ldc + col0;
#pragma unroll
                        for (int bj = 0; bj < 2; ++bj)
#pragma unroll
                            for (int n = 0; n < 2; ++n) bs[mm][bj][n] = *(const pg8::f32x4*)((const float*)base + off + bj * 128 + n * 16); }
                    asm volatile("" : "+v"(bs[0][0][0]), "+v"(bs[0][0][1]), "+v"(bs[0][1][0]), "+v"(bs[0][1][1]), "+v"(bs[1][0][0]), "+v"(bs[1][0][1]), "+v"(bs[1][1][0]), "+v"(bs[1][1][1]));
                } else { u32x2 bw[2][2][2];
#pragma unroll
                    for (int mm = 0; mm < 2; ++mm) { const size_t off = (size_t)(row0 + ai * 128 + (2 * mp + mm) * 16) * ldc + col0;
#pragma unroll
                        for (int bj = 0; bj < 2; ++bj)
#pragma unroll
                            for (int n = 0; n < 2; ++n) bw[mm][bj][n] = *(const u32x2*)((const bf16*)base + off + bj * 128 + n * 16); }
                    asm volatile("" : "+v"(bw[0][0][0]), "+v"(bw[0][0][1]), "+v"(bw[0][1][0]), "+v"(bw[0][1][1]), "+v"(bw[1][0][0]), "+v"(bw[1][0][1]), "+v"(bw[1][1][0]), "+v"(bw[1][1][1]));
#pragma unroll
                    for (int mm = 0; mm < 2; ++mm)
#pragma unroll
                        for (int bj = 0; bj < 2; ++bj)
#pragma unroll
                            for (int n = 0; n < 2; ++n) { const u32x2 w = bw[mm][bj][n]; bs[mm][bj][n] = (pg8::f32x4){__builtin_bit_cast(float, w.x << 16), __builtin_bit_cast(float, w.x & 0xffff0000u), __builtin_bit_cast(float, w.y << 16), __builtin_bit_cast(float, w.y & 0xffff0000u)}; } }
#pragma unroll
                for (int mm = 0; mm < 2; ++mm) { const size_t off = (size_t)(row0 + ai * 128 + (2 * mp + mm) * 16) * ldc + col0;
#pragma unroll
                    for (int bj = 0; bj < 2; ++bj)
#pragma unroll
                        for (int n = 0; n < 2; ++n) { const pg8::f32x4 o = bs[mm][bj][n] + acc[ai][bj][2 * mp + mm][n]; *(u32x2*)(out + off + bj * 128 + n * 16) = (u32x2){cvtpk_e(o.x, o.y), cvtpk_e(o.z, o.w)};
                            ss[ai][2 * mp + mm] += (o.x * o.x + o.y * o.y) + (o.z * o.z + o.w * o.w); } } }
#pragma unroll
        for (int ai = 0; ai < 2; ++ai)
#pragma unroll
            for (int m = 0; m < 4; ++m) { float v = ss[ai][m];
                v += __builtin_bit_cast(float, __builtin_amdgcn_ds_swizzle(__builtin_bit_cast(int, v), 0x401F));
                { float t = v; asm volatile("s_nop 1\n\tv_permlane32_swap_b32 %0, %1" : "+v"(v), "+v"(t)); v = v + t; }
                if (fq == 0) lpart[wc * 256 + wr * 64 + fr + ai * 128 + m * 16] = v; }
    }
};


struct EpiP {
    static constexpr bool PERM = true, AFTER_DRAIN = false;
    bf16* O; int ldc; const float* rstd; float* kmean;
    __device__ __forceinline__ void operator()(const pg8::f32x4 (&acc)[2][2][4][2], const pg8::Unit& u, int wr, int wc, int fr, int fq) const {
        const int row0 = u.pm * 256 + wr * 64 + fr, col0 = u.pn * 256 + wc * 32 + 8 * fq;
        float rs[2][4];
        { pg8::f32x4 pa[2][4], pb[2][4];
#pragma unroll
          for (int ai = 0; ai < 2; ++ai)
#pragma unroll
              for (int m = 0; m < 4; ++m) { const pg8::f32x4* rp = (const pg8::f32x4*)(rstd + (size_t)(row0 + ai * 128 + m * 16) * 8); pa[ai][m] = rp[0]; pb[ai][m] = rp[1]; }
          asm volatile("" : "+v"(pa[0][0]), "+v"(pa[0][1]), "+v"(pa[0][2]), "+v"(pa[0][3]), "+v"(pa[1][0]), "+v"(pa[1][1]), "+v"(pa[1][2]), "+v"(pa[1][3]));
          asm volatile("" : "+v"(pb[0][0]), "+v"(pb[0][1]), "+v"(pb[0][2]), "+v"(pb[0][3]), "+v"(pb[1][0]), "+v"(pb[1][1]), "+v"(pb[1][2]), "+v"(pb[1][3]));
#pragma unroll
          for (int ai = 0; ai < 2; ++ai)
#pragma unroll
              for (int m = 0; m < 4; ++m) { const float t = ((pa[ai][m].x + pa[ai][m].y) + (pa[ai][m].z + pa[ai][m].w)) + ((pb[ai][m].x + pb[ai][m].y) + (pb[ai][m].z + pb[ai][m].w));
                  rs[ai][m] = __builtin_amdgcn_rsqf(t * (1.f / DM) + 1e-6f); } }
        constexpr int KC0 = OFF_QKV + MOW;
        bool kr[2]; float cs[2][8];
#pragma unroll
        for (int bj = 0; bj < 2; ++bj) { const int cb_ = u.pn * 256 + bj * 128; kr[bj] = cb_ >= KC0 && cb_ < KC0 + MOW;
#pragma unroll
            for (int e = 0; e < 8; ++e) cs[bj][e] = 0.f; }
#pragma unroll
        for (int ai = 0; ai < 2; ++ai)
#pragma unroll
            for (int m = 0; m < 4; ++m) { bf16* rowp = O + (size_t)(row0 + ai * 128 + m * 16) * ldc + col0;
#pragma unroll
                for (int bj = 0; bj < 2; ++bj) { const int c = col0 + bj * 128; const float sc = ((c >= OFF_QKV && c < OFF_QKV + MOW) ? 0.125f * 1.4426950408889634f : 1.f) * rs[ai][m];
                    const pg8::f32x4 v0 = acc[ai][bj][m][0] * sc, v1 = acc[ai][bj][m][1] * sc;
                    if (kr[bj]) {
#pragma unroll
                        for (int e = 0; e < 4; ++e) { cs[bj][e] += v0[e]; cs[bj][4 + e] += v1[e]; } }
                    pg8::u32x4 w; w.x = pg8::cvt_pk_bf16(v0[0], v0[1]); w.y = pg8::cvt_pk_bf16(v0[2], v0[3]); w.z = pg8::cvt_pk_bf16(v1[0], v1[1]); w.w = pg8::cvt_pk_bf16(v1[2], v1[3]);
                    *(pg8::u32x4*)(rowp + bj * 128) = w; } }
#pragma unroll
        for (int bj = 0; bj < 2; ++bj) if (kr[bj]) { const int c0 = u.pn * 256 + bj * 128 + wc * 32 + 8 * fq - KC0;
            float* dst = kmean + ((size_t)((u.pm >> 4) * NH + (c0 >> 6)) * NBLK + (u.pm & 15)) * HD + (c0 & 63);
#pragma unroll
            for (int e = 0; e < 8; ++e) { float v = cs[bj][e];
                v += dpp0<0xB1, 0xf>(v); v += dpp0<0x4E, 0xf>(v); v += dpp0<0x141, 0xf>(v); v += dpp0<0x140, 0xf>(v);
                if (fr == 0) unsafeAtomicAdd(dst + e, v * (1.f / BLK)); } }
    }
};
__device__ __forceinline__ int tidx() { int t = threadIdx.x; asm volatile("" : "+v"(t)); return t; }
#ifndef PROBE_PH
#define PROBE_PH 0
#endif
struct Args { const float* in[23]; float* out; unsigned char* ws; };

__device__ __forceinline__ void phase_prep_weights(const Args& a, float* lds_f) {
    const int TID = tidx();
    const int lane = TID & 63, wave = TID >> 6;
    float* scr = lds_f + wave * 64 * 33;
    bf16* WinT = (bf16*)(a.ws + WS_WINT); bf16* WoutT = (bf16*)(a.ws + WS_WOUTT);
    const float* w_in = a.in[2]; const float* w_out = a.in[3];
    const int gw = blockIdx.x * NWAVES + wave, NGW = gridDim.x * NWAVES;
    constexpr int I_IN = (DM / 64) * (NIN / 32), I_OUT = (DM / 64) * (DM / 32);
    constexpr int NITEMS = DEPTH * (I_IN + I_OUT);
    for (int it = gw; it < NITEMS; it += NGW) {
        if (it < DEPTH * I_IN) { const int l = it / I_IN, r = it % I_IN; transpose_item(w_in + (size_t)l * DM * NIN, DM, NIN, WinT + (size_t)l * NINP * DM, scr, r, lane, a.in[1] + (size_t)l * DM); }
        else { const int r0 = it - DEPTH * I_IN, l = r0 / I_OUT, r = r0 % I_OUT; transpose_item(w_out + (size_t)l * DM * DM, DM, DM, WoutT + (size_t)l * DM * DM, scr, r, lane); }
    }
    const int gt = blockIdx.x * NTHREADS + TID, NGT = gridDim.x * NTHREADS;
    { bf16* LO = (bf16*)(a.ws + WS_LORA); const float* wu = a.in[13]; const float* au = a.in[15];
      for (int i = blockIdx.x * NTHREADS + TID; i < DEPTH * NH * 2 * 64 * 8; i += gridDim.x * NTHREADS) { const int c = i & 63, kg = (i >> 6) & 7, m = (i >> 9) & 1, lh = i >> 10, hh_ = lh % NH, l = lh / NH;
          const float* src = (m ? au : wu) + (size_t)l * 64 * RW + (size_t)(8 * kg) * RW + hh_ * 64 + c; float v[8];
#pragma unroll
          for (int e = 0; e < 8; ++e) v[e] = src[(size_t)e * RW];
          *(u32x4*)(LO + ((size_t)(lh * 2 + m) * 64 + c) * 64 + 8 * kg) = (u32x4){pk2(v[0], v[1]), pk2(v[2], v[3]), pk2(v[4], v[5]), pk2(v[6], v[7])}; } }
    constexpr int PADV = (NINP - NIN) * DM / 8;
    for (int i = gt; i < DEPTH * PADV; i += NGT) { const int l = i / PADV, r = i % PADV; *(u32x4*)(WinT + (size_t)l * NINP * DM + (size_t)NIN * DM + (size_t)r * 8) = (u32x4){0u, 0u, 0u, 0u}; }
}
template <bool FINAL> __device__ __forceinline__ void phase_rmsnorm(const void* x, int x_f32, const float* w, bf16* hb, float* outf) {
    const int TID = tidx();
    const int lane = TID & 63, wave = TID >> 6;
    for (int row = blockIdx.x * NWAVES + wave; row < MROWS; row += gridDim.x * NWAVES) {
        f32x4 v[8]; float s = 0.f;
        if (x_f32) { const f32x4* xr = (const f32x4*)((const float*)x + (size_t)row * DM) + lane;
#pragma unroll
            for (int j = 0; j < 8; ++j) v[j] = xr[64 * j]; }
        else { const u32x2* xr = (const u32x2*)((const bf16*)x + (size_t)row * DM) + lane;
#pragma unroll
            for (int j = 0; j < 8; ++j) { const u32x2 w2 = xr[64 * j]; v[j] = (f32x4){__builtin_bit_cast(float, w2.x << 16), __builtin_bit_cast(float, w2.x & 0xffff0000u), __builtin_bit_cast(float, w2.y << 16), __builtin_bit_cast(float, w2.y & 0xffff0000u)}; } }
#pragma unroll
        for (int j = 0; j < 8; ++j) s += (v[j].x * v[j].x + v[j].y * v[j].y) + (v[j].z * v[j].z + v[j].w * v[j].w);
        const float ssum = wave_sum(s); const float rstd = rsqrtf(ssum * (1.f / DM) + 1e-6f);
        if (!FINAL) {
            if (lane < 8) outf[(size_t)row * 8 + lane] = lane == 0 ? ssum : 0.f;
            if (x_f32) {
#pragma unroll
                for (int j = 0; j < 8; ++j) { u32x2 pk; pk.x = pk2(v[j].x, v[j].y); pk.y = pk2(v[j].z, v[j].w); ((u32x2*)(hb + (size_t)row * DM) + lane)[64 * j] = pk; } }
            continue; }
        const f32x4* wr = (const f32x4*)w + lane;
        f32x4 wv[8];
#pragma unroll
        for (int j = 0; j < 8; ++j) wv[j] = wr[64 * j];
        asm volatile("" : "+v"(wv[0]), "+v"(wv[1]), "+v"(wv[2]), "+v"(wv[3]), "+v"(wv[4]), "+v"(wv[5]), "+v"(wv[6]), "+v"(wv[7]));
#pragma unroll
        for (int j = 0; j < 8; ++j) { const f32x4 ww = wv[j]; const f32x4 o = v[j] * rstd * ww;
            if (FINAL) { ((f32x4*)(outf + (size_t)row * DM) + lane)[64 * j] = o; }
            else { u32x2 pk; pk.x = pk2(o.x, o.y); pk.y = pk2(o.z, o.w); ((u32x2*)(hb + (size_t)row * DM) + lane)[64 * j] = pk; } }
    }
}
struct LruP { const float *conv_w, *conv_b, *ga_w, *ga_b, *gx_w, *gx_b, *lam; };
struct LruBuf { float *HL, *AC, *SH, *SA; };
constexpr int LSEG = 256, NSEG = SEQ / LSEG, XSTR = 260;
typedef short lbfx8 __attribute__((ext_vector_type(8))); typedef float lfx16 __attribute__((ext_vector_type(16)));
__device__ __forceinline__ void lru_swap32(float& a, float& b) { asm volatile("s_nop 1\n\tv_permlane32_swap_b32 %0, %1" : "+v"(a), "+v"(b)); }
constexpr int LXS = 72;
__device__ __forceinline__ void lru_local_unit(int unit, const bf16* __restrict__ p, const LruP& P, const LruBuf& L, float* lds_f) {
    const int TID = tidx();
    bf16* sWTa = (bf16*)lds_f; bf16* sWTx = sWTa + 64 * LXS; bf16* sXB = sWTx + 64 * LXS;
    float* sCar = (float*)(sXB + 256 * LXS);
    const int b = unit >> 7, g = (unit >> 4) & 7, seg = unit & 15, c = TID & 63, tg = TID >> 6, t0 = seg * LSEG;
    { float wa[8], wx[8];
#pragma unroll
      for (int j = 0; j < 8; ++j) { wa[j] = P.ga_w[g * 4096 + TID + NTHREADS * j]; wx[j] = P.gx_w[g * 4096 + TID + NTHREADS * j]; }
      asm volatile("" : "+v"(wa[0]), "+v"(wa[1]), "+v"(wa[2]), "+v"(wa[3]), "+v"(wa[4]), "+v"(wa[5]), "+v"(wa[6]), "+v"(wa[7]));
      asm volatile("" : "+v"(wx[0]), "+v"(wx[1]), "+v"(wx[2]), "+v"(wx[3]), "+v"(wx[4]), "+v"(wx[5]), "+v"(wx[6]), "+v"(wx[7]));
#pragma unroll
      for (int j = 0; j < 8; ++j) { const int i = TID + NTHREADS * j, k = i >> 6, cc = i & 63; sWTa[cc * LXS + k] = (bf16)f2bf(wa[j]); sWTx[cc * LXS + k] = (bf16)f2bf(wx[j]); } }
    const int ch = g * 64 + c;
    const float cw0 = P.conv_w[0 * LRU_W + ch], cw1 = P.conv_w[1 * LRU_W + ch], cw2 = P.conv_w[2 * LRU_W + ch], cw3 = P.conv_w[3 * LRU_W + ch], cb = P.conv_b[ch];
    const float sp = log1pf(__expf(-P.lam[ch]));
    float xc[32];
    { const int tb = t0 + tg * 32; const bf16* pr = p + (size_t)(b * SEQ + tb) * NINP + OFF_XA + ch;
      unsigned xu[35];
#pragma unroll
      for (int i = 0; i < 35; ++i) xu[i] = (i >= 3 || tb >= 3 - i) ? (unsigned)pr[(ptrdiff_t)(i - 3) * NINP] : 0u;
#pragma unroll
      for (int gq = 0; gq < 5; ++gq) asm volatile("" : "+v"(xu[7 * gq]), "+v"(xu[7 * gq + 1]), "+v"(xu[7 * gq + 2]), "+v"(xu[7 * gq + 3]), "+v"(xu[7 * gq + 4]), "+v"(xu[7 * gq + 5]), "+v"(xu[7 * gq + 6]));
      float x3 = bf2f((unsigned short)xu[0]), x2 = bf2f((unsigned short)xu[1]), x1 = bf2f((unsigned short)xu[2]);
#pragma unroll
      for (int i = 0; i < 32; ++i) { const float x0 = bf2f((unsigned short)xu[i + 3]); xc[i] = cw3 * x0 + cw2 * x1 + cw1 * x2 + cw0 * x3 + cb; x3 = x2; x2 = x1; x1 = x0; } }
#pragma unroll
    for (int i = 0; i < 32; ++i) sXB[(tg * 32 + i) * LXS + c] = (bf16)f2bf(xc[i]);
    __syncthreads();
    float ra[32], ia[32];
    { const int r = c & 31, h = c >> 5;
      lbfx8 fa[4];
#pragma unroll
      for (int ks = 0; ks < 4; ++ks) fa[ks] = *(const lbfx8*)(sXB + (tg * 32 + r) * LXS + 16 * ks + 8 * h);
#pragma unroll
      for (int gate = 0; gate < 2; ++gate) { const bf16* W = gate ? sWTx : sWTa; const float* bp = (gate ? P.gx_b : P.ga_b) + g * 64;
          const float b0 = bp[r], b1 = bp[32 + r];
          lfx16 acc0 = {}, acc1 = {};
#pragma unroll
          for (int ks = 0; ks < 4; ++ks) { const lbfx8 w0 = *(const lbfx8*)(W + r * LXS + 16 * ks + 8 * h), w1 = *(const lbfx8*)(W + (32 + r) * LXS + 16 * ks + 8 * h);
              acc0 = __builtin_amdgcn_mfma_f32_32x32x16_bf16(fa[ks], w0, acc0, 0, 0, 0); acc1 = __builtin_amdgcn_mfma_f32_32x32x16_bf16(fa[ks], w1, acc1, 0, 0, 0); }
#pragma unroll
          for (int i = 0; i < 16; ++i) { float a0 = acc0[i] + b0, a1 = acc1[i] + b1; lru_swap32(a0, a1); const int t = (i & 3) + 8 * (i >> 2);
              if (gate == 0) { ra[t] = a0; ra[t + 4] = a1; } else { ia[t] = a0; ia[t + 4] = a1; } } } }
    { float h = 0.f, A = 1.f;
#pragma unroll
      for (int i = 0; i < 32; ++i) { const float r = sigmoidf_(ra[i]), ig = sigmoidf_(ia[i]);
          const float log_a = -8.f * r * sp; const float av = __expf(log_a);
          const float x2 = 2.f * log_a; float om = 1.f - av * av; if (x2 > -0.03f) om = -x2 * (1.f + x2 * (0.5f + x2 * (1.f / 6.f)));
          const float bb = __builtin_amdgcn_sqrtf(om) * (ig * xc[i]);
          h = av * h + bb; A *= av; ra[i] = h; ia[i] = A; }
      sCar[(tg * 64 + c) * 2] = h; sCar[(tg * 64 + c) * 2 + 1] = A; }
    __syncthreads();
    float cin = 0.f, Ap = 1.f;
    for (int q = 0; q < tg; ++q) { const float he = sCar[(q * 64 + c) * 2], Ae = sCar[(q * 64 + c) * 2 + 1]; cin = he + Ae * cin; Ap *= Ae; }
    { const size_t o = (size_t)(b * SEQ + t0 + tg * 32) * LRU_W + ch;
#pragma unroll
      for (int i = 0; i < 32; ++i) { const float h = ra[i] + ia[i] * cin, A = ia[i] * Ap; L.HL[o + (size_t)i * LRU_W] = h; L.AC[o + (size_t)i * LRU_W] = A;
          if (i == 31 && tg == 7) { L.SH[(b * NSEG + seg) * LRU_W + ch] = h; L.SA[(b * NSEG + seg) * LRU_W + ch] = A; } } }
    __syncthreads();
}
__device__ __forceinline__ void lru_final_unit(int unit, const bf16* __restrict__ p, const LruBuf& L, bf16* ybuf, float* lds_f) {
    const int TID = tidx();
    const int b = unit >> 7, g = (unit >> 4) & 7, seg = unit & 15, c = TID & 63, tg = TID >> 6, t0 = seg * LSEG, ch = g * 64 + c;
    float cin = 0.f;
    for (int s = 0; s < seg; ++s) cin = L.SH[(b * NSEG + s) * LRU_W + ch] + L.SA[(b * NSEG + s) * LRU_W + ch] * cin;
    const size_t row0 = (size_t)(b * SEQ + t0 + tg * 32);
    for (int i0 = 0; i0 < 32; i0 += 8) { float hl[8], ac[8]; unsigned gu[8];
#pragma unroll
        for (int i = 0; i < 8; ++i) { const size_t row = row0 + i0 + i; hl[i] = L.HL[row * LRU_W + ch]; ac[i] = L.AC[row * LRU_W + ch]; gu[i] = p[row * NINP + OFF_GA + ch]; }
        asm volatile("" : "+v"(hl[0]), "+v"(hl[1]), "+v"(hl[2]), "+v"(hl[3]), "+v"(hl[4]), "+v"(hl[5]), "+v"(hl[6]), "+v"(hl[7]));
        asm volatile("" : "+v"(ac[0]), "+v"(ac[1]), "+v"(ac[2]), "+v"(ac[3]), "+v"(ac[4]), "+v"(ac[5]), "+v"(ac[6]), "+v"(ac[7]));
        asm volatile("" : "+v"(gu[0]), "+v"(gu[1]), "+v"(gu[2]), "+v"(gu[3]), "+v"(gu[4]), "+v"(gu[5]), "+v"(gu[6]), "+v"(gu[7]));
#pragma unroll
        for (int i = 0; i < 8; ++i) { const size_t row = row0 + i0 + i; const float h = hl[i] + ac[i] * cin; const float ga = bf2f((unsigned short)gu[i]);
            ybuf[row * DM + ch] = (bf16)f2bf(h * siluf_(ga)); } }
}
struct RwkvP { const float *mix, *w0, *w_up, *a0, *a_up, *k_k, *k_a, *r_k, *ln_w, *ln_b; const bf16* lora; };
typedef short bfx8 __attribute__((ext_vector_type(8)));
typedef float fx16 __attribute__((ext_vector_type(16)));
#define MFMA32(a, b, c) __builtin_amdgcn_mfma_f32_32x32x16_bf16(a, b, c, 0, 0, 0)
constexpr int RC = 32, NCH = SEQ / RC;
constexpr int CH_AT = 0, CH_BT = 4096, CH_KT = 8192, CH_RT = 12288, CH_BHT = 16384, CH_KHT = 20480, CH_VT = 24576, CH_VR = 28672, CH_ECW = 32768, CH_C3 = 33024, CH_STRIDE = 33280;
constexpr int O_P = 0, O_QT = 4096, O_ARB = 8192, O_ARK = 10240, O_STRIDE = 12288;
constexpr int ST_S0 = 0, ST_UT = 8192, ST_STRIDE = 12288;
struct RwcBuf { unsigned char *CH, *O1, *ST; };
__device__ __forceinline__ int crow16(int reg, int h) { return (reg & 3) + 8 * (reg >> 2) + 4 * h; }
typedef float f32x2c_t __attribute__((ext_vector_type(2))); typedef __bf16 bf16x2c_t __attribute__((ext_vector_type(2)));
__device__ __forceinline__ unsigned cvtpk(float lo, float hi) { const f32x2c_t v = {lo, hi}; const bf16x2c_t b = __builtin_convertvector(v, bf16x2c_t); return __builtin_bit_cast(unsigned, b); }

__device__ __forceinline__ void rwkv_stage1(int item, const RwcBuf& B, unsigned char* wl);
__device__ __forceinline__ void rwkv_phaseA(int unit, const bf16* __restrict__ p, const RwkvP& P, const RwcBuf& B, unsigned char* lds) {
    const int TID = tidx();
    const int wave = TID >> 6;
    bf16* TW = (bf16*)(lds + 132096); bf16* AD = TW + 32 * 64;
    float* LWt = (float*)(lds + wave * 16384); float* LAt = LWt + 64 * 32;
    const int row0 = unit * 32, b = row0 >> 12, tb = row0 & (SEQ - 1), chunk = tb >> 5;
    { unsigned cu[8], pu[8];
      const float mixv = P.mix[2304 + (TID & 127)];
#pragma unroll
      for (int i = 0; i < 8; ++i) { const int idx = TID + 512 * i, tok = idx >> 7, col = idx & 127, cidx = 2304 + col;
          const bf16* cur = p + (size_t)(row0 + tok) * NINP + OFF_SB + cidx;
          cu[i] = cur[0]; pu[i] = (tb + tok) > 0 ? (unsigned)*(cur - NINP) : 0u; }
      asm volatile("" : "+v"(cu[0]), "+v"(cu[1]), "+v"(cu[2]), "+v"(cu[3]), "+v"(cu[4]), "+v"(cu[5]), "+v"(cu[6]), "+v"(cu[7]));
      asm volatile("" : "+v"(pu[0]), "+v"(pu[1]), "+v"(pu[2]), "+v"(pu[3]), "+v"(pu[4]), "+v"(pu[5]), "+v"(pu[6]), "+v"(pu[7]));
#pragma unroll
      for (int i = 0; i < 8; ++i) { const int idx = TID + 512 * i, tok = idx >> 7, col = idx & 127;
          const float c0 = bf2f((unsigned short)cu[i]), p0 = bf2f((unsigned short)pu[i]); const float s = c0 + mixv * (p0 - c0);
          const int cc = col & 63, so = tok * 64 + (((cc >> 3) ^ (tok & 7)) << 3) + (cc & 7);
          if (col < 64) TW[so] = (bf16)f2bf(tanhf(s)); else AD[so] = (bf16)f2bf(s); } }
    __syncthreads();
    for (int pass = 0; pass < 2; ++pass) {
        int tl_ = TID; asm volatile("" : "+v"(tl_));
        const int c = pass * 512 + tl_, lane = tl_ & 63, r = lane & 31, hh = lane >> 5;
        if (c < RW) {
            { bfx8 aW[4], aA[4];
#pragma unroll
              for (int ks = 0; ks < 4; ++ks) { const int so = r * 64 + (((2 * ks + hh) ^ (r & 7)) << 3); aW[ks] = *(const bfx8*)(TW + so); aA[ks] = *(const bfx8*)(AD + so); }
              const int cb = (c & ~63);
#pragma unroll
              for (int n = 0; n < 2; ++n) { fx16 xw = {}, xa = {};
                  const bf16* wfr = P.lora + ((size_t)((cb >> 6) * 2) * 64 + 32 * n + r) * 64 + 8 * hh; const bf16* afr = wfr + 64 * 64;
#pragma unroll
                  for (int ks = 0; ks < 4; ++ks) { const bfx8 bw = *(const bfx8*)(wfr + 16 * ks), ba = *(const bfx8*)(afr + 16 * ks);
                      xw = MFMA32(aW[ks], bw, xw); xa = MFMA32(aA[ks], ba, xa); }
#pragma unroll
                  for (int g = 0; g < 4; ++g) { const int so = (32 * n + r) * 32 + 4 * ((2 * g + hh) ^ (r & 7));
                      *(f32x4*)(LWt + so) = (f32x4){xw[4 * g], xw[4 * g + 1], xw[4 * g + 2], xw[4 * g + 3]};
                      *(f32x4*)(LAt + so) = (f32x4){xa[4 * g], xa[4 * g + 1], xa[4 * g + 2], xa[4 * g + 3]}; } } }
            float lw[32], la[32];
            { const float w0 = P.w0[c], a0 = P.a0[c];
#pragma unroll
              for (int q = 0; q < 8; ++q) { const int so = lane * 32 + 4 * (q ^ (lane & 7)); const f32x4 wv = *(const f32x4*)(LWt + so), av = *(const f32x4*)(LAt + so);
                  lw[4 * q] = wv.x + w0; lw[4 * q + 1] = wv.y + w0; lw[4 * q + 2] = wv.z + w0; lw[4 * q + 3] = wv.w + w0;
                  la[4 * q] = av.x + a0; la[4 * q + 1] = av.y + a0; la[4 * q + 2] = av.z + a0; la[4 * q + 3] = av.w + a0; } }
            float cwC;
            { float cw = 0.f;
#pragma unroll
              for (int i = 0; i < 32; ++i) { cw += -0.6065306597126334f * sigmoidf_(lw[i]); lw[i] = cw; la[i] = sigmoidf_(la[i]); }
              cwC = cw; }
            const float mr = P.mix[c], mk = P.mix[RW + c], mv = P.mix[2 * RW + c], kkw = P.k_k[c], kaw = P.k_a[c], rkw = P.r_k[c];
            const int h = c >> 6, j = c & 63;
            bf16* XS = (bf16*)LWt;
            { const int ln = lane;
              const bf16* src = p + (size_t)(row0 - 1) * NINP + OFF_SB + h * 64 + (ln & 7) * 8;
              u32x4 tv[3][5];
#pragma unroll
              for (int arr = 0; arr < 3; ++arr)
#pragma unroll
                  for (int q = 0; q < 5; ++q) { const int tok = 8 * q + (ln >> 3); tv[arr][q] = (u32x4){0u, 0u, 0u, 0u};
                      if (tok < 33 && (tb + tok) > 0) tv[arr][q] = *(const u32x4*)(src + (size_t)tok * NINP + arr * RW); }
#pragma unroll
              for (int arr = 0; arr < 3; ++arr)
#pragma unroll
                  for (int q = 0; q < 5; ++q) { const int tok = 8 * q + (ln >> 3); if (tok < 33) *(u32x4*)(XS + (tok * 3 + arr) * 64 + (ln & 7) * 8) = tv[arr][q]; } }
            float pr = bf2f(XS[0 * 64 + j]), pk = bf2f(XS[1 * 64 + j]), pv = bf2f(XS[2 * 64 + j]);
            unsigned char* ch = B.CH + (size_t)((b * NH + h) * NCH + chunk) * CH_STRIDE;
            bf16* AT = (bf16*)(ch + CH_AT); bf16* BT = (bf16*)(ch + CH_BT); bf16* KT = (bf16*)(ch + CH_KT); bf16* RT = (bf16*)(ch + CH_RT); bf16* VR = (bf16*)(ch + CH_VR);
            unsigned bhp[16], khp[16], vtp[16];
            float hold_b = 0.f, hold_k = 0.f, hold_v = 0.f;
#pragma unroll
            for (int i = 0; i < 32; ++i) { const float cr = bf2f(XS[(3 * (i + 1) + 0) * 64 + j]), ck = bf2f(XS[(3 * (i + 1) + 1) * 64 + j]), cv = bf2f(XS[(3 * (i + 1) + 2) * 64 + j]);
                const float r = cr + mr * (pr - cr), k = ck + mk * (pk - ck), v = cv + mv * (pv - cv); pr = cr; pk = ck; pv = cv;
                const float av = la[i];
                float kk = k * kkw;
                kk *= __builtin_amdgcn_rcpf(fmaxf(__builtin_amdgcn_sqrtf(wave_sum(kk * kk)), 1e-12f));
                const float km = k * (1.f + (av - 1.f) * kaw);
                const float be = kk * av;
                const float cwi = lw[i], cwp = i > 0 ? lw[i - 1] : 0.f;
                const float em = __expf(-cwi), eh = __expf(cwC - cwi);
                const float c3 = wave_sum(r * km * rkw);
                AT[i * 64 + j] = (bf16)f2bf(-kk * __expf(cwp)); BT[i * 64 + j] = (bf16)f2bf(be * em); KT[i * 64 + j] = (bf16)f2bf(km * em); RT[i * 64 + j] = (bf16)f2bf(r * __expf(cwi)); VR[i * 64 + j] = (bf16)f2bf(v);
                const float bhv = be * eh, khv = km * eh;
                if (i & 1) { bhp[i >> 1] = cvtpk(hold_b, bhv); khp[i >> 1] = cvtpk(hold_k, khv); vtp[i >> 1] = cvtpk(hold_v, v); } else { hold_b = bhv; hold_k = khv; hold_v = v; }
                if (j == 0) ((float*)(ch + CH_C3))[i] = c3; }
            u32x4* BHT = (u32x4*)(ch + CH_BHT + j * 64); u32x4* KHT = (u32x4*)(ch + CH_KHT + j * 64); u32x4* VT = (u32x4*)(ch + CH_VT + j * 64);
#pragma unroll
            for (int q = 0; q < 4; ++q) { BHT[q] = (u32x4){bhp[4 * q], bhp[4 * q + 1], bhp[4 * q + 2], bhp[4 * q + 3]}; KHT[q] = (u32x4){khp[4 * q], khp[4 * q + 1], khp[4 * q + 2], khp[4 * q + 3]};
                VT[q] = (u32x4){vtp[4 * q], vtp[4 * q + 1], vtp[4 * q + 2], vtp[4 * q + 3]}; }
            ((float*)(ch + CH_ECW))[j] = __expf(cwC);
        }
        else {
            asm volatile("s_waitcnt vmcnt(0)" ::: "memory");
            rwkv_stage1((b * NH + (tl_ >> 6)) * NCH + chunk, B, lds + (tl_ >> 6) * 16384);
        }
    }
    asm volatile("s_waitcnt vmcnt(0)" ::: "memory");
    __syncthreads();
}

#define FMAC(acc, a, b) asm("v_fmac_f32 %0, %1, %2" : "+v"(acc) : "v"(a), "v"(b))
template <int N> __device__ __forceinline__ void sub_pin(f32x4* v) {
    if constexpr (N >= 8) { asm volatile("" : "+v"(v[0]), "+v"(v[1]), "+v"(v[2]), "+v"(v[3]), "+v"(v[4]), "+v"(v[5]), "+v"(v[6]), "+v"(v[7]) :: "memory"); sub_pin<N - 8>(v + 8); }
    else if constexpr (N >= 4) { asm volatile("" : "+v"(v[0]), "+v"(v[1]), "+v"(v[2]), "+v"(v[3]) :: "memory"); sub_pin<N - 4>(v + 4); }
    else if constexpr (N >= 2) { asm volatile("" : "+v"(v[0]), "+v"(v[1]) :: "memory"); sub_pin<N - 2>(v + 2); }
    else if constexpr (N == 1) { asm volatile("" : "+v"(v[0]) :: "memory"); }
}
constexpr int sub_nq(int t) { return t <= 31 ? (t + 3) / 4 : 0; }
template <int T0> __device__ __forceinline__ void sub_load(const float* Lf, f32x4 (&l)[16]) {
#pragma unroll
    for (int q = 0; q < sub_nq(T0); ++q) l[q] = *(const f32x4*)(Lf + T0 * 32 + 4 * (q ^ (T0 & 7)));
#pragma unroll
    for (int q = 0; q < sub_nq(T0 + 1); ++q) l[sub_nq(T0) + q] = *(const f32x4*)(Lf + (T0 + 1) * 32 + 4 * (q ^ ((T0 + 1) & 7)));
}
template <int T> __device__ __forceinline__ void sub_row(const f32x4* l, float (&xp)[32], float (&xq)[32]) {
#pragma unroll
    for (int q = 0; q < sub_nq(T); ++q)
#pragma unroll
        for (int e = 0; e < 4; ++e) { const int s = 4 * q + e; if (s < T) { FMAC(xp[T], l[q][e], xp[s]); FMAC(xq[T], l[q][e], xq[s]); } }
}
template <int T0> __device__ __forceinline__ void sub_step(const float* Lf, float (&xp)[32], float (&xq)[32], f32x4 (&cur)[16]) {
    f32x4 nxt[16];
    if constexpr (T0 + 2 <= 31) sub_load<T0 + 2>(Lf, nxt);
    sub_pin<sub_nq(T0) + sub_nq(T0 + 1)>(cur);
    sub_row<T0>(cur, xp, xq);
    if constexpr (T0 + 1 <= 31) sub_row<T0 + 1>(cur + sub_nq(T0), xp, xq);
    if constexpr (T0 + 2 <= 31) sub_step<T0 + 2>(Lf, xp, xq, nxt);
}
__device__ __forceinline__ void rwkv_stage1(int item, const RwcBuf& B, unsigned char* wl  ) {
    const int TID = tidx();
    const int lane = TID & 63, r = lane & 31, h = lane >> 5;
    const unsigned char* ch = B.CH + (size_t)item * CH_STRIDE; unsigned char* o1 = B.O1 + (size_t)item * O_STRIDE;
    float* Lf = (float*)wl;
    bf16* LakB = (bf16*)(wl + 12288);
    float* GT = (float*)(wl + 4096);
    const bf16* AT = (const bf16*)(ch + CH_AT); const bf16* BT = (const bf16*)(ch + CH_BT); const bf16* KT = (const bf16*)(ch + CH_KT); const bf16* RT = (const bf16*)(ch + CH_RT);
    const bf16* VT = (const bf16*)(ch + CH_VT);
    bfx8 fA[4], fB[4], fK[4], fR[4];
#pragma unroll
    for (int ks = 0; ks < 4; ++ks) { const int o = r * 64 + 16 * ks + 8 * h; fA[ks] = *(const bfx8*)(AT + o); fB[ks] = *(const bfx8*)(BT + o); fK[ks] = *(const bfx8*)(KT + o); fR[ks] = *(const bfx8*)(RT + o); }
    bf16* ATs = (bf16*)(wl + 12288);
    u32x4 atv[4];
#pragma unroll
    for (int q = 0; q < 4; ++q) atv[q] = *(const u32x4*)(AT + (lane + 64 * q) * 8);
    const fx16 zero = {};
    { fx16 x = zero;
#pragma unroll
      for (int ks = 0; ks < 4; ++ks) x = MFMA32(fB[ks], fA[ks], x);
#pragma unroll
      for (int g = 0; g < 4; ++g) { f32x4 w;
#pragma unroll
          for (int e = 0; e < 4; ++e) { const int s = 8 * g + 4 * h + e; w[e] = s < r ? x[4 * g + e] : 0.f; }
          *(f32x4*)(Lf + r * 32 + 4 * ((2 * g + h) ^ (r & 7))) = w; } }
    { fx16 x = zero;
#pragma unroll
      for (int ks = 0; ks < 4; ++ks) x = MFMA32(fK[ks], fA[ks], x);
#pragma unroll
      for (int g = 0; g < 4; ++g) { float w[4];
#pragma unroll
          for (int e = 0; e < 4; ++e) { const int s = 8 * g + 4 * h + e; w[e] = s < r ? x[4 * g + e] : 0.f; }
          *(u32x2*)(LakB + r * 32 + 8 * g + 4 * h) = (u32x2){cvtpk(w[0], w[1]), cvtpk(w[2], w[3])}; } }
    { fx16 x = zero, y = zero;
#pragma unroll
      for (int ks = 0; ks < 4; ++ks) { x = MFMA32(fB[ks], fR[ks], x); y = MFMA32(fK[ks], fR[ks], y); }
      bf16* ARB = (bf16*)(o1 + O_ARB); bf16* ARK = (bf16*)(o1 + O_ARK);
#pragma unroll
      for (int g = 0; g < 4; ++g) { float w[4], z[4];
#pragma unroll
          for (int e = 0; e < 4; ++e) { const int s = 8 * g + 4 * h + e; w[e] = s <= r ? x[4 * g + e] : 0.f; z[e] = s <= r ? y[4 * g + e] : 0.f; }
          *(u32x2*)(ARB + r * 32 + 8 * g + 4 * h) = (u32x2){cvtpk(w[0], w[1]), cvtpk(w[2], w[3])}; *(u32x2*)(ARK + r * 32 + 8 * g + 4 * h) = (u32x2){cvtpk(z[0], z[1]), cvtpk(z[2], z[3])}; } }
#pragma unroll
    for (int n = 0; n < 2; ++n) { fx16 x = zero;
#pragma unroll
        for (int ks = 0; ks < 2; ++ks) { const bfx8 a = *(const bfx8*)(LakB + r * 32 + 16 * ks + 8 * h); const bfx8 bb = *(const bfx8*)(VT + (32 * n + r) * 32 + 16 * ks + 8 * h); x = MFMA32(a, bb, x); }
#pragma unroll
        for (int g = 0; g < 4; ++g) *(f32x4*)(GT + (32 * n + r) * 32 + 4 * ((2 * g + h) ^ (r & 7))) = (f32x4){x[4 * g], x[4 * g + 1], x[4 * g + 2], x[4 * g + 3]}; }
#pragma unroll
    for (int q = 0; q < 4; ++q) *(u32x4*)(ATs + (lane + 64 * q) * 8) = atv[q];
    float xp[32], xq[32];
    { unsigned xu[32];
#pragma unroll
      for (int t = 0; t < 32; ++t) xu[t] = ATs[t * 64 + lane];
#pragma unroll
      for (int g = 0; g < 4; ++g) asm volatile("" : "+v"(xu[8 * g]), "+v"(xu[8 * g + 1]), "+v"(xu[8 * g + 2]), "+v"(xu[8 * g + 3]), "+v"(xu[8 * g + 4]), "+v"(xu[8 * g + 5]), "+v"(xu[8 * g + 6]), "+v"(xu[8 * g + 7]));
#pragma unroll
      for (int t = 0; t < 32; ++t) xp[t] = __builtin_bit_cast(float, xu[t] << 16); }
#pragma unroll
    for (int q = 0; q < 8; ++q) { const f32x4 gv = *(const f32x4*)(GT + lane * 32 + 4 * (q ^ (lane & 7))); xq[4 * q] = gv.x; xq[4 * q + 1] = gv.y; xq[4 * q + 2] = gv.z; xq[4 * q + 3] = gv.w; }
    { f32x4 l0[16]; sub_load<1>(Lf, l0); sub_step<1>(Lf, xp, xq, l0); }
    { bf16* Pg = (bf16*)(o1 + O_P);
#pragma unroll
      for (int t = 0; t < 32; ++t) Pg[t * 64 + lane] = (bf16)f2bf(xp[t]);
      u32x4* Qg = (u32x4*)(o1 + O_QT + lane * 64);
#pragma unroll
      for (int q = 0; q < 4; ++q) Qg[q] = (u32x4){cvtpk(xq[8 * q], xq[8 * q + 1]), cvtpk(xq[8 * q + 2], xq[8 * q + 3]), cvtpk(xq[8 * q + 4], xq[8 * q + 5]), cvtpk(xq[8 * q + 6], xq[8 * q + 7])}; }
}

constexpr int S2_P = 0, S2_QT = 4608, S2_BHT = 9728, S2_KHT = 14848, S2_VT = 19968, S2_ECW = 25088, S2_BUF = 25344;
__device__ __forceinline__ void s2_src_dst(int idx, const unsigned char* ch, const unsigned char* o1, const unsigned char*& src, int& dst) {
    if (idx < 256) { src = o1 + O_P + idx * 16; dst = S2_P + (idx >> 3) * 144 + (idx & 7) * 16; }
    else if (idx < 1280) { const int a = (idx - 256) >> 8, j = (idx - 256) & 255;
        src = (a == 0 ? o1 + O_QT : a == 1 ? ch + CH_BHT : a == 2 ? ch + CH_KHT : ch + CH_VT) + j * 16; dst = S2_QT + a * 5120 + (j >> 2) * 80 + (j & 3) * 16; }
    else { src = ch + CH_ECW + (idx - 1280) * 16; dst = S2_ECW + (idx - 1280) * 16; }
}
__device__ __forceinline__ bfx8 cat8(u32x2 lo, u32x2 hi) { return __builtin_bit_cast(bfx8, (u32x4){lo.x, lo.y, hi.x, hi.y}); }
__device__ __forceinline__ void rwkv_stage2(int bh, const RwcBuf& B, unsigned char* ldsb) {
    const int TID = tidx();
    const int lane = TID & 63, wave = TID >> 6, r = lane & 31, h = lane >> 5, n = wave;
    const unsigned char* chb = B.CH + (size_t)bh * NCH * CH_STRIDE; const unsigned char* o1b = B.O1 + (size_t)bh * NCH * O_STRIDE;
    unsigned char* stb = B.ST + (size_t)bh * NCH * ST_STRIDE;
    u32x4 preA[4], preB[4]; preA[0] = preA[1] = preA[2] = preA[3] = preB[0] = preB[1] = preB[2] = preB[3] = (u32x4){0u, 0u, 0u, 0u};
    const int TS = TID - 128;
#define S2_LOAD(R, cc) { _Pragma("unroll") for (int i = 0; i < 4; ++i) { const int idx = TS + 384 * i; if (TS >= 0 && idx < 1296) { const unsigned char* s_; int d_; s2_src_dst(idx, chb + (size_t)(cc) * CH_STRIDE, o1b + (size_t)(cc) * O_STRIDE, s_, d_); R[i] = *(const u32x4*)s_; } } }
#define S2_WRITE(R, bo) { _Pragma("unroll") for (int i = 0; i < 4; ++i) { const int idx = TS + 384 * i; if (TS >= 0 && idx < 1296) { const unsigned char* s_; int d_; s2_src_dst(idx, chb, o1b, s_, d_); *(u32x4*)(ldsb + (bo) + d_) = R[i]; } } }
    S2_LOAD(preA, 0); S2_WRITE(preA, 0);
    S2_LOAD(preB, 1);
    __syncthreads();
    fx16 S[2]; S[0] = fx16{}; S[1] = fx16{};
    int bcur = 0;
    for (int c2 = 0; c2 < NCH; c2 += 2) {
#pragma unroll
        for (int par = 0; par < 2; ++par) { const int c = c2 + par;
        const unsigned char* cur = ldsb + bcur; const int bnxt = bcur == 2 * S2_BUF ? 0 : bcur + S2_BUF;
        if (c + 2 < NCH) { if (par == 0) S2_LOAD(preA, c + 2) else S2_LOAD(preB, c + 2) }
        if (wave < 2) {
            unsigned char* st = stb + (size_t)c * ST_STRIDE;
            bfx8 sb[4];
#pragma unroll
            for (int ks = 0; ks < 4; ++ks) { const fx16& T = S[ks >> 1]; const int o = 8 * (ks & 1);
                sb[ks] = __builtin_bit_cast(bfx8, (u32x4){cvtpk(T[o], T[o + 1]), cvtpk(T[o + 2], T[o + 3]), cvtpk(T[o + 4], T[o + 5]), cvtpk(T[o + 6], T[o + 7])}); }
            { bf16* Sg = (bf16*)(st + ST_S0);
#pragma unroll
              for (int ks = 0; ks < 4; ++ks) { const u32x4 w = __builtin_bit_cast(u32x4, sb[ks]);
                  *(u32x2*)(Sg + (32 * n + r) * 64 + 16 * ks + 4 * h) = (u32x2){w.x, w.y}; *(u32x2*)(Sg + (32 * n + r) * 64 + 16 * ks + 8 + 4 * h) = (u32x2){w.z, w.w}; } }
            fx16 U;
            { const bf16* QTl = (const bf16*)(cur + S2_QT);
#pragma unroll
              for (int g = 0; g < 4; ++g) { const u32x2 q2 = *(const u32x2*)(QTl + (32 * n + r) * 40 + 8 * g + 4 * h); U[4 * g] = bflo(q2.x); U[4 * g + 1] = bfhi(q2.x); U[4 * g + 2] = bflo(q2.y); U[4 * g + 3] = bfhi(q2.y); } }
            { const bf16* Pl = (const bf16*)(cur + S2_P);
#pragma unroll
              for (int ks = 0; ks < 4; ++ks) { const bfx8 pa = cat8(*(const u32x2*)(Pl + r * 72 + 16 * ks + 4 * h), *(const u32x2*)(Pl + r * 72 + 16 * ks + 8 + 4 * h)); U = MFMA32(pa, sb[ks], U); } }
            bfx8 ub[2];
#pragma unroll
            for (int ks = 0; ks < 2; ++ks) { const int o = 8 * ks; ub[ks] = __builtin_bit_cast(bfx8, (u32x4){cvtpk(U[o], U[o + 1]), cvtpk(U[o + 2], U[o + 3]), cvtpk(U[o + 4], U[o + 5]), cvtpk(U[o + 6], U[o + 7])}); }
            { bf16* Ug = (bf16*)(st + ST_UT);
#pragma unroll
              for (int ks = 0; ks < 2; ++ks) { const u32x4 w = __builtin_bit_cast(u32x4, ub[ks]);
                  *(u32x2*)(Ug + (32 * n + r) * 32 + 16 * ks + 4 * h) = (u32x2){w.x, w.y}; *(u32x2*)(Ug + (32 * n + r) * 32 + 16 * ks + 8 + 4 * h) = (u32x2){w.z, w.w}; } }
            const bf16* BHl = (const bf16*)(cur + S2_BHT); const bf16* KHl = (const bf16*)(cur + S2_KHT); const bf16* VTl = (const bf16*)(cur + S2_VT); const float* El = (const float*)(cur + S2_ECW);
            bfx8 vb[2];
#pragma unroll
            for (int ks = 0; ks < 2; ++ks) vb[ks] = *(const bfx8*)(VTl + (32 * n + r) * 40 + 16 * ks + 8 * h);
#pragma unroll
            for (int m = 0; m < 2; ++m) { fx16 acc;
#pragma unroll
                for (int g = 0; g < 4; ++g) { const f32x4 e4 = *(const f32x4*)(El + 32 * m + 8 * g + 4 * h); acc[4 * g] = S[m][4 * g] * e4.x; acc[4 * g + 1] = S[m][4 * g + 1] * e4.y; acc[4 * g + 2] = S[m][4 * g + 2] * e4.z; acc[4 * g + 3] = S[m][4 * g + 3] * e4.w; }
#pragma unroll
                for (int ks = 0; ks < 2; ++ks) { const bfx8 ba = cat8(*(const u32x2*)(BHl + (32 * m + r) * 40 + 16 * ks + 4 * h), *(const u32x2*)(BHl + (32 * m + r) * 40 + 16 * ks + 8 + 4 * h));
                    const bfx8 ka = *(const bfx8*)(KHl + (32 * m + r) * 40 + 16 * ks + 8 * h);
                    acc = MFMA32(ba, ub[ks], acc); acc = MFMA32(ka, vb[ks], acc); }
                S[m] = acc; }
        }
        if (c + 1 < NCH) { if (par == 0) S2_WRITE(preB, bnxt) else S2_WRITE(preA, bnxt) }
        __syncthreads();
        bcur = bnxt; }
    }
#undef S2_LOAD
#undef S2_WRITE
}

__device__ __forceinline__ void rwkv_stage3(int item, const bf16* __restrict__ p, const RwkvP& P, const RwcBuf& B, bf16* ybuf, unsigned char* wl) {
    const int TID = tidx();
    const int lane = TID & 63, r = lane & 31, h = lane >> 5;
    const int bh = item / NCH, chunk = item % NCH, b = bh / NH, hd = bh % NH;
    const unsigned char* ch = B.CH + (size_t)item * CH_STRIDE; const unsigned char* o1 = B.O1 + (size_t)item * O_STRIDE; const unsigned char* st = B.ST + (size_t)item * ST_STRIDE;
    const bf16* Sg = (const bf16*)(st + ST_S0); const bf16* UT = (const bf16*)(st + ST_UT);
    float* Yf = (float*)wl;
    const bf16* ARB = (const bf16*)(o1 + O_ARB); const bf16* ARK = (const bf16*)(o1 + O_ARK);
    const bf16* RT = (const bf16*)(ch + CH_RT); const bf16* VT = (const bf16*)(ch + CH_VT); const bf16* VR = (const bf16*)(ch + CH_VR);
    bfx8 fR[4], fArb[2], fArk[2], sbf[2][4], ubf[2][2], vbf[2][2];
#pragma unroll
    for (int ks = 0; ks < 4; ++ks) fR[ks] = *(const bfx8*)(RT + r * 64 + 16 * ks + 8 * h);
#pragma unroll
    for (int ks = 0; ks < 2; ++ks) { fArb[ks] = *(const bfx8*)(ARB + r * 32 + 16 * ks + 8 * h); fArk[ks] = *(const bfx8*)(ARK + r * 32 + 16 * ks + 8 * h); }
#pragma unroll
    for (int n = 0; n < 2; ++n) {
#pragma unroll
        for (int ks = 0; ks < 4; ++ks) sbf[n][ks] = *(const bfx8*)(Sg + (32 * n + r) * 64 + 16 * ks + 8 * h);
#pragma unroll
        for (int ks = 0; ks < 2; ++ks) { ubf[n][ks] = *(const bfx8*)(UT + (32 * n + r) * 32 + 16 * ks + 8 * h); vbf[n][ks] = *(const bfx8*)(VT + (32 * n + r) * 32 + 16 * ks + 8 * h); } }
#pragma unroll
    for (int n = 0; n < 2; ++n) { fx16 y = {};
#pragma unroll
        for (int ks = 0; ks < 4; ++ks) y = MFMA32(fR[ks], sbf[n][ks], y);
#pragma unroll
        for (int ks = 0; ks < 2; ++ks) { y = MFMA32(fArb[ks], ubf[n][ks], y); y = MFMA32(fArk[ks], vbf[n][ks], y); }
#pragma unroll
        for (int reg = 0; reg < 16; ++reg) Yf[crow16(reg, h) * 68 + 32 * n + r] = y[reg]; }
    { const int t = lane >> 1, hf = lane & 1; const float* yr = Yf + t * 68 + 32 * hf; float yv[32]; float s = 0.f;
#pragma unroll
      for (int q = 0; q < 8; ++q) { const f32x4 v4 = *(const f32x4*)(yr + 4 * q); yv[4 * q] = v4.x; yv[4 * q + 1] = v4.y; yv[4 * q + 2] = v4.z; yv[4 * q + 3] = v4.w; s += (v4.x + v4.y) + (v4.z + v4.w); }
      s += dpp0<0xB1, 0xf>(s); const float mu = s * (1.f / 64.f); float q2 = 0.f;
#pragma unroll
      for (int i = 0; i < 32; ++i) { yv[i] -= mu; q2 += yv[i] * yv[i]; }
      q2 += dpp0<0xB1, 0xf>(q2); const float rstd = rsqrtf(q2 * (1.f / 64.f) + 64e-5f);
      const float c3 = ((const float*)(ch + CH_C3))[t];
      const size_t row = (size_t)(b * SEQ + chunk * RC + t); const int c0 = hd * HD + 32 * hf;
      const u32x4* vr = (const u32x4*)(VR + t * 64 + 32 * hf); const u32x4* gp = (const u32x4*)(p + row * NINP + OFF_GB + c0); u32x4* yo = (u32x4*)(ybuf + row * DM + LRU_W + c0);
      const f32x4* lwp = (const f32x4*)(P.ln_w + c0); const f32x4* lbp = (const f32x4*)(P.ln_b + c0);
      u32x4 vvq[4], ggq[4]; f32x4 lwq[8], lbq[8];
#pragma unroll
      for (int q = 0; q < 4; ++q) { vvq[q] = vr[q]; ggq[q] = gp[q]; lwq[2 * q] = lwp[2 * q]; lwq[2 * q + 1] = lwp[2 * q + 1]; lbq[2 * q] = lbp[2 * q]; lbq[2 * q + 1] = lbp[2 * q + 1]; }
      asm volatile("" : "+v"(vvq[0]), "+v"(vvq[1]), "+v"(vvq[2]), "+v"(vvq[3]), "+v"(ggq[0]), "+v"(ggq[1]), "+v"(ggq[2]), "+v"(ggq[3]));
      asm volatile("" : "+v"(lwq[0]), "+v"(lwq[1]), "+v"(lwq[2]), "+v"(lwq[3]), "+v"(lwq[4]), "+v"(lwq[5]), "+v"(lwq[6]), "+v"(lwq[7]));
      asm volatile("" : "+v"(lbq[0]), "+v"(lbq[1]), "+v"(lbq[2]), "+v"(lbq[3]), "+v"(lbq[4]), "+v"(lbq[5]), "+v"(lbq[6]), "+v"(lbq[7]));
#pragma unroll
      for (int q = 0; q < 4; ++q) { const u32x4 vv = vvq[q], gg = ggq[q]; const f32x4 w0 = lwq[2 * q], w1 = lwq[2 * q + 1], b0 = lbq[2 * q], b1 = lbq[2 * q + 1]; u32x4 o;
          const float wv[8] = {w0.x, w0.y, w0.z, w0.w, w1.x, w1.y, w1.z, w1.w}, bv[8] = {b0.x, b0.y, b0.z, b0.w, b1.x, b1.y, b1.z, b1.w};
#pragma unroll
          for (int e = 0; e < 4; ++e) { const float v0 = bflo(vv[e]), v1 = bfhi(vv[e]), g0 = bflo(gg[e]), g1 = bfhi(gg[e]);
              const float y0 = yv[8 * q + 2 * e] * rstd * wv[2 * e] + bv[2 * e] + c3 * v0, y1 = yv[8 * q + 2 * e + 1] * rstd * wv[2 * e + 1] + bv[2 * e + 1] + c3 * v1;
              o[e] = cvtpk(y0 * siluf_(g0), y1 * siluf_(g1)); }
          yo[q] = o; } }
}


__device__ __forceinline__ void phase_moba_kmean(const bf16* p, float* kmean, int vbid, int vgrid) {
    const int TID = tidx();
    const int lane = TID & 63, wave = TID >> 6;
    for (int item = vbid * NWAVES + wave; item < NB * NH * NBLK; item += vgrid * NWAVES) {
        const int n = item % NBLK, bh = item / NBLK, b = bh / NH, h = bh % NH;
        const bf16* kp = p + (size_t)(b * SEQ + n * BLK + (lane >> 3)) * NINP + OFF_QKV + MOW + h * HD + (lane & 7) * 8;
        float s[8];
#pragma unroll
        for (int e = 0; e < 8; ++e) s[e] = 0.f;
#pragma unroll
        for (int half = 0; half < 2; ++half) { u32x4 v[16];
#pragma unroll
            for (int q = 0; q < 16; ++q) v[q] = *(const u32x4*)(kp + (size_t)(8 * (16 * half + q)) * NINP);
#pragma unroll
            for (int q = 0; q < 16; ++q)
#pragma unroll
                for (int e = 0; e < 4; ++e) { s[2 * e] += bflo(v[q][e]); s[2 * e + 1] += bfhi(v[q][e]); } }
#pragma unroll
        for (int e = 0; e < 8; ++e) { s[e] += dpp0<0x128, 0xf>(s[e]);
            s[e] += __builtin_bit_cast(float, __builtin_amdgcn_ds_swizzle(__builtin_bit_cast(int, s[e]), 0x401F));
            float a_ = s[e], b_ = s[e]; asm volatile("s_nop 1\n\tv_permlane32_swap_b32 %0, %1" : "+v"(a_), "+v"(b_)); s[e] = a_ + b_; }
        if (lane < 8) { float* dst = kmean + ((size_t)bh * NBLK + n) * HD + lane * 8;
            *(f32x4*)dst = (f32x4){s[0], s[1], s[2], s[3]} * (1.f / BLK); *(f32x4*)(dst + 4) = (f32x4){s[4], s[5], s[6], s[7]} * (1.f / BLK); }
    }
}
namespace attn_body {
using bf16=__hip_bfloat16;
using bf16x8=__attribute__((ext_vector_type(8)))short;
using s16x4=__attribute__((ext_vector_type(4)))short;
using f32x16=__attribute__((ext_vector_type(16)))float;
using u32x4=__attribute__((ext_vector_type(4)))unsigned;
using f32x4v=__attribute__((ext_vector_type(4)))float;
constexpr int BATCH=2,NHEAD=12,SEQ=4096,D=64,DM=7424;
constexpr int YP=2048, QCOL=4224, KCOL=4224+768, VCOL=4224+1536, GCOL=6528, YCOL=1280;
constexpr int NW=8,QBLK=32,QB=QBLK*NW,KVBLK=64,NQB=SEQ/QB;
constexpr int ATTN_PITCH=DM, ATTN_UNIT_ROWS=QB;
__device__ __forceinline__ int crow(int r,int hi){return (r&3)+8*(r>>2)+4*hi;}
#define SBAR() __builtin_amdgcn_sched_barrier(0)
__device__ __forceinline__ void moba_hook(f32x16&p0,f32x16&p1,int t,int NT,int qrel,int hi,unsigned selbits,const float*tab){
  const float NEG=-INFINITY;
  asm volatile("":"+v"(qrel));
  const int jb=t-(NT-4);
  if(t>=NT-6){
    const bool keep=jb>=0?true:(((selbits>>(t>>2))&1u)!=0u);
    const int dq=qrel-64*jb-4*hi;
    #pragma unroll
    for(int g=0;g<4;++g){
      #pragma unroll
      for(int rr=0;rr<4;++rr){ const int r=4*g+rr; const int d0=dq-((r&3)+8*(r>>2)), d1=d0-32;
        const int i0=d0<0?0:(d0<127?d0:127), i1=d1<0?0:(d1<127?d1:127);
        const float b0=tab[i0], b1=tab[i1];
        p0[r]=(keep&&d0>=0)?p0[r]+b0:NEG; p1[r]=(keep&&d1>=0)?p1[r]+b1:NEG; }
      asm volatile("":"+v"(p0),"+v"(p1)); SBAR();
    }
  } else {
    const bool keep=(selbits>>(t>>2))&1u;
    #pragma unroll
    for(int r=0;r<16;++r){p0[r]=keep?p0[r]:NEG; p1[r]=keep?p1[r]:NEG;}
  }
}
__device__ __forceinline__ void swap32(float&a,float&b){asm volatile("s_nop 1\n\tv_permlane32_swap_b32 %0, %1":"+v"(a),"+v"(b));}

constexpr int NSLOT=3, SLOTB=8192;
constexpr int LDS_K=0, LDS_V=NSLOT*SLOTB, LDS_WS=2*NSLOT*SLOTB, LDS_OST=LDS_WS+NW*64*4, LDS_TAB=LDS_OST+NW*4096, LDS_BYTES=LDS_TAB+512;
constexpr float C2=0.125f*1.4426950408889634f;
__device__ __forceinline__ void glds16(const void*gsrc,unsigned lds_dst){unsigned keep;
  asm volatile("s_mov_b32 %0, m0\n\ts_mov_b32 m0, %2\n\ts_nop 0\n\tglobal_load_lds_dwordx4 %1, off\n\ts_mov_b32 m0, %0":"=&s"(keep):"v"(gsrc),"s"(lds_dst):"memory");}
__device__ __forceinline__ float max3f(float a,float b,float c){float r;asm("v_max3_f32 %0, %1, %2, %3":"=v"(r):"v"(a),"v"(b),"v"(c));return r;}
__device__ __forceinline__ float max2f(float a,float b){float r;asm("v_max_f32_e32 %0, %1, %2":"=v"(r):"v"(a),"v"(b));return r;}
__device__ __forceinline__ float fadd_s(float a,float b){float r;asm("v_add_f32_e32 %0, %1, %2":"=v"(r):"v"(a),"v"(b));return r;}
__device__ __forceinline__ float fsub_s(float a,float b){float r;asm("v_sub_f32_e32 %0, %1, %2":"=v"(r):"v"(a),"v"(b));return r;}
typedef float f32x2_t __attribute__((ext_vector_type(2))); typedef __bf16 bf16x2_t __attribute__((ext_vector_type(2)));
__device__ __forceinline__ unsigned cvtpk_s(float lo,float hi){f32x2_t v={lo,hi};bf16x2_t b=__builtin_convertvector(v,bf16x2_t);return __builtin_bit_cast(unsigned,b);}
#define WAIT_BAR(N) asm volatile("s_waitcnt vmcnt(" #N ") lgkmcnt(0)\n\ts_barrier":::"memory")

__device__ __forceinline__ void qkt(f32x16&p0,f32x16&p1,const char*Kslot,const bf16x8*qr,const f32x16&negm,int r32,int hi){
  const char*kb=Kslot+hi*1024+r32*16;
  #pragma unroll
  for(int d0=0;d0<4;++d0){
    const bf16x8 b0=*reinterpret_cast<const bf16x8*>(kb+d0*2048);
    const bf16x8 b1=*reinterpret_cast<const bf16x8*>(kb+d0*2048+512);
    if(d0==0){p0=__builtin_amdgcn_mfma_f32_32x32x16_bf16(b0,qr[0],negm,0,0,0);p1=__builtin_amdgcn_mfma_f32_32x32x16_bf16(b1,qr[0],negm,0,0,0);}
    else{p0=__builtin_amdgcn_mfma_f32_32x32x16_bf16(b0,qr[d0],p0,0,0,0);p1=__builtin_amdgcn_mfma_f32_32x32x16_bf16(b1,qr[d0],p1,0,0,0);}}
}
typedef __attribute__((address_space(3))) const char* lds_cptr;
typedef short v4i16_t __attribute__((ext_vector_type(4)));
__device__ __forceinline__ void kload8(bf16x8*kf,lds_cptr kp){
  kf[0]=*(const __attribute__((address_space(3))) bf16x8*)(kp);      kf[1]=*(const __attribute__((address_space(3))) bf16x8*)(kp+512);
  kf[2]=*(const __attribute__((address_space(3))) bf16x8*)(kp+2048); kf[3]=*(const __attribute__((address_space(3))) bf16x8*)(kp+2560);
  kf[4]=*(const __attribute__((address_space(3))) bf16x8*)(kp+4096); kf[5]=*(const __attribute__((address_space(3))) bf16x8*)(kp+4608);
  kf[6]=*(const __attribute__((address_space(3))) bf16x8*)(kp+6144); kf[7]=*(const __attribute__((address_space(3))) bf16x8*)(kp+6656);
}
__device__ __forceinline__ void kload2(bf16x8*kf,lds_cptr kp,int j){ kf[2*j]=*(const __attribute__((address_space(3))) bf16x8*)(kp+j*2048); kf[2*j+1]=*(const __attribute__((address_space(3))) bf16x8*)(kp+j*2048+512); }
__device__ __forceinline__ s16x4 vtr(lds_cptr p){ return __builtin_bit_cast(s16x4,__builtin_amdgcn_ds_read_tr16_b64_v4i16((__attribute__((address_space(3))) v4i16_t*)p)); }
__device__ __forceinline__ float rowmax(const f32x16&p0,const f32x16&p1){
  float a=max3f(p0[0],p0[1],p1[0]),b=max3f(p0[2],p0[3],p1[1]);a=max3f(a,p1[2],p1[3]);
  #pragma unroll
  for(int r=4;r<16;r+=4){a=max3f(a,p0[r],p0[r+1]);b=max3f(b,p0[r+2],p0[r+3]);a=max3f(a,p1[r],p1[r+1]);b=max3f(b,p1[r+2],p1[r+3]);}
  float m=max2f(a,b), m2=m; swap32(m,m2);
  return max2f(m,m2);
}
__device__ __forceinline__ void pv(f32x16*o,int vb,bf16x8 pa0,bf16x8 pa1,bf16x8 pa2,bf16x8 pa3){
  #pragma unroll
  for(int d0=0;d0<2;++d0){s16x4 lo[4],hi[4];
    #pragma unroll
    for(int ks=0;ks<4;++ks){
      asm volatile("ds_read_b64_tr_b16 %0,%1 offset:%c2":"=&v"(lo[ks]):"v"(vb),"i"(d0*4096+ks*1024):"memory");
      asm volatile("ds_read_b64_tr_b16 %0,%1 offset:%c2":"=&v"(hi[ks]):"v"(vb),"i"(d0*4096+ks*1024+512):"memory");}
    asm volatile("s_waitcnt lgkmcnt(0)":::"memory");SBAR();
    #define PK(k) (bf16x8){lo[k][0],lo[k][1],lo[k][2],lo[k][3],hi[k][0],hi[k][1],hi[k][2],hi[k][3]}
    o[d0]=__builtin_amdgcn_mfma_f32_32x32x16_bf16(pa0,PK(0),o[d0],0,0,0);
    o[d0]=__builtin_amdgcn_mfma_f32_32x32x16_bf16(pa1,PK(1),o[d0],0,0,0);
    o[d0]=__builtin_amdgcn_mfma_f32_32x32x16_bf16(pa2,PK(2),o[d0],0,0,0);
    o[d0]=__builtin_amdgcn_mfma_f32_32x32x16_bf16(pa3,PK(3),o[d0],0,0,0);
    #undef PK
  }
}

#ifndef ATTN_STORE16
#define ATTN_STORE16(p,v) (*(u32x4*)(p)=(v))
#endif
template<int THRL> __device__ __forceinline__ void attn_unit(int b,int h,int qb,const bf16*__restrict__ Pq,const float*__restrict__ kmean_bh,const float*__restrict__ rel_bias,bf16*__restrict__ Yo,char*shm,unsigned*qctr,int nslot){
  int tid_=threadIdx.x; asm volatile("":"+v"(tid_)); const int tid=tid_,lane=tid&63,r32=lane&31,hi=lane>>5; const int wid=__builtin_amdgcn_readfirstlane(tid>>6);
  const long rowbase=(long)b*SEQ; const int q0=qb*QB;
  const bf16*Qw=Pq+(rowbase+q0+wid*QBLK)*DM+QCOL+h*D;
  const bf16*Kh=Pq+rowbase*DM+KCOL+h*D,*Vh=Pq+rowbase*DM+VCOL+h*D;
  float*tab=(float*)(shm+LDS_TAB);
  const unsigned lds0=(unsigned)(uintptr_t)shm;
  float*wsf=(float*)(shm+LDS_WS)+wid*64;
  const bf16*ksrc=Kh+(long)lane*DM+wid*8;
  const bf16*vsrc=Vh+(long)(16*(wid&3)+(lane>>2))*DM+(wid>>2)*32+(lane&3)*8;
  const unsigned kdst=lds0+LDS_K+wid*1024, vdst=lds0+LDS_V+wid*1024;
  #define DMA_K(t,slot) glds16(ksrc+(long)(t)*KVBLK*DM,(unsigned)__builtin_amdgcn_readfirstlane(kdst+(slot)))
  #define DMA_V(t,slot) glds16(vsrc+(long)(t)*KVBLK*DM,(unsigned)__builtin_amdgcn_readfirstlane(vdst+(slot)))
  const int vb0=(int)(lds0+LDS_V)+((lane>>4)&1)*32+(lane&3)*8+(4*hi+((lane&15)>>2))*64;
  const char*Kbase=shm+LDS_K; bf16x8 kf[8];
  const lds_cptr shm3=(lds_cptr)shm; const lds_cptr kp0=shm3+LDS_K+hi*1024+r32*16; const lds_cptr vp0=shm3+LDS_V+((lane>>4)&1)*32+(lane&3)*8+(4*hi+((lane&15)>>2))*64;
  const int NT=(q0+QB)/KVBLK;
  DMA_K(0,0);DMA_V(0,0);DMA_K(1,SLOTB);
  bf16x8 qr[4];
  #pragma unroll
  for(int d0=0;d0<4;++d0)qr[d0]=*reinterpret_cast<const bf16x8*>(&Qw[(long)r32*DM+d0*16+hi*8]);
  if(tid<128){ const int n=tid; int bk=n; if(n>=16){ bk=16+(int)(logf((float)n/16.f)/2.0794415416798357f*16.f); bk=bk<31?bk:31; }
    tab[n]=(rel_bias[bk*NHEAD+h]-rel_bias[31*NHEAD+h])*1.4426950408889634f; }
  unsigned selbits=0u;
  { float qf[32];
    #pragma unroll
    for(int d0=0;d0<4;++d0){
      #pragma unroll
      for(int j=0;j<8;++j)qf[8*d0+j]=__uint_as_float(((unsigned)(unsigned short)qr[d0][j])<<16); }
    int s0=-1,s1=-1,s2=-1; float g0=-INFINITY,g1=-INFINITY,g2=-INFINITY;
    for(int n=0;n<qb;++n){ const float*km=kmean_bh+n*64+8*hi; float g=0.f;
      #pragma unroll
      for(int d0=0;d0<4;++d0){ const f32x4v k0=*(const f32x4v*)(km+16*d0), k1=*(const f32x4v*)(km+16*d0+4);
        g+=qf[8*d0+0]*k0[0]+qf[8*d0+1]*k0[1]+qf[8*d0+2]*k0[2]+qf[8*d0+3]*k0[3]+qf[8*d0+4]*k1[0]+qf[8*d0+5]*k1[1]+qf[8*d0+6]*k1[2]+qf[8*d0+7]*k1[3]; }
      float g_=g; swap32(g,g_); g=g+g_;
      if(g>g0){g2=g1;s2=s1;g1=g0;s1=s0;g0=g;s0=n;} else if(g>g1){g2=g1;s2=s1;g1=g;s1=n;} else if(g>g2){g2=g;s2=n;} }
    if(s0>=0)selbits|=1u<<s0; if(s1>=0)selbits|=1u<<s1; if(s2>=0)selbits|=1u<<s2; }
  float mhat=0.f,l_reg=0.f;f32x16 o[2];o[0]=f32x16{};o[1]=f32x16{};f32x16 negm=f32x16{};asm volatile("":"+v"(negm));
  const int qrel=wid*QBLK+r32;
  #define CMASK(P0,P1,t) moba_hook(P0,P1,t,NT,qrel,hi,selbits,tab)
  bool resc=false;
  #define START(P0,P1) do{ const float rm=rowmax(P0,P1); resc=false; \
    { const float dl=rm<-1e30f?-1024.f:rm; mhat=fadd_s(mhat,dl); \
      _Pragma("unroll") for(int r=0;r<16;++r){P0[r]=fsub_s(P0[r],dl);P1[r]=fsub_s(P1[r],dl);} \
      _Pragma("unroll") for(int r=0;r<16;++r)negm[r]=-mhat; asm volatile("":"+v"(negm)); } \
    _Pragma("unroll") for(int r=0;r<16;++r)P0[r]=__builtin_amdgcn_exp2f(P0[r]); }while(0)
  #define RESC() do{ if(resc){ asm volatile("s_waitcnt lgkmcnt(0)":::"memory"); \
      _Pragma("unroll") for(int d_=0;d_<2;++d_) _Pragma("unroll") for(int r=0;r<16;++r)o[d_][r]*=wsf[crow(r,hi)]; } }while(0)
  f32x16 pA0,pA1,pB0,pB1;
  int sl_prev=0,sl_cur=0,sl_next=SLOTB;
  #define ROT() do{sl_prev=sl_cur;sl_cur=sl_next;sl_next=(sl_next==(NSLOT-1)*SLOTB)?0:sl_next+SLOTB;}while(0)
  DMA_K(2,2*SLOTB);
  if(tid==448){ const unsigned nx_=__hip_atomic_fetch_add(qctr,1u,__ATOMIC_RELAXED,__HIP_MEMORY_SCOPE_AGENT); *(volatile __attribute__((address_space(3))) unsigned*)(lds0+131072u+320u+4u*(unsigned)nslot)=nx_; }
  WAIT_BAR(3);
  qkt(pA0,pA1,Kbase,qr,negm,r32,hi);asm volatile("s_nop 15\n\ts_nop 7":"+v"(pA0),"+v"(pA1));CMASK(pA0,pA1,0);
  START(pA0,pA1);
  _Pragma("unroll") for(int r=0;r<16;++r)pA1[r]=__builtin_amdgcn_exp2f(pA1[r]);
  WAIT_BAR(0);
  DMA_K(3,0);DMA_V(1,SLOTB);
  ROT();
  kload8(kf,kp0+sl_cur);
  WAIT_BAR(2);
  s16x4 vlo[8],vhi[8]; u32x4 pw0,pw1,pw2,pw3;
  #define PKW(P,B) cvtpk_s(P[B],P[B+1])
  #define PAF(k) __builtin_bit_cast(bf16x8,pw##k)
  #define VFR(i) (bf16x8){vlo[i][0],vlo[i][1],vlo[i][2],vlo[i][3],vhi[i][0],vhi[i][1],vhi[i][2],vhi[i][3]}
  #define PIN(x) asm volatile("":"+v"(x))
  #define MX3(a,b,c) __builtin_fmaxf(__builtin_fmaxf((a),(b)),(c))
  #define GAPA(MF,A0,A1,A2,A3,W0,W1,PW) do{ MF; sacc+=A0; sacc+=A1; sacc+=A2; sacc+=A3; PIN(sacc); W0; W1; PIN(PW); SBAR(); }while(0)
  #define EX(v) __builtin_amdgcn_exp2f(v)
  #define GAPB(MF,X,B) do{ MF; X[B]=EX(X[B]); X[B+1]=EX(X[B+1]); X[B+2]=EX(X[B+2]); X[B+3]=EX(X[B+3]); PIN(X); SBAR(); }while(0)
  #define VRD(i) do{ vlo[i]=vtr(vp_+(((i)>>2)*4096+((i)&3)*1024)); vhi[i]=vtr(vp_+(((i)>>2)*4096+((i)&3)*1024+512)); }while(0)
  #define KRD(G,j) do{ if(G){ kload2(kf,kp0+sl_next,j); SBAR(); } }while(0)
  #define STEP(C0,C1,P0,P1,t,GK,GV,GL) do{ SBAR(); \
    const lds_cptr vp_=vp0+sl_prev; \
    VRD(0); SBAR(); float sacc=(P0[0]+P0[1]); \
    GAPA(C0=__builtin_amdgcn_mfma_f32_32x32x16_bf16(kf[0],qr[0],negm,0,0,0), P0[2],P0[3],P0[4],P0[5],     pw0[0]=PKW(P0,0), pw0[1]=PKW(P0,2), pw0); \
    VRD(4); SBAR(); GAPA(C1=__builtin_amdgcn_mfma_f32_32x32x16_bf16(kf[1],qr[0],negm,0,0,0), P0[6],P0[7],P0[8],P0[9],     pw0[2]=PKW(P0,4), pw0[3]=PKW(P0,6), pw0); \
    VRD(1); SBAR(); GAPA(C0=__builtin_amdgcn_mfma_f32_32x32x16_bf16(kf[2],qr[1],C0,0,0,0),   P0[10],P0[11],P0[12],P0[13], pw1[0]=PKW(P0,8), pw1[1]=PKW(P0,10), pw1); \
    VRD(5); SBAR(); GAPA(C1=__builtin_amdgcn_mfma_f32_32x32x16_bf16(kf[3],qr[1],C1,0,0,0),   P0[14],P0[15],P1[0],P1[1],   pw1[2]=PKW(P0,12),pw1[3]=PKW(P0,14), pw1); \
    VRD(2); SBAR(); GAPA(C0=__builtin_amdgcn_mfma_f32_32x32x16_bf16(kf[4],qr[2],C0,0,0,0),   P1[2],P1[3],P1[4],P1[5],     pw2[0]=PKW(P1,0), pw2[1]=PKW(P1,2), pw2); \
    VRD(6); SBAR(); GAPA(C1=__builtin_amdgcn_mfma_f32_32x32x16_bf16(kf[5],qr[2],C1,0,0,0),   P1[6],P1[7],P1[8],P1[9],     pw2[2]=PKW(P1,4), pw2[3]=PKW(P1,6), pw2); \
    VRD(3); SBAR(); GAPA(C0=__builtin_amdgcn_mfma_f32_32x32x16_bf16(kf[6],qr[3],C0,0,0,0),   P1[10],P1[11],P1[12],P1[13], pw3[0]=PKW(P1,8), pw3[1]=PKW(P1,10), pw3); \
    VRD(7); SBAR(); GAPA(C1=__builtin_amdgcn_mfma_f32_32x32x16_bf16(kf[7],qr[3],C1,0,0,0),   P1[14],P1[15],0.f,0.f,       pw3[2]=PKW(P1,12),pw3[3]=PKW(P1,14), pw3); \
    l_reg+=sacc; \
    if(GK){DMA_K((t)+3,sl_cur);} if(GV){DMA_V((t)+1,sl_next);} \
    CMASK(C0,C1,t); \
    { float a=MX3(C0[0],C0[1],C1[0]),b=MX3(C0[2],C0[3],C1[1]); a=MX3(a,C1[2],C1[3]); \
      _Pragma("unroll") for(int r=4;r<16;r+=4){a=MX3(a,C0[r],C0[r+1]);b=MX3(b,C0[r+2],C0[r+3]);a=MX3(a,C1[r],C1[r+1]);b=MX3(b,C1[r+2],C1[r+3]);} \
      float rm=__builtin_fmaxf(a,b); { float rm2_=rm; swap32(rm,rm2_); rm=__builtin_fmaxf(rm,rm2_); } \
      resc=false; \
      if(__builtin_expect(__any(rm>(float)THRL),0)){ const float dl=__builtin_fmaxf(rm,0.f); mhat+=dl; \
        _Pragma("unroll") for(int r=0;r<16;++r){C0[r]-=dl;C1[r]-=dl;} \
        _Pragma("unroll") for(int r=0;r<16;++r)negm[r]=-mhat; asm volatile("":"+v"(negm)); \
        const float f=__builtin_amdgcn_exp2f(-dl); l_reg*=f; if(hi==0)wsf[r32]=f; resc=true; } } \
    SBAR(); \
    GAPB(o[0]=__builtin_amdgcn_mfma_f32_32x32x16_bf16(PAF(0),VFR(0),o[0],0,0,0), C0,0); \
    GAPB(o[1]=__builtin_amdgcn_mfma_f32_32x32x16_bf16(PAF(0),VFR(4),o[1],0,0,0), C0,4); \
    KRD(GL,0); GAPB(o[0]=__builtin_amdgcn_mfma_f32_32x32x16_bf16(PAF(1),VFR(1),o[0],0,0,0), C0,8); \
    KRD(GL,1); GAPB(o[1]=__builtin_amdgcn_mfma_f32_32x32x16_bf16(PAF(1),VFR(5),o[1],0,0,0), C0,12); \
    KRD(GL,2); GAPB(o[0]=__builtin_amdgcn_mfma_f32_32x32x16_bf16(PAF(2),VFR(2),o[0],0,0,0), C1,0); \
    KRD(GL,3); GAPB(o[1]=__builtin_amdgcn_mfma_f32_32x32x16_bf16(PAF(2),VFR(6),o[1],0,0,0), C1,4); \
    GAPB(o[0]=__builtin_amdgcn_mfma_f32_32x32x16_bf16(PAF(3),VFR(3),o[0],0,0,0), C1,8); \
    GAPB(o[1]=__builtin_amdgcn_mfma_f32_32x32x16_bf16(PAF(3),VFR(7),o[1],0,0,0), C1,12); \
    }while(0)
  int t=1;
  for(;t+5<NT;t+=2){
    STEP(pB0,pB1,pA0,pA1,t,true,true,true);     WAIT_BAR(2); RESC(); ROT();
    STEP(pA0,pA1,pB0,pB1,t+1,true,true,true);   WAIT_BAR(2); RESC(); ROT();
  }
  #define ENDW(tt) do{ if((tt)+3<NT){WAIT_BAR(2);} else if((tt)+2<NT){WAIT_BAR(1);} else {WAIT_BAR(0);} }while(0)
  for(;t+1<NT;t+=2){
    STEP(pB0,pB1,pA0,pA1,t,(t+3<NT),(t+1<NT),(t+1<NT));       ENDW(t);   RESC(); ROT();
    STEP(pA0,pA1,pB0,pB1,t+1,(t+4<NT),(t+2<NT),(t+2<NT));     ENDW(t+1); RESC(); ROT();
  }
  STEP(pB0,pB1,pA0,pA1,NT-1,false,false,false); RESC();
  { float sacc=pB0[0]+pB0[1]; _Pragma("unroll") for(int r=2;r<16;++r)sacc+=pB0[r]; _Pragma("unroll") for(int r=0;r<16;++r)sacc+=pB1[r]; l_reg+=sacc;
    pw0=(u32x4){PKW(pB0,0),PKW(pB0,2),PKW(pB0,4),PKW(pB0,6)};pw1=(u32x4){PKW(pB0,8),PKW(pB0,10),PKW(pB0,12),PKW(pB0,14)};pw2=(u32x4){PKW(pB1,0),PKW(pB1,2),PKW(pB1,4),PKW(pB1,6)};pw3=(u32x4){PKW(pB1,8),PKW(pB1,10),PKW(pB1,12),PKW(pB1,14)};
    SBAR(); pv(o,vb0+sl_cur,PAF(0),PAF(1),PAF(2),PAF(3)); }
  #undef PKW
  #undef PAF
  #undef VFR
  #undef PIN
  #undef MX3
  #undef GAPA
  #undef GAPB
  #undef EX
  #undef VRD
  #undef KRD
  #undef STEP
  #undef ENDW
  { float l2_=l_reg; swap32(l_reg,l2_); l_reg=l_reg+l2_; }
  if(hi==0)wsf[32+r32]=l_reg;asm volatile("s_waitcnt lgkmcnt(0)":::"memory");
  float rli[16];
  #pragma unroll
  for(int r=0;r<16;++r)rli[r]=__builtin_amdgcn_rcpf(wsf[32+crow(r,hi)]);
  bf16*Ow=Yo+(rowbase+q0+wid*QBLK)*YP+YCOL+h*D; const bf16*Gw=Pq+(rowbase+q0+wid*QBLK)*DM+GCOL+h*D;
  { bf16*stg=(bf16*)(shm+LDS_OST)+wid*2048;
    #pragma unroll
    for(int r=0;r<16;++r){const int orow=crow(r,hi);
      #pragma unroll
      for(int d0=0;d0<2;++d0)stg[orow*64+d0*32+r32]=__float2bfloat16(o[d0][r]*rli[r]);}
    asm volatile("s_waitcnt lgkmcnt(0)":::"memory");
    #pragma unroll
    for(int i=0;i<4;++i){const int row=i*8+(lane>>3),ch=lane&7; const u32x4 v=*(const u32x4*)(stg+row*64+ch*8); const u32x4 g=*(const u32x4*)(Gw+(long)row*DM+ch*8); u32x4 w;
      #pragma unroll
      for(int e=0;e<4;++e){ const float a0=__uint_as_float(v[e]<<16),a1=__uint_as_float(v[e]&0xffff0000u),g0=__uint_as_float(g[e]<<16),g1=__uint_as_float(g[e]&0xffff0000u);
        w[e]=cvtpk_s(a0*g0*__builtin_amdgcn_rcpf(1.f+__expf(-g0)),a1*g1*__builtin_amdgcn_rcpf(1.f+__expf(-g1))); }
      ATTN_STORE16(Ow+(long)row*YP+ch*8,w);} }
  asm volatile("s_waitcnt lgkmcnt(0)\n\ts_barrier":::"memory");
  #undef DMA_K
  #undef DMA_V
  #undef CMASK
  #undef START
  #undef RESC
  #undef ROT
}
constexpr int ATTN_LDS_BYTES=LDS_BYTES;
#undef SBAR
#undef WAIT_BAR
}

#define LAS __attribute__((address_space(3)))
#define XB_TMO      128
#define XB_XCNT(j)  (256  + 64 * (j))
#define XB_XSUB(j)  (1280 + 64 * (j))
#define XB_XGEN(j)  (2304 + 64 * (j))
#define XB_TOP      3328
#define XB_TOPGEN   3392
#define XCD_BAR_WORDS 3456
#define XB_SPIN_CAP (1u << 18)

__device__ __forceinline__ unsigned xb_ld(unsigned* p)              { return __hip_atomic_load(p, __ATOMIC_RELAXED, __HIP_MEMORY_SCOPE_AGENT); }
__device__ __forceinline__ unsigned xb_add(unsigned* p, unsigned v) { return __hip_atomic_fetch_add(p, v, __ATOMIC_RELAXED, __HIP_MEMORY_SCOPE_AGENT); }
__device__ __forceinline__ unsigned xb_xcc_id() { return (unsigned)__builtin_amdgcn_s_getreg((3 << 11) | 20) & 0xFu; }
#define XB_SPIN(cond, bar) do { unsigned _sp = 0; while (cond) { __builtin_amdgcn_s_sleep(1); \
    if ((++_sp & 255u) == 0u) { if (xb_ld(&(bar)[XB_TMO])) break; if (_sp > XB_SPIN_CAP) { atomicAdd(&(bar)[XB_TMO], 1u); break; } } } } while (0)

struct XcdBarrier {
    unsigned* bar; unsigned x;
    volatile LAS unsigned* st;
};

__device__ __forceinline__ XcdBarrier xcd_barrier_post(unsigned* bar, volatile LAS unsigned* st) {
    XcdBarrier b; b.bar = bar; b.x = (unsigned)__builtin_amdgcn_readfirstlane((int)xb_xcc_id()); b.st = st;
    if (threadIdx.x == 0) (void)xb_add(&bar[XB_XCNT(b.x)], 1u);
    return b;
}
__device__ __forceinline__ void xcd_barrier_complete(unsigned* bar, unsigned x, unsigned& nloc, unsigned& nx) {
    const unsigned G = gridDim.x * gridDim.y * gridDim.z;
    unsigned sum, cnt, mine, sp = 0u;
    for (;;) {
        sum = 0u; cnt = 0u; mine = 0u;
#pragma unroll
        for (unsigned j = 0; j < 16; ++j) { const unsigned c = xb_ld(&bar[XB_XCNT(j)]); sum += c; cnt += (c > 0u) ? 1u : 0u; mine = (j == x) ? c : mine; }
        if (sum == G) break;
        __builtin_amdgcn_s_sleep(1);
        if ((++sp & 255u) == 0u) { if (xb_ld(&bar[XB_TMO])) break; if (sp > XB_SPIN_CAP) { atomicAdd(&bar[XB_TMO], 1u); break; } }
    }
    nloc = mine > 0u ? mine : 1u; nx = cnt > 0u ? cnt : 1u;
}

__device__ __forceinline__ void xcd_barrier(const XcdBarrier& b) {
    asm volatile("s_waitcnt vmcnt(0)" ::: "memory");
    __syncthreads();
    if (threadIdx.x == 0) {
        unsigned* bar = b.bar; asm volatile("" : "+s"(bar)); unsigned bx = b.x; asm volatile("" : "+s"(bx));
        __builtin_amdgcn_s_waitcnt(0);
        unsigned nloc = b.st[0], nx = b.st[1];
        if (nloc == 0u) { xcd_barrier_complete(bar, bx, nloc, nx); b.st[0] = nloc; b.st[1] = nx; }
        const unsigned old = xb_add(&bar[XB_XSUB(bx)], 1u);
        const unsigned gen = old / nloc;
        if (old + 1u == (gen + 1u) * nloc) {
            __builtin_amdgcn_fence(__ATOMIC_RELEASE, "agent");
            asm volatile("s_waitcnt vmcnt(0)" ::: "memory");
            const unsigned og = xb_add(&bar[XB_TOP], 1u);
            const unsigned tg = og / nx;
            if (og + 1u == (tg + 1u) * nx) xb_add(&bar[XB_TOPGEN], 1u);
            else XB_SPIN(xb_ld(&bar[XB_TOPGEN]) == tg, bar);
            __builtin_amdgcn_fence(__ATOMIC_ACQUIRE, "agent");
            asm volatile("s_waitcnt vmcnt(0)" ::: "memory");
        } else {
            XB_SPIN(xb_ld(&bar[XB_TOPGEN]) == gen, bar);
            __builtin_amdgcn_fence(__ATOMIC_ACQUIRE, "agent");
            asm volatile("s_waitcnt vmcnt(0)" ::: "memory");
        }
    }
    __syncthreads();
}

namespace cg = cooperative_groups;
__global__ void __launch_bounds__(NTHREADS, 2) mega_fwd(Args a) {
    extern __shared__ __attribute__((aligned(16))) unsigned char lds[];
    cg::grid_group grid = cg::this_grid();
    float* lds_f = (float*)lds;
    unsigned char* ws = a.ws;
    bf16* WinT = (bf16*)(ws + WS_WINT); bf16* WoutT = (bf16*)(ws + WS_WOUTT); bf16* X = (bf16*)(ws + WS_X); bf16* H = (bf16*)(ws + WS_H); bf16* Pb = (bf16*)(ws + WS_P); bf16* Y = (bf16*)(ws + WS_Y);
    RwcBuf RB; RB.CH = ws + WS_RW; RB.ST = ws + WS_RWST; RB.O1 = ws + WS_O1;
    float* kmean = (float*)(ws + WS_KMEAN);
    LruBuf LB; LB.HL = (float*)(ws + WS_LRU); LB.AC = LB.HL + (size_t)MROWS * LRU_W; LB.SH = LB.AC + (size_t)MROWS * LRU_W; LB.SA = LB.SH + NB * NSEG * LRU_W;
    const int G = gridDim.x, bid = blockIdx.x;
    volatile LAS unsigned* MISC = (volatile LAS unsigned*)((LAS unsigned char*)lds + 131072 + 320);
    if (threadIdx.x < 64) MISC[threadIdx.x] = 0u;
    __syncthreads();
    grid.sync();
    XcdBarrier bar = xcd_barrier_post((unsigned*)(ws + WS_CTL) + 4096, MISC + 8);
#define GRID_BAR() xcd_barrier(bar)

    phase_prep_weights(a, lds_f);
    for (int l = 0; l < DEPTH; ++l) {
        const void* xcur = l == 0 ? (const void*)a.in[0] : (const void*)X; const int xf32 = l == 0;
        if (l == 0) { const int i = bid * NTHREADS + tidx(); if (i < NB * NH * NBLK * HD) kmean[i] = 0.f; }
        if (l == 0 || G != 256) { phase_rmsnorm<false>(xcur, xf32, a.in[1] + (size_t)l * DM, H, (float*)(ws + WS_CTL + 512 * 1024));
        GRID_BAR(); }
        for (int rep = 0; rep < (PROBE_PH == 2 ? 2 : 1); ++rep) {
        { pg8::Gemm g{l == 0 ? H : X, WinT + (size_t)l * NINP * DM, MROWS, NINP, DM};   pg8::StaticOrder S; S.init(MROWS, NINP, G, bid);
          EpiP E{Pb, NINP, (const float*)(ws + WS_CTL + 512 * 1024), kmean};
          pg8::gemm_phase<EpiP, pg8::StaticOrder, true, true>((PG8_LAS unsigned char*)lds, g, S, E); }
        GRID_BAR(); }
        { RwkvP P{a.in[11] + (size_t)l * RSTREAM, a.in[12] + (size_t)l * RW, a.in[13] + (size_t)l * 64 * RW, a.in[14] + (size_t)l * RW, a.in[15] + (size_t)l * 64 * RW,
                  a.in[16] + (size_t)l * RW, a.in[17] + (size_t)l * RW, a.in[18] + (size_t)l * RW, a.in[19] + (size_t)l * RW, a.in[20] + (size_t)l * RW,
                  (const bf16*)(ws + WS_LORA) + (size_t)l * NH * 2 * 64 * 64};
          { LruP LP{a.in[4] + (size_t)l * 4 * LRU_W, a.in[5] + (size_t)l * LRU_W, a.in[6] + (size_t)l * 8 * 4096, a.in[7] + (size_t)l * LRU_W, a.in[8] + (size_t)l * 8 * 4096, a.in[9] + (size_t)l * LRU_W, a.in[10] + (size_t)l * LRU_W};
            if (PROBE_PH == 31) { for (int u = bid; u < NB * 8 * NSEG; u += G) lru_local_unit(u, Pb, LP, LB, lds_f); GRID_BAR(); } }
          if (PROBE_PH == 34) { for (int u = bid; u < MROWS / 32; u += G) rwkv_phaseA(u, Pb, P, RB, (unsigned char*)lds); GRID_BAR(); }
          if (PROBE_PH == 35) { for (int u = bid; u < MROWS / 32; u += G) { const int bb_ = (u * 32) >> 12, ck_ = ((u * 32) & (SEQ - 1)) >> 5; const int wv_ = tidx() >> 6;
              for (int k = wv_; k < NH; k += NWAVES) rwkv_stage1((bb_ * NH + k) * NCH + ck_, RB, (unsigned char*)lds + wv_ * 16384); } GRID_BAR(); }
          for (int rep = 0; rep < (PROBE_PH == 32 ? 2 : 1); ++rep) { if (PROBE_PH == 32 && rep == 1) GRID_BAR();
          for (int u = bid; u < MROWS / 32; u += G) {
              rwkv_phaseA(u, Pb, P, RB, (unsigned char*)lds);
              const int bb_ = (u * 32) >> 12, ck_ = ((u * 32) & (SEQ - 1)) >> 5; const int wv_ = tidx() >> 6;
              { const int k = wv_ < 4 ? wv_ : wv_ + 4;
                rwkv_stage1((bb_ * NH + k) * NCH + ck_, RB, (unsigned char*)lds + wv_ * 16384); }
              __syncthreads(); } }
          GRID_BAR();
          if (PROBE_PH == 41) { if (bid < NB * NH) rwkv_stage2(bid, RB, (unsigned char*)lds); GRID_BAR(); }
          if (bid < NB * NH) rwkv_stage2(bid, RB, (unsigned char*)lds);
          else { LruP LP{a.in[4] + (size_t)l * 4 * LRU_W, a.in[5] + (size_t)l * LRU_W, a.in[6] + (size_t)l * 8 * 4096, a.in[7] + (size_t)l * LRU_W, a.in[8] + (size_t)l * 8 * 4096, a.in[9] + (size_t)l * LRU_W, a.in[10] + (size_t)l * LRU_W};
              for (int u = bid - NB * NH; u < NB * 8 * NSEG; u += G - NB * NH) lru_local_unit(u, Pb, LP, LB, lds_f); }
          {
            unsigned* qc = (unsigned*)(ws + WS_CTL) + 8192 + 64 * (2 * l);
            __syncthreads();
            if (threadIdx.x == 0) MISC[16] = __hip_atomic_fetch_add(qc, 1u, __ATOMIC_RELAXED, __HIP_MEMORY_SCOPE_AGENT);
            __syncthreads();
            int idx = (int)MISC[16], slot = 0;
            while (idx < NB * NH * NBLK) {
                const int qb = NBLK - 1 - idx / (NB * NH), bh = idx % (NB * NH);
                attn_body::attn_unit<8>(bh / NH, bh % NH, qb, (const attn_body::bf16*)Pb, kmean + (size_t)bh * NBLK * HD, a.in[21], (attn_body::bf16*)Y, (char*)lds, qc, 17 + slot);
                idx = (int)MISC[17 + slot]; slot ^= 1; }
          }
          GRID_BAR();
          { const int i = bid * NTHREADS + tidx(); if (i < NB * NH * NBLK * HD) kmean[i] = 0.f; }
          for (int rep = 0; rep < (PROBE_PH == 5 ? 2 : 1); ++rep) {
          { const int wv_ = tidx() >> 6; for (int it = bid * NWAVES + wv_; it < NB * NH * NCH; it += G * NWAVES) rwkv_stage3(it, Pb, P, RB, Y, (unsigned char*)lds + wv_ * 16384); }
          for (int u = bid; u < NB * 8 * NSEG; u += G) lru_final_unit(u, Pb, LB, Y, lds_f);
          if (PROBE_PH == 5 && rep == 0) GRID_BAR(); }
        }
        GRID_BAR();
        { pg8::Gemm g{Y, WoutT + (size_t)l * DM * DM, MROWS, DM, DM}; pg8::StaticOrder S; S.init(MROWS, DM, G, bid);
          float* lpart = (float*)((unsigned char*)lds + 132096);
          EpiRes E{xcur, X, DM, xf32, lpart};
          pg8::gemm_phase<EpiRes, pg8::StaticOrder, true, true>((PG8_LAS unsigned char*)lds, g, S, E);
          __syncthreads();
          { pg8::Unit u; const int t_ = tidx(); if (G == 256 && S.next(0, u) && t_ < 256) ((float*)(ws + WS_CTL + 512 * 1024))[(size_t)(u.pm * 256 + t_) * 8 + u.pn] = (lpart[t_] + lpart[256 + t_]) + (lpart[512 + t_] + lpart[768 + t_]); } }
        GRID_BAR();
    }
    phase_rmsnorm<true>(X, 0, a.in[22], nullptr, a.out);
}

extern "C" void kernel_launch(void* const* d_in, const int* in_sizes, int n_in, void* d_out, int out_size, void* d_ws, size_t ws_size, hipStream_t stream) {
    static int grid_blocks = 0;
    if (grid_blocks == 0) {
        if (ws_size < WS_END || n_in != 23) { fprintf(stderr, "kernel_launch: bad workspace/inputs: ws %zu need %zu, n_in %d\n", ws_size, (size_t)WS_END, n_in); grid_blocks = -1; return; }
        int dev = 0, cus = 0, per_cu = 0;
        (void)hipGetDevice(&dev); (void)hipDeviceGetAttribute(&cus, hipDeviceAttributeMultiprocessorCount, dev);
        (void)hipFuncSetAttribute((const void*)mega_fwd, hipFuncAttributeMaxDynamicSharedMemorySize, LDS_BYTES);
        (void)hipOccupancyMaxActiveBlocksPerMultiprocessor(&per_cu, (const void*)mega_fwd, NTHREADS, LDS_BYTES);
        if (per_cu < 1) { fprintf(stderr, "kernel_launch: occupancy query says %d blocks per CU\n", per_cu); per_cu = 1; }
        if (cus != 256) fprintf(stderr, "kernel_launch: this build assumes 256 compute units (one GEMM2 tile per workgroup), found %d\n", cus);
        grid_blocks = cus;
        fprintf(stderr, "kernel_launch: cus %d per_cu %d grid %d\n", cus, per_cu, grid_blocks);
    }
    if (grid_blocks < 0) return;
    Args a; memset(&a, 0, sizeof(a));
    for (int i = 0; i < 23; ++i) a.in[i] = (const float*)d_in[i];
    a.out = (float*)d_out; a.ws = (unsigned char*)d_ws;
    (void)hipMemsetAsync((unsigned char*)d_ws + WS_CTL, 0, 1 * MiB, stream);
    void* args[] = {&a};
    hipError_t e = hipLaunchCooperativeKernel((const void*)mega_fwd, dim3(grid_blocks), dim3(NTHREADS), args, LDS_BYTES, stream);
    if (e != hipSuccess) fprintf(stderr, "cooperative launch failed: %s (grid %d)\n", hipGetErrorString(e), grid_blocks);
}
```

```cpp
#include <hip/hip_runtime.h>
#include <hip/hip_cooperative_groups.h>
#include <hip/hip_bf16.h>
#include <cstdio>
#include <cstdint>
#include <cstring>
#include <cmath>
namespace pg8 {
#define PG8_LAS __attribute__((address_space(3)))
typedef unsigned short bf16_t;
typedef short bf16x8 __attribute__((ext_vector_type(8)));
typedef float f32x4 __attribute__((ext_vector_type(4)));
typedef unsigned u32x4 __attribute__((ext_vector_type(4)));
constexpr int BM = 256, BK = 64, HALF = 128, HTB = HALF * BK * 2  , STAGE_BYTES = 8 * HTB, NXCD = 8, WGM = 8;

__host__ __device__ __forceinline__ int lds_byte(int r, int c) { const int st = (r >> 4) * 2 + (c >> 5), rr = r & 15, cc = c & 31, ob = rr * 64 + cc * 2; return st * 1024 + (ob ^ (((ob >> 9) & 1) << 5)); }
__host__ __device__ __forceinline__ void stage_rc(int b, int& R, int& C) { const int st = b / 1024, sb = b % 1024, swz = sb ^ (((sb >> 9) & 1) << 5); R = (st >> 1) * 16 + swz / 64; C = (st & 1) * 32 + (swz % 64) / 2; }
__host__ __device__ __forceinline__ int perm32(int rho) { const int n = rho >> 4, i = rho & 15; return 8 * (i >> 2) + 4 * n + (i & 3); }

struct Unit { int pm, pn; };
struct Gemm { const bf16_t* A; const bf16_t* Bt; int M, N, K; };

struct StaticOrder {
    int nM, nN, nwg, G, c;
    __host__ __device__ void init(int M, int N, int G_, int c_) { nM = M / BM; nN = N / BM; nwg = nM * nN; G = G_; c = c_; }
    __host__ __device__ bool next(int i, Unit& u) const {
        const long L = (long)i * G + c; if (L >= nwg) return false;
        int wgid = (int)L; { const int q = nwg / NXCD, r = nwg % NXCD, xcd = wgid % NXCD, off = wgid / NXCD; wgid = (xcd < r ? xcd * (q + 1) : r * (q + 1) + (xcd - r) * q) + off; }
        const int nig = WGM * nN, gid = wgid / nig, fm = gid * WGM, gsz = (nM - fm) < WGM ? (nM - fm) : WGM;
        u.pm = fm + ((wgid % nig) % gsz); u.pn = (wgid % nig) / gsz; return true;
    }
    __device__ __forceinline__ void a_ready(const Unit&) const {}
    __device__ __forceinline__ void done(const Unit&) const {}
};

__device__ __forceinline__ unsigned cvt_pk_bf16(float lo, float hi) { unsigned r; asm volatile("v_cvt_pk_bf16_f32 %0, %1, %2" : "=v"(r) : "v"(lo), "v"(hi)); return r; }
typedef float f32x2 __attribute__((ext_vector_type(2)));
__device__ __forceinline__ f32x2 gelu_pk(f32x2 v) {
    const f32x2 av = __builtin_elementwise_abs(v), d = av * 0.2316418882f + 1.0f;
    f32x2 t; t.x = __builtin_amdgcn_rcpf(d.x); t.y = __builtin_amdgcn_rcpf(d.y);
    f32x2 q = t * 0.5307027145f + (-0.7265760135f); q = q * t + 0.7107068705f; q = q * t + (-0.142248368f); q = q * t + 0.127414796f; q = q * t;
    const f32x2 s = (v * v) * (-0.72134752044f);
    f32x2 e; e.x = __builtin_amdgcn_exp2f(s.x); e.y = __builtin_amdgcn_exp2f(s.y);
    const f32x2 m = v * (q * e), r = v - m;
    f32x2 o; o.x = v.x < 0.f ? m.x : r.x; o.y = v.y < 0.f ? m.y : r.y; return o;
}

template <int ACT  > struct EpiBf16 {
    static constexpr bool PERM = true, AFTER_DRAIN = false; static_assert(ACT == 0 || ACT == 1, "EpiBf16: ACT is 0 (none) or 1 (gelu_pk)");
    bf16_t* O; int ldc; const float* bias; int split_cols; size_t split_stride; float scale0;
    __device__ __forceinline__ void operator()(const f32x4 (&acc)[2][2][4][2], const Unit& u, int wr, int wc, int fr, int fq) const {
        const int row0 = u.pm * BM + wr * 64 + fr; int colt = u.pn * BM; bf16_t* base = O;
        float sc = 1.f; if (split_cols) { const int t = colt / split_cols; base += (size_t)t * split_stride; colt -= t * split_cols; if (t == 0) sc = scale0; }
        const int col0 = colt + wc * 32 + 8 * fq, bcol0 = u.pn * BM + wc * 32 + 8 * fq;
        f32x4 bv[2][2];
#pragma unroll
        for (int bj = 0; bj < 2; ++bj)
#pragma unroll
            for (int n = 0; n < 2; ++n) bv[bj][n] = bias ? *(const f32x4*)(bias + bcol0 + bj * HALF + 4 * n) : (f32x4){0.f, 0.f, 0.f, 0.f};
#pragma unroll
        for (int ai = 0; ai < 2; ++ai)
#pragma unroll
            for (int m = 0; m < 4; ++m) { bf16_t* rowp = base + (size_t)(row0 + ai * HALF + m * 16) * ldc + col0;
#pragma unroll
                for (int bj = 0; bj < 2; ++bj) { f32x4 v0 = acc[ai][bj][m][0] + bv[bj][0], v1 = acc[ai][bj][m][1] + bv[bj][1];
                    if (ACT == 1) { f32x2 a = gelu_pk((f32x2){v0[0], v0[1]}), b = gelu_pk((f32x2){v0[2], v0[3]}), c = gelu_pk((f32x2){v1[0], v1[1]}), d = gelu_pk((f32x2){v1[2], v1[3]});
                        v0 = (f32x4){a.x, a.y, b.x, b.y}; v1 = (f32x4){c.x, c.y, d.x, d.y}; }
                    v0 = v0 * sc; v1 = v1 * sc; u32x4 w; w.x = cvt_pk_bf16(v0[0], v0[1]); w.y = cvt_pk_bf16(v0[2], v0[3]); w.z = cvt_pk_bf16(v1[0], v1[1]); w.w = cvt_pk_bf16(v1[2], v1[3]);
                    *(u32x4*)(rowp + bj * HALF) = w; } }
    }
};
template <class Epi, class Sched, bool ALIGN_EPI = false, bool SP2 = false>
__device__ __forceinline__ void gemm_phase(PG8_LAS unsigned char* lds, const Gemm g, const Sched& S, const Epi& E) {
    int tid_ = threadIdx.x; asm volatile("" : "+v"(tid_)); const int tid = tid_, wid = __builtin_amdgcn_readfirstlane(tid >> 6), lane = tid & 63, wr = wid >> 2, wc = wid & 3, fr = lane & 15, fq = lane >> 4;
    const int K = g.K, nt = K / BK;
    unsigned voffA[2], voffB[2];
#pragma unroll
    for (int i = 0; i < 2; ++i) { int R, C; stage_rc(tid * 16 + i * 8192, R, C); const int Rb = Epi::PERM ? ((R & ~31) + perm32(R & 31)) : R;
        voffA[i] = (unsigned)(R * K + C) * 2u; voffB[i] = (unsigned)(Rb * K + C) * 2u; }
    const size_t kstep = (size_t)(BK * 2);
    const size_t hstep = (size_t)HALF * K * 2;
    const size_t tstep = 2 * hstep;
    const unsigned ldsw = (unsigned)wid * 1024u;
    const int aoff = lds_byte(wr * 64 + fr, fq * 8), boff = lds_byte(wc * 32 + fr, fq * 8);
#define PG8_SA(b, h) (((b) * 2 + (h)) * HTB)
#define PG8_SB(b, h) ((4 + (b) * 2 + (h)) * HTB)
#define PG8_STAGE(bufoff, gbase, voff) do { _Pragma("unroll") for (int _i = 0; _i < 2; ++_i) \
        __builtin_amdgcn_global_load_lds((const unsigned*)((const char*)(gbase) + (voff)[_i]), (PG8_LAS unsigned*)(lds + (bufoff) + ldsw + _i * 8192), 16, 0, 0); } while (0)
#define PG8_LDA(dst, b, h) do { _Pragma("unroll") for (int m = 0; m < 4; ++m) _Pragma("unroll") for (int k = 0; k < 2; ++k) dst[m][k] = *(const PG8_LAS bf16x8*)(lds + PG8_SA(b, h) + aoff + m * 2048 + k * 1024); } while (0)
#define PG8_LDB(dst, b, h) do { _Pragma("unroll") for (int n = 0; n < 2; ++n) _Pragma("unroll") for (int k = 0; k < 2; ++k) dst[n][k] = *(const PG8_LAS bf16x8*)(lds + PG8_SB(b, h) + boff + n * 2048 + k * 1024); } while (0)
#define PG8_MMA(ai, bj, At, Bt) do { __builtin_amdgcn_s_setprio(1); _Pragma("unroll") for (int m = 0; m < 4; ++m) _Pragma("unroll") for (int n = 0; n < 2; ++n) _Pragma("unroll") for (int k = 0; k < 2; ++k) \
        acc[ai][bj][m][n] = __builtin_amdgcn_mfma_f32_16x16x32_bf16(Bt[n][k], At[m][k], acc[ai][bj][m][n], 0, 0, 0); __builtin_amdgcn_s_setprio(0); } while (0)
#define PG8_WAIT_V(n) asm volatile("s_waitcnt vmcnt(" #n ")" ::: "memory")
#define PG8_WAIT_L(n) asm volatile("s_waitcnt lgkmcnt(" #n ")" ::: "memory")
#define PG8_BAR __builtin_amdgcn_s_barrier()
#define PG8_SCHED __builtin_amdgcn_sched_barrier(0)
    Unit cur, nxt; int ui = 0;
    if (!S.next(0, cur)) return;
    f32x4 acc[2][2][4][2];
#pragma unroll
    for (int a = 0; a < 2; ++a)
#pragma unroll
        for (int b = 0; b < 2; ++b)
#pragma unroll
            for (int m = 0; m < 4; ++m)
#pragma unroll
                for (int n = 0; n < 2; ++n) acc[a][b][m][n] = (f32x4){0.f, 0.f, 0.f, 0.f};
    bf16x8 At[4][2], B0[2][2], B1[2][2];
    const char* cA = (const char*)g.A + (size_t)cur.pm * tstep; const char* cB = (const char*)g.Bt + (size_t)cur.pn * tstep;
    S.a_ready(cur);
    if constexpr (SP2) {
        PG8_STAGE(PG8_SB(0, 0), cB, voffB); PG8_STAGE(PG8_SB(0, 1), cB + hstep, voffB); PG8_STAGE(PG8_SA(0, 0), cA, voffA); PG8_STAGE(PG8_SA(0, 1), cA + hstep, voffA);
        if (wr == 1) PG8_BAR;
        PG8_WAIT_V(2); PG8_BAR;
        PG8_STAGE(PG8_SB(1, 0), cB + kstep, voffB); PG8_STAGE(PG8_SA(1, 0), cA + kstep, voffA); PG8_STAGE(PG8_SB(1, 1), cB + hstep + kstep, voffB);
        PG8_WAIT_V(6); PG8_BAR;
    } else {
        PG8_STAGE(PG8_SB(0, 0), cB, voffB); PG8_STAGE(PG8_SA(0, 0), cA, voffA); PG8_STAGE(PG8_SB(0, 1), cB + hstep, voffB); PG8_STAGE(PG8_SA(0, 1), cA + hstep, voffA);
        if (wr == 1) PG8_BAR;
        PG8_WAIT_V(4); PG8_BAR;
        PG8_STAGE(PG8_SB(1, 0), cB + kstep, voffB); PG8_STAGE(PG8_SA(1, 0), cA + kstep, voffA); PG8_STAGE(PG8_SB(1, 1), cB + hstep + kstep, voffB);
        PG8_WAIT_V(6); PG8_BAR;
    }
    for (;;) {
        const bool has_next = S.next(ui + 1, nxt);
        const char* nA = has_next ? (const char*)g.A + (size_t)nxt.pm * tstep : cA; const char* nB = has_next ? (const char*)g.Bt + (size_t)nxt.pn * tstep : cB;
        for (int t = 0; t < nt; t += 2) {
            const bool last = (t == nt - 2);
            const char* a1 = cA + (size_t)(t + 1) * kstep;
            const char* a2 = last ? nA : cA + (size_t)(t + 2) * kstep; const char* b2 = last ? nB : cB + (size_t)(t + 2) * kstep;
            const char* a3 = a2 + kstep; const char* b3 = b2 + kstep;
            if (last && has_next) S.a_ready(nxt);
            if constexpr (SP2) {
            PG8_LDB(B0, 0, 0); PG8_LDB(B1, 0, 1); PG8_SCHED; PG8_LDA(At, 0, 0); PG8_STAGE(PG8_SA(1, 1), a1 + hstep, voffA);
            PG8_WAIT_V(8); PG8_WAIT_L(0); PG8_BAR; PG8_MMA(0, 0, At, B0); PG8_MMA(0, 1, At, B1); PG8_BAR; PG8_SCHED;
            PG8_LDA(At, 0, 1); PG8_STAGE(PG8_SB(0, 0), b2, voffB); PG8_STAGE(PG8_SB(0, 1), b2 + hstep, voffB); PG8_STAGE(PG8_SA(0, 0), a2, voffA);
            PG8_WAIT_V(8); PG8_WAIT_L(0); PG8_BAR; PG8_MMA(1, 0, At, B0); PG8_MMA(1, 1, At, B1); PG8_BAR; PG8_SCHED;
            PG8_LDB(B0, 1, 0); PG8_LDB(B1, 1, 1); PG8_SCHED; PG8_LDA(At, 1, 0); PG8_STAGE(PG8_SA(0, 1), a2 + hstep, voffA);
            PG8_WAIT_V(8); PG8_WAIT_L(0); PG8_BAR; PG8_MMA(0, 0, At, B0); PG8_MMA(0, 1, At, B1); PG8_BAR; PG8_SCHED;
            PG8_LDA(At, 1, 1); PG8_STAGE(PG8_SB(1, 0), b3, voffB); PG8_STAGE(PG8_SB(1, 1), b3 + hstep, voffB); PG8_STAGE(PG8_SA(1, 0), a3, voffA);
            PG8_WAIT_V(8); PG8_WAIT_L(0); PG8_BAR; PG8_MMA(1, 0, At, B0); PG8_MMA(1, 1, At, B1); PG8_BAR; PG8_SCHED;
            } else {
            PG8_LDB(B0, 0, 0); PG8_SCHED; PG8_LDA(At, 0, 0); PG8_STAGE(PG8_SA(1, 1), a1 + hstep, voffA);
            PG8_WAIT_L(8); PG8_BAR; PG8_WAIT_L(0); PG8_MMA(0, 0, At, B0); PG8_BAR; PG8_SCHED;
            PG8_LDB(B1, 0, 1); PG8_STAGE(PG8_SB(0, 0), b2, voffB);
            PG8_BAR; PG8_WAIT_L(0); PG8_MMA(0, 1, At, B1); PG8_BAR;
            PG8_LDA(At, 0, 1); PG8_STAGE(PG8_SA(0, 0), a2, voffA);
            PG8_BAR; PG8_WAIT_L(0); PG8_MMA(1, 0, At, B0); PG8_BAR; PG8_SCHED;
            PG8_STAGE(PG8_SB(0, 1), b2 + hstep, voffB);
            PG8_WAIT_V(6); PG8_BAR; PG8_MMA(1, 1, At, B1); PG8_BAR;
            PG8_LDB(B0, 1, 0); PG8_SCHED; PG8_LDA(At, 1, 0); PG8_STAGE(PG8_SA(0, 1), a2 + hstep, voffA);
            PG8_WAIT_L(8); PG8_BAR; PG8_WAIT_L(0); PG8_MMA(0, 0, At, B0); PG8_BAR; PG8_SCHED;
            PG8_LDB(B1, 1, 1); PG8_STAGE(PG8_SB(1, 0), b3, voffB);
            PG8_BAR; PG8_WAIT_L(0); PG8_MMA(0, 1, At, B1); PG8_BAR;
            PG8_LDA(At, 1, 1); PG8_STAGE(PG8_SA(1, 0), a3, voffA);
            PG8_BAR; PG8_WAIT_L(0); PG8_MMA(1, 0, At, B0); PG8_BAR; PG8_SCHED;
            PG8_STAGE(PG8_SB(1, 1), b3 + hstep, voffB);
            PG8_WAIT_V(6); PG8_BAR; PG8_MMA(1, 1, At, B1); PG8_BAR;
            }
        }
        if constexpr (ALIGN_EPI) { if (wr == 0) PG8_BAR; }
        if constexpr (!Epi::AFTER_DRAIN) { E(acc, cur, wr, wc, fr, fq); S.done(cur); }
        if (!has_next) break;
#pragma unroll
        for (int a = 0; a < 2; ++a)
#pragma unroll
            for (int b = 0; b < 2; ++b)
#pragma unroll
                for (int m = 0; m < 4; ++m)
#pragma unroll
                    for (int n = 0; n < 2; ++n) acc[a][b][m][n] = (f32x4){0.f, 0.f, 0.f, 0.f};
        cur = nxt; cA = nA; cB = nB; ++ui;
        if constexpr (ALIGN_EPI) { if (wr == 1) PG8_BAR; }
    }
    PG8_WAIT_V(0);
    if constexpr (!ALIGN_EPI) { if (wr == 0) PG8_BAR; }
    PG8_BAR;
    if constexpr (Epi::AFTER_DRAIN) { E.fused(acc, cur, wr, wc, fr, fq, lds, wid, lane); S.done(cur); }
#undef PG8_SA
#undef PG8_SB
#undef PG8_STAGE
#undef PG8_LDA
#undef PG8_LDB
#undef PG8_MMA
#undef PG8_WAIT_V
#undef PG8_WAIT_L
#undef PG8_BAR
#undef PG8_SCHED
}
}

constexpr int DM = 2048, NB = 2, SEQ = 4096, MROWS = NB * SEQ, DEPTH = 4;
constexpr int LRU_W = 512, RW = 768, MOW = 768, NIN = 7296, NINP = 7424;
constexpr int OFF_XA = 0, OFF_GA = 512, OFF_SB = 1024, OFF_GB = 3456, OFF_QKV = 4224, OFF_GC = 6528;
constexpr int RSTREAM = 2432;
constexpr int NH = 12, HD = 64, NBLK = 16, BLK = 256;

typedef unsigned short bf16;
typedef float f32x4 __attribute__((ext_vector_type(4)));
typedef unsigned u32x4 __attribute__((ext_vector_type(4)));
typedef unsigned u32x2 __attribute__((ext_vector_type(2)));

__device__ __forceinline__ unsigned f2bf(float f) { unsigned u = __builtin_bit_cast(unsigned, f); return (u + 0x7fffu + ((u >> 16) & 1u)) >> 16; }
__device__ __forceinline__ unsigned pk2(float lo, float hi) { return f2bf(lo) | (f2bf(hi) << 16); }
__device__ __forceinline__ float bf2f(unsigned short b) { return __builtin_bit_cast(float, (unsigned)b << 16); }
__device__ __forceinline__ float bflo(unsigned w) { return __builtin_bit_cast(float, w << 16); }
__device__ __forceinline__ float bfhi(unsigned w) { return __builtin_bit_cast(float, w & 0xffff0000u); }
__device__ __forceinline__ float sigmoidf_(float x) { return __builtin_amdgcn_rcpf(1.f + __expf(-x)); }
__device__ __forceinline__ float siluf_(float x) { return x * __builtin_amdgcn_rcpf(1.f + __expf(-x)); }
template <int CTRL, int RMASK> __device__ __forceinline__ float dpp0(float v) { return __builtin_bit_cast(float, __builtin_amdgcn_update_dpp(0, __builtin_bit_cast(int, v), CTRL, RMASK, 0xf, false)); }
__device__ __forceinline__ float wave_sum(float v) {
    v += dpp0<0xB1, 0xf>(v); v += dpp0<0x4E, 0xf>(v); v += dpp0<0x141, 0xf>(v); v += dpp0<0x140, 0xf>(v);
    v += dpp0<0x142, 0xa>(v);
    v += dpp0<0x143, 0xc>(v);
    return __builtin_bit_cast(float, __builtin_amdgcn_readlane(__builtin_bit_cast(int, v), 63));
}

__device__ __forceinline__ void transpose_item(const float* W, int K, int N, bf16* WT, float* scr, int item, int lane, const float* kscale = nullptr) {
    const int nblk = N / 32, kb = item / nblk, nb = item % nblk, k0 = 64 * kb, n0 = 32 * nb;
#pragma unroll 8
    for (int i = 0; i < 32; ++i) { const int kk = 2 * i + (lane >> 5); scr[kk * 33 + (lane & 31)] = W[(size_t)(k0 + kk) * N + n0 + (lane & 31)]; }
    __builtin_amdgcn_s_waitcnt(0xc07f); __builtin_amdgcn_wave_barrier();
    const int c = lane & 7;
    float ks8[8];
#pragma unroll
    for (int e = 0; e < 8; ++e) ks8[e] = kscale ? kscale[k0 + 8 * c + e] : 1.f;
#pragma unroll
    for (int j = 0; j < 4; ++j) { const int n = (lane >> 3) + 8 * j; const float* s = scr + (8 * c) * 33 + n;
        u32x4 o; o.x = pk2(s[0 * 33] * ks8[0], s[1 * 33] * ks8[1]); o.y = pk2(s[2 * 33] * ks8[2], s[3 * 33] * ks8[3]); o.z = pk2(s[4 * 33] * ks8[4], s[5 * 33] * ks8[5]); o.w = pk2(s[6 * 33] * ks8[6], s[7 * 33] * ks8[7]);
        *(u32x4*)(WT + (size_t)(n0 + n) * K + k0 + 8 * c) = o; }
    __builtin_amdgcn_s_waitcnt(0xc07f); __builtin_amdgcn_wave_barrier();
}

constexpr size_t MiB = 1u << 20;
constexpr size_t WS_CTL = 0;
constexpr size_t WS_WINT = 1 * MiB;
constexpr size_t WS_WOUTT = WS_WINT + (size_t)DEPTH * NINP * DM * 2;
constexpr size_t WS_X = WS_WOUTT + (size_t)DEPTH * DM * DM * 2;
constexpr size_t WS_H = WS_X + (size_t)MROWS * DM * 4;
constexpr size_t WS_P = WS_H + (size_t)MROWS * DM * 2;
constexpr size_t WS_Y = WS_P + (size_t)MROWS * NINP * 2;
constexpr size_t WS_RW = WS_Y + (size_t)MROWS * DM * 2;
constexpr size_t RW_ARR = (size_t)MROWS * RW * 4;
constexpr size_t WS_RWST = WS_RW + 104 * MiB;
constexpr size_t WS_KMEAN = WS_RW + 8 * RW_ARR;
constexpr size_t WS_LRU = WS_KMEAN + 1 * MiB;
constexpr size_t WS_O1 = WS_LRU + 2 * (size_t)MROWS * LRU_W * 4 + 1 * MiB;
constexpr size_t WS_LORA = WS_O1 + (size_t)NB * NH * (SEQ / 32) * 12288;
constexpr size_t WS_END = WS_LORA + (size_t)DEPTH * NH * 2 * 64 * 64 * 2;
constexpr int LDS_BYTES = 147456;
constexpr int NTHREADS = 512, NWAVES = 8;

typedef float f32x2e_t __attribute__((ext_vector_type(2))); typedef __bf16 bf16x2e_t __attribute__((ext_vector_type(2)));
__device__ __forceinline__ unsigned cvtpk_e(float lo, float hi) { const f32x2e_t v = {lo, hi}; const bf16x2e_t b = __builtin_convertvector(v, bf16x2e_t); return __builtin_bit_cast(unsigned, b); }
struct EpiRes {
    static constexpr bool PERM = false, AFTER_DRAIN = false;
    const void* base; bf16* out; int ldc; int base_f32; float* lpart;
    __device__ __forceinline__ void operator()(const pg8::f32x4 (&acc)[2][2][4][2], const pg8::Unit& u, int wr, int wc, int fr, int fq) const {
        const int row0 = u.pm * 256 + wr * 64 + fr, col0 = u.pn * 256 + wc * 32 + 4 * fq;
        float ss[2][4];
#pragma unroll
        for (int ai = 0; ai < 2; ++ai)
#pragma unroll
            for (int m = 0; m < 4; ++m) ss[ai][m] = 0.f;
#pragma unroll
        for (int ai = 0; ai < 2; ++ai)
#pragma unroll
            for (int mp = 0; mp < 2; ++mp) { pg8::f32x4 bs[2][2][2];
                if (base_f32) {
#pragma unroll
                    for (int mm = 0; mm < 2; ++mm) { const size_t off = (size_t)(row0 + ai * 128 + (2 * mp + mm) * 16) * ldc + col0;
#pragma unroll
                        for (int bj = 0; bj < 2; ++bj)
#pragma unroll
                            for (int n = 0; n < 2; ++n) bs[mm][bj][n] = *(const pg8::f32x4*)((const float*)base + off + bj * 128 + n * 16); }
                    asm volatile("" : "+v"(bs[0][0][0]), "+v"(bs[0][0][1]), "+v"(bs[0][1][0]), "+v"(bs[0][1][1]), "+v"(bs[1][0][0]), "+v"(bs[1][0][1]), "+v"(bs[1][1][0]), "+v"(bs[1][1][1]));
                } else { u32x2 bw[2][2][2];
#pragma unroll
                    for (int mm = 0; mm < 2; ++mm) { const size_t off = (size_t)(row0 + ai * 128 + (2 * mp + mm) * 16) * ldc + col0;
#pragma unroll
                        for (int bj = 0; bj < 2; ++bj)
#pragma unroll
                            for (int n = 0; n < 2; ++n) bw[mm][bj][n] = *(const u32x2*)((const bf16*)base + off + bj * 128 + n * 16); }
                    asm volatile("" : "+v"(bw[0][0][0]), "+v"(bw[0][0][1]), "+v"(bw[0][1][0]), "+v"(bw[0][1][1]), "+v"(bw[1][0][0]), "+v"(bw[1][0][1]), "+v"(bw[1][1][0]), "+v"(bw[1][1][1]));
#pragma unroll
                    for (int mm = 0; mm < 2; ++mm)
#pragma unroll
                        for (int bj = 0; bj < 2; ++bj)
#pragma unroll
                            for (int n = 0; n < 2; ++n) { const u32x2 w = bw[mm][bj][n]; bs[mm][bj][n] = (pg8::f32x4){__builtin_bit_cast(float, w.x << 16), __builtin_bit_cast(float, w.x & 0xffff0000u), __builtin_bit_cast(float, w.y << 16), __builtin_bit_cast(float, w.y & 0xffff0000u)}; } }
#pragma unroll
                for (int mm = 0; mm < 2; ++mm) { const size_t off = (size_t)(row0 + ai * 128 + (2 * mp + mm) * 16) * ldc + col0;
#pragma unroll
                    for (int bj = 0; bj < 2; ++bj)
#pragma unroll
                        for (int n = 0; n < 2; ++n) { const pg8::f32x4 o = bs[mm][bj][n] + acc[ai][bj][2 * mp + mm][n]; *(u32x2*)(out + off + bj * 128 + n * 16) = (u32x2){cvtpk_e(o.x, o.y), cvtpk_e(o.z, o.w)};
                            ss[ai][2 * mp + mm] += (o.x * o.x + o.y * o.y) + (o.z * o.z + o.w * o.w); } } }
#pragma unroll
        for (int ai = 0; ai < 2; ++ai)
#pragma unroll
            for (int m = 0; m < 4; ++m) { float v = ss[ai][m];
                v += __builtin_bit_cast(float, __builtin_amdgcn_ds_swizzle(__builtin_bit_cast(int, v), 0x401F));
                { float t = v; asm volatile("s_nop 1\n\tv_permlane32_swap_b32 %0, %1" : "+v"(v), "+v"(t)); v = v + t; }
                if (fq == 0) lpart[wc * 256 + wr * 64 + fr + ai * 128 + m * 16] = v; }
    }
};


struct EpiP {
    static constexpr bool PERM = true, AFTER_DRAIN = false;
    bf16* O; int ldc; const float* rstd; float* kmean;
    __device__ __forceinline__ void operator()(const pg8::f32x4 (&acc)[2][2][4][2], const pg8::Unit& u, int wr, int wc, int fr, int fq) const {
        const int row0 = u.pm * 256 + wr * 64 + fr, col0 = u.pn * 256 + wc * 32 + 8 * fq;
        float rs[2][4];
        { pg8::f32x4 pa[2][4], pb[2][4];
#pragma unroll
          for (int ai = 0; ai < 2; ++ai)
#pragma unroll
              for (int m = 0; m < 4; ++m) { const pg8::f32x4* rp = (const pg8::f32x4*)(rstd + (size_t)(row0 + ai * 128 + m * 16) * 8); pa[ai][m] = rp[0]; pb[ai][m] = rp[1]; }
          asm volatile("" : "+v"(pa[0][0]), "+v"(pa[0][1]), "+v"(pa[0][2]), "+v"(pa[0][3]), "+v"(pa[1][0]), "+v"(pa[1][1]), "+v"(pa[1][2]), "+v"(pa[1][3]));
          asm volatile("" : "+v"(pb[0][0]), "+v"(pb[0][1]), "+v"(pb[0][2]), "+v"(pb[0][3]), "+v"(pb[1][0]), "+v"(pb[1][1]), "+v"(pb[1][2]), "+v"(pb[1][3]));
#pragma unroll
          for (int ai = 0; ai < 2; ++ai)
#pragma unroll
              for (int m = 0; m < 4; ++m) { const float t = ((pa[ai][m].x + pa[ai][m].y) + (pa[ai][m].z + pa[ai][m].w)) + ((pb[ai][m].x + pb[ai][m].y) + (pb[ai][m].z + pb[ai][m].w));
                  rs[ai][m] = __builtin_amdgcn_rsqf(t * (1.f / DM) + 1e-6f); } }
        constexpr int KC0 = OFF_QKV + MOW;
        bool kr[2]; float cs[2][8];
#pragma unroll
        for (int bj = 0; bj < 2; ++bj) { const int cb_ = u.pn * 256 + bj * 128; kr[bj] = cb_ >= KC0 && cb_ < KC0 + MOW;
#pragma unroll
            for (int e = 0; e < 8; ++e) cs[bj][e] = 0.f; }
#pragma unroll
        for (int ai = 0; ai < 2; ++ai)
#pragma unroll
            for (int m = 0; m < 4; ++m) { bf16* rowp = O + (size_t)(row0 + ai * 128 + m * 16) * ldc + col0;
#pragma unroll
                for (int bj = 0; bj < 2; ++bj) { const int c = col0 + bj * 128; const float sc = ((c >= OFF_QKV && c < OFF_QKV + MOW) ? 0.125f * 1.4426950408889634f : 1.f) * rs[ai][m];
                    const pg8::f32x4 v0 = acc[ai][bj][m][0] * sc, v1 = acc[ai][bj][m][1] * sc;
                    if (kr[bj]) {
#pragma unroll
                        for (int e = 0; e < 4; ++e) { cs[bj][e] += v0[e]; cs[bj][4 + e] += v1[e]; } }
                    pg8::u32x4 w; w.x = pg8::cvt_pk_bf16(v0[0], v0[1]); w.y = pg8::cvt_pk_bf16(v0[2], v0[3]); w.z = pg8::cvt_pk_bf16(v1[0], v1[1]); w.w = pg8::cvt_pk_bf16(v1[2], v1[3]);
                    *(pg8::u32x4*)(rowp + bj * 128) = w; } }
#pragma unroll
        for (int bj = 0; bj < 2; ++bj) if (kr[bj]) { const int c0 = u.pn * 256 + bj * 128 + wc * 32 + 8 * fq - KC0;
            float* dst = kmean + ((size_t)((u.pm >> 4) * NH + (c0 >> 6)) * NBLK + (u.pm & 15)) * HD + (c0 & 63);
#pragma unroll
            for (int e = 0; e < 8; ++e) { float v = cs[bj][e];
                v += dpp0<0xB1, 0xf>(v); v += dpp0<0x4E, 0xf>(v); v += dpp0<0x141, 0xf>(v); v += dpp0<0x140, 0xf>(v);
                if (fr == 0) unsafeAtomicAdd(dst + e, v * (1.f / BLK)); } }
    }
};
__device__ __forceinline__ int tidx() { int t = threadIdx.x; asm volatile("" : "+v"(t)); return t; }
#ifndef PROBE_PH
#define PROBE_PH 0
#endif
struct Args { const float* in[23]; float* out; unsigned char* ws; };

__device__ __forceinline__ void phase_prep_weights(const Args& a, float* lds_f) {
    const int TID = tidx();
    const int lane = TID & 63, wave = TID >> 6;
    float* scr = lds_f + wave * 64 * 33;
    bf16* WinT = (bf16*)(a.ws + WS_WINT); bf16* WoutT = (bf16*)(a.ws + WS_WOUTT);
    const float* w_in = a.in[2]; const float* w_out = a.in[3];
    const int gw = blockIdx.x * NWAVES + wave, NGW = gridDim.x * NWAVES;
    constexpr int I_IN = (DM / 64) * (NIN / 32), I_OUT = (DM / 64) * (DM / 32);
    constexpr int NITEMS = DEPTH * (I_IN + I_OUT);
    for (int it = gw; it < NITEMS; it += NGW) {
        if (it < DEPTH * I_IN) { const int l = it / I_IN, r = it % I_IN; transpose_item(w_in + (size_t)l * DM * NIN, DM, NIN, WinT + (size_t)l * NINP * DM, scr, r, lane, a.in[1] + (size_t)l * DM); }
        else { const int r0 = it - DEPTH * I_IN, l = r0 / I_OUT, r = r0 % I_OUT; transpose_item(w_out + (size_t)l * DM * DM, DM, DM, WoutT + (size_t)l * DM * DM, scr, r, lane); }
    }
    const int gt = blockIdx.x * NTHREADS + TID, NGT = gridDim.x * NTHREADS;
    { bf16* LO = (bf16*)(a.ws + WS_LORA); const float* wu = a.in[13]; const float* au = a.in[15];
      for (int i = blockIdx.x * NTHREADS + TID; i < DEPTH * NH * 2 * 64 * 8; i += gridDim.x * NTHREADS) { const int c = i & 63, kg = (i >> 6) & 7, m = (i >> 9) & 1, lh = i >> 10, hh_ = lh % NH, l = lh / NH;
          const float* src = (m ? au : wu) + (size_t)l * 64 * RW + (size_t)(8 * kg) * RW + hh_ * 64 + c; float v[8];
#pragma unroll
          for (int e = 0; e < 8; ++e) v[e] = src[(size_t)e * RW];
          *(u32x4*)(LO + ((size_t)(lh * 2 + m) * 64 + c) * 64 + 8 * kg) = (u32x4){pk2(v[0], v[1]), pk2(v[2], v[3]), pk2(v[4], v[5]), pk2(v[6], v[7])}; } }
    constexpr int PADV = (NINP - NIN) * DM / 8;
    for (int i = gt; i < DEPTH * PADV; i += NGT) { const int l = i / PADV, r = i % PADV; *(u32x4*)(WinT + (size_t)l * NINP * DM + (size_t)NIN * DM + (size_t)r * 8) = (u32x4){0u, 0u, 0u, 0u}; }
}
template <bool FINAL> __device__ __forceinline__ void phase_rmsnorm(const void* x, int x_f32, const float* w, bf16* hb, float* outf) {
    const int TID = tidx();
    const int lane = TID & 63, wave = TID >> 6;
    for (int row = blockIdx.x * NWAVES + wave; row < MROWS; row += gridDim.x * NWAVES) {
        f32x4 v[8]; float s = 0.f;
        if (x_f32) { const f32x4* xr = (const f32x4*)((const float*)x + (size_t)row * DM) + lane;
#pragma unroll
            for (int j = 0; j < 8; ++j) v[j] = xr[64 * j]; }
        else { const u32x2* xr = (const u32x2*)((const bf16*)x + (size_t)row * DM) + lane;
#pragma unroll
            for (int j = 0; j < 8; ++j) { const u32x2 w2 = xr[64 * j]; v[j] = (f32x4){__builtin_bit_cast(float, w2.x << 16), __builtin_bit_cast(float, w2.x & 0xffff0000u), __builtin_bit_cast(float, w2.y << 16), __builtin_bit_cast(float, w2.y & 0xffff0000u)}; } }
#pragma unroll
        for (int j = 0; j < 8; ++j) s += (v[j].x * v[j].x + v[j].y * v[j].y) + (v[j].z * v[j].z + v[j].w * v[j].w);
        const float ssum = wave_sum(s); const float rstd = rsqrtf(ssum * (1.f / DM) + 1e-6f);
        if (!FINAL) {
            if (lane < 8) outf[(size_t)row * 8 + lane] = lane == 0 ? ssum : 0.f;
            if (x_f32) {
#pragma unroll
                for (int j = 0; j < 8; ++j) { u32x2 pk; pk.x = pk2(v[j].x, v[j].y); pk.y = pk2(v[j].z, v[j].w); ((u32x2*)(hb + (size_t)row * DM) + lane)[64 * j] = pk; } }
            continue; }
        const f32x4* wr = (const f32x4*)w + lane;
        f32x4 wv[8];
#pragma unroll
        for (int j = 0; j < 8; ++j) wv[j] = wr[64 * j];
        asm volatile("" : "+v"(wv[0]), "+v"(wv[1]), "+v"(wv[2]), "+v"(wv[3]), "+v"(wv[4]), "+v"(wv[5]), "+v"(wv[6]), "+v"(wv[7]));
#pragma unroll
        for (int j = 0; j < 8; ++j) { const f32x4 ww = wv[j]; const f32x4 o = v[j] * rstd * ww;
            if (FINAL) { ((f32x4*)(outf + (size_t)row * DM) + lane)[64 * j] = o; }
            else { u32x2 pk; pk.x = pk2(o.x, o.y); pk.y = pk2(o.z, o.w); ((u32x2*)(hb + (size_t)row * DM) + lane)[64 * j] = pk; } }
    }
}
struct LruP { const float *conv_w, *conv_b, *ga_w, *ga_b, *gx_w, *gx_b, *lam; };
struct LruBuf { float *HL, *AC, *SH, *SA; };
constexpr int LSEG = 256, NSEG = SEQ / LSEG, XSTR = 260;
typedef short lbfx8 __attribute__((ext_vector_type(8))); typedef float lfx16 __attribute__((ext_vector_type(16)));
__device__ __forceinline__ void lru_swap32(float& a, float& b) { asm volatile("s_nop 1\n\tv_permlane32_swap_b32 %0, %1" : "+v"(a), "+v"(b)); }
constexpr int LXS = 72;
__device__ __forceinline__ void lru_local_unit(int unit, const bf16* __restrict__ p, const LruP& P, const LruBuf& L, float* lds_f) {
    const int TID = tidx();
    bf16* sWTa = (bf16*)lds_f; bf16* sWTx = sWTa + 64 * LXS; bf16* sXB = sWTx + 64 * LXS;
    float* sCar = (float*)(sXB + 256 * LXS);
    const int b = unit >> 7, g = (unit >> 4) & 7, seg = unit & 15, c = TID & 63, tg = TID >> 6, t0 = seg * LSEG;
    { float wa[8], wx[8];
#pragma unroll
      for (int j = 0; j < 8; ++j) { wa[j] = P.ga_w[g * 4096 + TID + NTHREADS * j]; wx[j] = P.gx_w[g * 4096 + TID + NTHREADS * j]; }
      asm volatile("" : "+v"(wa[0]), "+v"(wa[1]), "+v"(wa[2]), "+v"(wa[3]), "+v"(wa[4]), "+v"(wa[5]), "+v"(wa[6]), "+v"(wa[7]));
      asm volatile("" : "+v"(wx[0]), "+v"(wx[1]), "+v"(wx[2]), "+v"(wx[3]), "+v"(wx[4]), "+v"(wx[5]), "+v"(wx[6]), "+v"(wx[7]));
#pragma unroll
      for (int j = 0; j < 8; ++j) { const int i = TID + NTHREADS * j, k = i >> 6, cc = i & 63; sWTa[cc * LXS + k] = (bf16)f2bf(wa[j]); sWTx[cc * LXS + k] = (bf16)f2bf(wx[j]); } }
    const int ch = g * 64 + c;
    const float cw0 = P.conv_w[0 * LRU_W + ch], cw1 = P.conv_w[1 * LRU_W + ch], cw2 = P.conv_w[2 * LRU_W + ch], cw3 = P.conv_w[3 * LRU_W + ch], cb = P.conv_b[ch];
    const float sp = log1pf(__expf(-P.lam[ch]));
    float xc[32];
    { const int tb = t0 + tg * 32; const bf16* pr = p + (size_t)(b * SEQ + tb) * NINP + OFF_XA + ch;
      unsigned xu[35];
#pragma unroll
      for (int i = 0; i < 35; ++i) xu[i] = (i >= 3 || tb >= 3 - i) ? (unsigned)pr[(ptrdiff_t)(i - 3) * NINP] : 0u;
#pragma unroll
      for (int gq = 0; gq < 5; ++gq) asm volatile("" : "+v"(xu[7 * gq]), "+v"(xu[7 * gq + 1]), "+v"(xu[7 * gq + 2]), "+v"(xu[7 * gq + 3]), "+v"(xu[7 * gq + 4]), "+v"(xu[7 * gq + 5]), "+v"(xu[7 * gq + 6]));
      float x3 = bf2f((unsigned short)xu[0]), x2 = bf2f((unsigned short)xu[1]), x1 = bf2f((unsigned short)xu[2]);
#pragma unroll
      for (int i = 0; i < 32; ++i) { const float x0 = bf2f((unsigned short)xu[i + 3]); xc[i] = cw3 * x0 + cw2 * x1 + cw1 * x2 + cw0 * x3 + cb; x3 = x2; x2 = x1; x1 = x0; } }
#pragma unroll
    for (int i = 0; i < 32; ++i) sXB[(tg * 32 + i) * LXS + c] = (bf16)f2bf(xc[i]);
    __syncthreads();
    float ra[32], ia[32];
    { const int r = c & 31, h = c >> 5;
      lbfx8 fa[4];
#pragma unroll
      for (int ks = 0; ks < 4; ++ks) fa[ks] = *(const lbfx8*)(sXB + (tg * 32 + r) * LXS + 16 * ks + 8 * h);
#pragma unroll
      for (int gate = 0; gate < 2; ++gate) { const bf16* W = gate ? sWTx : sWTa; const float* bp = (gate ? P.gx_b : P.ga_b) + g * 64;
          const float b0 = bp[r], b1 = bp[32 + r];
          lfx16 acc0 = {}, acc1 = {};
#pragma unroll
          for (int ks = 0; ks < 4; ++ks) { const lbfx8 w0 = *(const lbfx8*)(W + r * LXS + 16 * ks + 8 * h), w1 = *(const lbfx8*)(W + (32 + r) * LXS + 16 * ks + 8 * h);
              acc0 = __builtin_amdgcn_mfma_f32_32x32x16_bf16(fa[ks], w0, acc0, 0, 0, 0); acc1 = __builtin_amdgcn_mfma_f32_32x32x16_bf16(fa[ks], w1, acc1, 0, 0, 0); }
#pragma unroll
          for (int i = 0; i < 16; ++i) { float a0 = acc0[i] + b0, a1 = acc1[i] + b1; lru_swap32(a0, a1); const int t = (i & 3) + 8 * (i >> 2);
              if (gate == 0) { ra[t] = a0; ra[t + 4] = a1; } else { ia[t] = a0; ia[t + 4] = a1; } } } }
    { float h = 0.f, A = 1.f;
#pragma unroll
      for (int i = 0; i < 32; ++i) { const float r = sigmoidf_(ra[i]), ig = sigmoidf_(ia[i]);
          const float log_a = -8.f * r * sp; const float av = __expf(log_a);
          const float x2 = 2.f * log_a; float om = 1.f - av * av; if (x2 > -0.03f) om = -x2 * (1.f + x2 * (0.5f + x2 * (1.f / 6.f)));
          const float bb = __builtin_amdgcn_sqrtf(om) * (ig * xc[i]);
          h = av * h + bb; A *= av; ra[i] = h; ia[i] = A; }
      sCar[(tg * 64 + c) * 2] = h; sCar[(tg * 64 + c) * 2 + 1] = A; }
    __syncthreads();
    float cin = 0.f, Ap = 1.f;
    for (int q = 0; q < tg; ++q) { const float he = sCar[(q * 64 + c) * 2], Ae = sCar[(q * 64 + c) * 2 + 1]; cin = he + Ae * cin; Ap *= Ae; }
    { const size_t o = (size_t)(b * SEQ + t0 + tg * 32) * LRU_W + ch;
#pragma unroll
      for (int i = 0; i < 32; ++i) { const float h = ra[i] + ia[i] * cin, A = ia[i] * Ap; L.HL[o + (size_t)i * LRU_W] = h; L.AC[o + (size_t)i * LRU_W] = A;
          if (i == 31 && tg == 7) { L.SH[(b * NSEG + seg) * LRU_W + ch] = h; L.SA[(b * NSEG + seg) * LRU_W + ch] = A; } } }
    __syncthreads();
}
__device__ __forceinline__ void lru_final_unit(int unit, const bf16* __restrict__ p, const LruBuf& L, bf16* ybuf, float* lds_f) {
    const int TID = tidx();
    const int b = unit >> 7, g = (unit >> 4) & 7, seg = unit & 15, c = TID & 63, tg = TID >> 6, t0 = seg * LSEG, ch = g * 64 + c;
    float cin = 0.f;
    for (int s = 0; s < seg; ++s) cin = L.SH[(b * NSEG + s) * LRU_W + ch] + L.SA[(b * NSEG + s) * LRU_W + ch] * cin;
    const size_t row0 = (size_t)(b * SEQ + t0 + tg * 32);
    for (int i0 = 0; i0 < 32; i0 += 8) { float hl[8], ac[8]; unsigned gu[8];
#pragma unroll
        for (int i = 0; i < 8; ++i) { const size_t row = row0 + i0 + i; hl[i] = L.HL[row * LRU_W + ch]; ac[i] = L.AC[row * LRU_W + ch]; gu[i] = p[row * NINP + OFF_GA + ch]; }
        asm volatile("" : "+v"(hl[0]), "+v"(hl[1]), "+v"(hl[2]), "+v"(hl[3]), "+v"(hl[4]), "+v"(hl[5]), "+v"(hl[6]), "+v"(hl[7]));
        asm volatile("" : "+v"(ac[0]), "+v"(ac[1]), "+v"(ac[2]), "+v"(ac[3]), "+v"(ac[4]), "+v"(ac[5]), "+v"(ac[6]), "+v"(ac[7]));
        asm volatile("" : "+v"(gu[0]), "+v"(gu[1]), "+v"(gu[2]), "+v"(gu[3]), "+v"(gu[4]), "+v"(gu[5]), "+v"(gu[6]), "+v"(gu[7]));
#pragma unroll
        for (int i = 0; i < 8; ++i) { const size_t row = row0 + i0 + i; const float h = hl[i] + ac[i] * cin; const float ga = bf2f((unsigned short)gu[i]);
            ybuf[row * DM + ch] = (bf16)f2bf(h * siluf_(ga)); } }
}
struct RwkvP { const float *mix, *w0, *w_up, *a0, *a_up, *k_k, *k_a, *r_k, *ln_w, *ln_b; const bf16* lora; };
typedef short bfx8 __attribute__((ext_vector_type(8)));
typedef float fx16 __attribute__((ext_vector_type(16)));
#define MFMA32(a, b, c) __builtin_amdgcn_mfma_f32_32x32x16_bf16(a, b, c, 0, 0, 0)
constexpr int RC = 32, NCH = SEQ / RC;
constexpr int CH_AT = 0, CH_BT = 4096, CH_KT = 8192, CH_RT = 12288, CH_BHT = 16384, CH_KHT = 20480, CH_VT = 24576, CH_VR = 28672, CH_ECW = 32768, CH_C3 = 33024, CH_STRIDE = 33280;
constexpr int O_P = 0, O_QT = 4096, O_ARB = 8192, O_ARK = 10240, O_STRIDE = 12288;
constexpr int ST_S0 = 0, ST_UT = 8192, ST_STRIDE = 12288;
struct RwcBuf { unsigned char *CH, *O1, *ST; };
__device__ __forceinline__ int crow16(int reg, int h) { return (reg & 3) + 8 * (reg >> 2) + 4 * h; }
typedef float f32x2c_t __attribute__((ext_vector_type(2))); typedef __bf16 bf16x2c_t __attribute__((ext_vector_type(2)));
__device__ __forceinline__ unsigned cvtpk(float lo, float hi) { const f32x2c_t v = {lo, hi}; const bf16x2c_t b = __builtin_convertvector(v, bf16x2c_t); return __builtin_bit_cast(unsigned, b); }

__device__ __forceinline__ void rwkv_stage1(int item, const RwcBuf& B, unsigned char* wl);
__device__ __forceinline__ void rwkv_phaseA(int unit, const bf16* __restrict__ p, const RwkvP& P, const RwcBuf& B, unsigned char* lds) {
    const int TID = tidx();
    const int wave = TID >> 6;
    bf16* TW = (bf16*)(lds + 132096); bf16* AD = TW + 32 * 64;
    float* LWt = (float*)(lds + wave * 16384); float* LAt = LWt + 64 * 32;
    const int row0 = unit * 32, b = row0 >> 12, tb = row0 & (SEQ - 1), chunk = tb >> 5;
    { unsigned cu[8], pu[8];
      const float mixv = P.mix[2304 + (TID & 127)];
#pragma unroll
      for (int i = 0; i < 8; ++i) { const int idx = TID + 512 * i, tok = idx >> 7, col = idx & 127, cidx = 2304 + col;
          const bf16* cur = p + (size_t)(row0 + tok) * NINP + OFF_SB + cidx;
          cu[i] = cur[0]; pu[i] = (tb + tok) > 0 ? (unsigned)*(cur - NINP) : 0u; }
      asm volatile("" : "+v"(cu[0]), "+v"(cu[1]), "+v"(cu[2]), "+v"(cu[3]), "+v"(cu[4]), "+v"(cu[5]), "+v"(cu[6]), "+v"(cu[7]));
      asm volatile("" : "+v"(pu[0]), "+v"(pu[1]), "+v"(pu[2]), "+v"(pu[3]), "+v"(pu[4]), "+v"(pu[5]), "+v"(pu[6]), "+v"(pu[7]));
#pragma unroll
      for (int i = 0; i < 8; ++i) { const int idx = TID + 512 * i, tok = idx >> 7, col = idx & 127;
          const float c0 = bf2f((unsigned short)cu[i]), p0 = bf2f((unsigned short)pu[i]); const float s = c0 + mixv * (p0 - c0);
          const int cc = col & 63, so = tok * 64 + (((cc >> 3) ^ (tok & 7)) << 3) + (cc & 7);
          if (col < 64) TW[so] = (bf16)f2bf(tanhf(s)); else AD[so] = (bf16)f2bf(s); } }
    __syncthreads();
    for (int pass = 0; pass < 2; ++pass) {
        int tl_ = TID; asm volatile("" : "+v"(tl_));
        const int c = pass * 512 + tl_, lane = tl_ & 63, r = lane & 31, hh = lane >> 5;
        if (c < RW) {
            { bfx8 aW[4], aA[4];
#pragma unroll
              for (int ks = 0; ks < 4; ++ks) { const int so = r * 64 + (((2 * ks + hh) ^ (r & 7)) << 3); aW[ks] = *(const bfx8*)(TW + so); aA[ks] = *(const bfx8*)(AD + so); }
              const int cb = (c & ~63);
#pragma unroll
              for (int n = 0; n < 2; ++n) { fx16 xw = {}, xa = {};
                  const bf16* wfr = P.lora + ((size_t)((cb >> 6) * 2) * 64 + 32 * n + r) * 64 + 8 * hh; const bf16* afr = wfr + 64 * 64;
#pragma unroll
                  for (int ks = 0; ks < 4; ++ks) { const bfx8 bw = *(const bfx8*)(wfr + 16 * ks), ba = *(const bfx8*)(afr + 16 * ks);
                      xw = MFMA32(aW[ks], bw, xw); xa = MFMA32(aA[ks], ba, xa); }
#pragma unroll
                  for (int g = 0; g < 4; ++g) { const int so = (32 * n + r) * 32 + 4 * ((2 * g + hh) ^ (r & 7));
                      *(f32x4*)(LWt + so) = (f32x4){xw[4 * g], xw[4 * g + 1], xw[4 * g + 2], xw[4 * g + 3]};
                      *(f32x4*)(LAt + so) = (f32x4){xa[4 * g], xa[4 * g + 1], xa[4 * g + 2], xa[4 * g + 3]}; } } }
            float lw[32], la[32];
            { const float w0 = P.w0[c], a0 = P.a0[c];
#pragma unroll
              for (int q = 0; q < 8; ++q) { const int so = lane * 32 + 4 * (q ^ (lane & 7)); const f32x4 wv = *(const f32x4*)(LWt + so), av = *(const f32x4*)(LAt + so);
                  lw[4 * q] = wv.x + w0; lw[4 * q + 1] = wv.y + w0; lw[4 * q + 2] = wv.z + w0; lw[4 * q + 3] = wv.w + w0;
                  la[4 * q] = av.x + a0; la[4 * q + 1] = av.y + a0; la[4 * q + 2] = av.z + a0; la[4 * q + 3] = av.w + a0; } }
            float cwC;
            { float cw = 0.f;
#pragma unroll
              for (int i = 0; i < 32; ++i) { cw += -0.6065306597126334f * sigmoidf_(lw[i]); lw[i] = cw; la[i] = sigmoidf_(la[i]); }
              cwC = cw; }
            const float mr = P.mix[c], mk = P.mix[RW + c], mv = P.mix[2 * RW + c], kkw = P.k_k[c], kaw = P.k_a[c], rkw = P.r_k[c];
            const int h = c >> 6, j = c & 63;
            bf16* XS = (bf16*)LWt;
            { const int ln = lane;
              const bf16* src = p + (size_t)(row0 - 1) * NINP + OFF_SB + h * 64 + (ln & 7) * 8;
              u32x4 tv[3][5];
#pragma unroll
              for (int arr = 0; arr < 3; ++arr)
#pragma unroll
                  for (int q = 0; q < 5; ++q) { const int tok = 8 * q + (ln >> 3); tv[arr][q] = (u32x4){0u, 0u, 0u, 0u};
                      if (tok < 33 && (tb + tok) > 0) tv[arr][q] = *(const u32x4*)(src + (size_t)tok * NINP + arr * RW); }
#pragma unroll
              for (int arr = 0; arr < 3; ++arr)
#pragma unroll
                  for (int q = 0; q < 5; ++q) { const int tok = 8 * q + (ln >> 3); if (tok < 33) *(u32x4*)(XS + (tok * 3 + arr) * 64 + (ln & 7) * 8) = tv[arr][q]; } }
            float pr = bf2f(XS[0 * 64 + j]), pk = bf2f(XS[1 * 64 + j]), pv = bf2f(XS[2 * 64 + j]);
            unsigned char* ch = B.CH + (size_t)((b * NH + h) * NCH + chunk) * CH_STRIDE;
            bf16* AT = (bf16*)(ch + CH_AT); bf16* BT = (bf16*)(ch + CH_BT); bf16* KT = (bf16*)(ch + CH_KT); bf16* RT = (bf16*)(ch + CH_RT); bf16* VR = (bf16*)(ch + CH_VR);
            unsigned bhp[16], khp[16], vtp[16];
            float hold_b = 0.f, hold_k = 0.f, hold_v = 0.f;
            float h_at = 0.f, h_bt = 0.f, h_kt = 0.f, h_rt = 0.f, h_vr = 0.f;
            const bool oddl = (j & 1) != 0; const int pbase = (oddl ? 64 : 0) + (j & ~1);
#define PAIR_ST(ARR, HOLD, CUR) { const float snd_ = oddl ? HOLD : CUR; const float rcv_ = dpp0<0xB1, 0xf>(snd_); \
                *(unsigned*)(ARR + (i - 1) * 64 + pbase) = oddl ? cvtpk(rcv_, CUR) : cvtpk(HOLD, rcv_); }
#pragma unroll
            for (int i = 0; i < 32; ++i) { const float cr = bf2f(XS[(3 * (i + 1) + 0) * 64 + j]), ck = bf2f(XS[(3 * (i + 1) + 1) * 64 + j]), cv = bf2f(XS[(3 * (i + 1) + 2) * 64 + j]);
                const float r = cr + mr * (pr - cr), k = ck + mk * (pk - ck), v = cv + mv * (pv - cv); pr = cr; pk = ck; pv = cv;
                const float av = la[i];
                float kk = k * kkw;
                kk *= __builtin_amdgcn_rcpf(fmaxf(__builtin_amdgcn_sqrtf(wave_sum(kk * kk)), 1e-12f));
                const float km = k * (1.f + (av - 1.f) * kaw);
                const float be = kk * av;
                const float cwi = lw[i], cwp = i > 0 ? lw[i - 1] : 0.f;
                const float em = __expf(-cwi), eh = __expf(cwC - cwi);
                const float c3 = wave_sum(r * km * rkw);
                { const float v_at = -kk * __expf(cwp), v_bt = be * em, v_kt = km * em, v_rt = r * __expf(cwi);
                  if (i & 1) { PAIR_ST(AT, h_at, v_at) PAIR_ST(BT, h_bt, v_bt) PAIR_ST(KT, h_kt, v_kt) PAIR_ST(RT, h_rt, v_rt) PAIR_ST(VR, h_vr, v) }
                  else { h_at = v_at; h_bt = v_bt; h_kt = v_kt; h_rt = v_rt; h_vr = v; } }
                const float bhv = be * eh, khv = km * eh;
                if (i & 1) { bhp[i >> 1] = cvtpk(hold_b, bhv); khp[i >> 1] = cvtpk(hold_k, khv); vtp[i >> 1] = cvtpk(hold_v, v); } else { hold_b = bhv; hold_k = khv; hold_v = v; }
                if (j == 0) ((float*)(ch + CH_C3))[i] = c3; }
#undef PAIR_ST
            u32x4* BHT = (u32x4*)(ch + CH_BHT + j * 64); u32x4* KHT = (u32x4*)(ch + CH_KHT + j * 64); u32x4* VT = (u32x4*)(ch + CH_VT + j * 64);
#pragma unroll
            for (int q = 0; q < 4; ++q) { BHT[q] = (u32x4){bhp[4 * q], bhp[4 * q + 1], bhp[4 * q + 2], bhp[4 * q + 3]}; KHT[q] = (u32x4){khp[4 * q], khp[4 * q + 1], khp[4 * q + 2], khp[4 * q + 3]};
                VT[q] = (u32x4){vtp[4 * q], vtp[4 * q + 1], vtp[4 * q + 2], vtp[4 * q + 3]}; }
            ((float*)(ch + CH_ECW))[j] = __expf(cwC);
        }
        else {
            asm volatile("s_waitcnt vmcnt(0)" ::: "memory");
            rwkv_stage1((b * NH + (tl_ >> 6)) * NCH + chunk, B, lds + (tl_ >> 6) * 16384);
        }
    }
    asm volatile("s_waitcnt vmcnt(0)" ::: "memory");
    __syncthreads();
}

#define FMAC(acc, a, b) asm("v_fmac_f32 %0, %1, %2" : "+v"(acc) : "v"(a), "v"(b))
template <int N> __device__ __forceinline__ void sub_pin(f32x4* v) {
    if constexpr (N >= 8) { asm volatile("" : "+v"(v[0]), "+v"(v[1]), "+v"(v[2]), "+v"(v[3]), "+v"(v[4]), "+v"(v[5]), "+v"(v[6]), "+v"(v[7]) :: "memory"); sub_pin<N - 8>(v + 8); }
    else if constexpr (N >= 4) { asm volatile("" : "+v"(v[0]), "+v"(v[1]), "+v"(v[2]), "+v"(v[3]) :: "memory"); sub_pin<N - 4>(v + 4); }
    else if constexpr (N >= 2) { asm volatile("" : "+v"(v[0]), "+v"(v[1]) :: "memory"); sub_pin<N - 2>(v + 2); }
    else if constexpr (N == 1) { asm volatile("" : "+v"(v[0]) :: "memory"); }
}
constexpr int sub_nq(int t) { return t <= 31 ? (t + 3) / 4 : 0; }
template <int T0> __device__ __forceinline__ void sub_load(const float* Lf, f32x4 (&l)[16]) {
#pragma unroll
    for (int q = 0; q < sub_nq(T0); ++q) l[q] = *(const f32x4*)(Lf + T0 * 32 + 4 * (q ^ (T0 & 7)));
#pragma unroll
    for (int q = 0; q < sub_nq(T0 + 1); ++q) l[sub_nq(T0) + q] = *(const f32x4*)(Lf + (T0 + 1) * 32 + 4 * (q ^ ((T0 + 1) & 7)));
}
template <int T> __device__ __forceinline__ void sub_row(const f32x4* l, float (&xp)[32], float (&xq)[32]) {
#pragma unroll
    for (int q = 0; q < sub_nq(T); ++q)
#pragma unroll
        for (int e = 0; e < 4; ++e) { const int s = 4 * q + e; if (s < T) { FMAC(xp[T], l[q][e], xp[s]); FMAC(xq[T], l[q][e], xq[s]); } }
}
template <int T0> __device__ __forceinline__ void sub_step(const float* Lf, float (&xp)[32], float (&xq)[32], f32x4 (&cur)[16]) {
    f32x4 nxt[16];
    if constexpr (T0 + 2 <= 31) sub_load<T0 + 2>(Lf, nxt);
    sub_pin<sub_nq(T0) + sub_nq(T0 + 1)>(cur);
    sub_row<T0>(cur, xp, xq);
    if constexpr (T0 + 1 <= 31) sub_row<T0 + 1>(cur + sub_nq(T0), xp, xq);
    if constexpr (T0 + 2 <= 31) sub_step<T0 + 2>(Lf, xp, xq, nxt);
}
__device__ __forceinline__ void rwkv_stage1(int item, const RwcBuf& B, unsigned char* wl  ) {
    const int TID = tidx();
    const int lane = TID & 63, r = lane & 31, h = lane >> 5;
    const unsigned char* ch = B.CH + (size_t)item * CH_STRIDE; unsigned char* o1 = B.O1 + (size_t)item * O_STRIDE;
    float* Lf = (float*)wl;
    bf16* LakB = (bf16*)(wl + 12288);
    float* GT = (float*)(wl + 4096);
    const bf16* AT = (const bf16*)(ch + CH_AT); const bf16* BT = (const bf16*)(ch + CH_BT); const bf16* KT = (const bf16*)(ch + CH_KT); const bf16* RT = (const bf16*)(ch + CH_RT);
    const bf16* VT = (const bf16*)(ch + CH_VT);
    bfx8 fA[4], fB[4], fK[4], fR[4];
#pragma unroll
    for (int ks = 0; ks < 4; ++ks) { const int o = r * 64 + 16 * ks + 8 * h; fA[ks] = *(const bfx8*)(AT + o); fB[ks] = *(const bfx8*)(BT + o); fK[ks] = *(const bfx8*)(KT + o); fR[ks] = *(const bfx8*)(RT + o); }
    bf16* ATs = (bf16*)(wl + 12288);
    u32x4 atv[4];
#pragma unroll
    for (int q = 0; q < 4; ++q) atv[q] = *(const u32x4*)(AT + (lane + 64 * q) * 8);
    const fx16 zero = {};
    { fx16 x = zero;
#pragma unroll
      for (int ks = 0; ks < 4; ++ks) x = MFMA32(fB[ks], fA[ks], x);
#pragma unroll
      for (int g = 0; g < 4; ++g) { f32x4 w;
#pragma unroll
          for (int e = 0; e < 4; ++e) { const int s = 8 * g + 4 * h + e; w[e] = s < r ? x[4 * g + e] : 0.f; }
          *(f32x4*)(Lf + r * 32 + 4 * ((2 * g + h) ^ (r & 7))) = w; } }
    { fx16 x = zero;
#pragma unroll
      for (int ks = 0; ks < 4; ++ks) x = MFMA32(fK[ks], fA[ks], x);
#pragma unroll
      for (int g = 0; g < 4; ++g) { float w[4];
#pragma unroll
          for (int e = 0; e < 4; ++e) { const int s = 8 * g + 4 * h + e; w[e] = s < r ? x[4 * g + e] : 0.f; }
          *(u32x2*)(LakB + r * 32 + 8 * g + 4 * h) = (u32x2){cvtpk(w[0], w[1]), cvtpk(w[2], w[3])}; } }
    { fx16 x = zero, y = zero;
#pragma unroll
      for (int ks = 0; ks < 4; ++ks) { x = MFMA32(fB[ks], fR[ks], x); y = MFMA32(fK[ks], fR[ks], y); }
      bf16* ARB = (bf16*)(o1 + O_ARB); bf16* ARK = (bf16*)(o1 + O_ARK);
#pragma unroll
      for (int g = 0; g < 4; ++g) { float w[4], z[4];
#pragma unroll
          for (int e = 0; e < 4; ++e) { const int s = 8 * g + 4 * h + e; w[e] = s <= r ? x[4 * g + e] : 0.f; z[e] = s <= r ? y[4 * g + e] : 0.f; }
          *(u32x2*)(ARB + r * 32 + 8 * g + 4 * h) = (u32x2){cvtpk(w[0], w[1]), cvtpk(w[2], w[3])}; *(u32x2*)(ARK + r * 32 + 8 * g + 4 * h) = (u32x2){cvtpk(z[0], z[1]), cvtpk(z[2], z[3])}; } }
#pragma unroll
    for (int n = 0; n < 2; ++n) { fx16 x = zero;
#pragma unroll
        for (int ks = 0; ks < 2; ++ks) { const bfx8 a = *(const bfx8*)(LakB + r * 32 + 16 * ks + 8 * h); const bfx8 bb = *(const bfx8*)(VT + (32 * n + r) * 32 + 16 * ks + 8 * h); x = MFMA32(a, bb, x); }
#pragma unroll
        for (int g = 0; g < 4; ++g) *(f32x4*)(GT + (32 * n + r) * 32 + 4 * ((2 * g + h) ^ (r & 7))) = (f32x4){x[4 * g], x[4 * g + 1], x[4 * g + 2], x[4 * g + 3]}; }
#pragma unroll
    for (int q = 0; q < 4; ++q) *(u32x4*)(ATs + (lane + 64 * q) * 8) = atv[q];
    float xp[32], xq[32];
    { unsigned xu[32];
#pragma unroll
      for (int t = 0; t < 32; ++t) xu[t] = ATs[t * 64 + lane];
#pragma unroll
      for (int g = 0; g < 4; ++g) asm volatile("" : "+v"(xu[8 * g]), "+v"(xu[8 * g + 1]), "+v"(xu[8 * g + 2]), "+v"(xu[8 * g + 3]), "+v"(xu[8 * g + 4]), "+v"(xu[8 * g + 5]), "+v"(xu[8 * g + 6]), "+v"(xu[8 * g + 7]));
#pragma unroll
      for (int t = 0; t < 32; ++t) xp[t] = __builtin_bit_cast(float, xu[t] << 16); }
#pragma unroll
    for (int q = 0; q < 8; ++q) { const f32x4 gv = *(const f32x4*)(GT + lane * 32 + 4 * (q ^ (lane & 7))); xq[4 * q] = gv.x; xq[4 * q + 1] = gv.y; xq[4 * q + 2] = gv.z; xq[4 * q + 3] = gv.w; }
    { f32x4 l0[16]; sub_load<1>(Lf, l0); sub_step<1>(Lf, xp, xq, l0); }
    { bf16* Pg = (bf16*)(o1 + O_P);
#pragma unroll
      for (int t = 0; t < 32; ++t) Pg[t * 64 + lane] = (bf16)f2bf(xp[t]);
      u32x4* Qg = (u32x4*)(o1 + O_QT + lane * 64);
#pragma unroll
      for (int q = 0; q < 4; ++q) Qg[q] = (u32x4){cvtpk(xq[8 * q], xq[8 * q + 1]), cvtpk(xq[8 * q + 2], xq[8 * q + 3]), cvtpk(xq[8 * q + 4], xq[8 * q + 5]), cvtpk(xq[8 * q + 6], xq[8 * q + 7])}; }
}

constexpr int S2_P = 0, S2_QT = 4608, S2_BHT = 9728, S2_KHT = 14848, S2_VT = 19968, S2_ECW = 25088, S2_BUF = 25344;
__device__ __forceinline__ void s2_src_dst(int idx, const unsigned char* ch, const unsigned char* o1, const unsigned char*& src, int& dst) {
    if (idx < 256) { src = o1 + O_P + idx * 16; dst = S2_P + (idx >> 3) * 144 + (idx & 7) * 16; }
    else if (idx < 1280) { const int a = (idx - 256) >> 8, j = (idx - 256) & 255;
        src = (a == 0 ? o1 + O_QT : a == 1 ? ch + CH_BHT : a == 2 ? ch + CH_KHT : ch + CH_VT) + j * 16; dst = S2_QT + a * 5120 + (j >> 2) * 80 + (j & 3) * 16; }
    else { src = ch + CH_ECW + (idx - 1280) * 16; dst = S2_ECW + (idx - 1280) * 16; }
}
__device__ __forceinline__ bfx8 cat8(u32x2 lo, u32x2 hi) { return __builtin_bit_cast(bfx8, (u32x4){lo.x, lo.y, hi.x, hi.y}); }
__device__ __forceinline__ void rwkv_stage2(int bh, const RwcBuf& B, unsigned char* ldsb) {
    const int TID = tidx();
    const int lane = TID & 63, wave = TID >> 6, r = lane & 31, h = lane >> 5, n = wave;
    const unsigned char* chb = B.CH + (size_t)bh * NCH * CH_STRIDE; const unsigned char* o1b = B.O1 + (size_t)bh * NCH * O_STRIDE;
    unsigned char* stb = B.ST + (size_t)bh * NCH * ST_STRIDE;
    u32x4 preA[4], preB[4]; preA[0] = preA[1] = preA[2] = preA[3] = preB[0] = preB[1] = preB[2] = preB[3] = (u32x4){0u, 0u, 0u, 0u};
    const int TS = TID - 128;
#define S2_LOAD(R, cc) { _Pragma("unroll") for (int i = 0; i < 4; ++i) { const int idx = TS + 384 * i; if (TS >= 0 && idx < 1296) { const unsigned char* s_; int d_; s2_src_dst(idx, chb + (size_t)(cc) * CH_STRIDE, o1b + (size_t)(cc) * O_STRIDE, s_, d_); R[i] = *(const u32x4*)s_; } } }
#define S2_WRITE(R, bo) { _Pragma("unroll") for (int i = 0; i < 4; ++i) { const int idx = TS + 384 * i; if (TS >= 0 && idx < 1296) { const unsigned char* s_; int d_; s2_src_dst(idx, chb, o1b, s_, d_); *(u32x4*)(ldsb + (bo) + d_) = R[i]; } } }
    S2_LOAD(preA, 0); S2_WRITE(preA, 0);
    S2_LOAD(preB, 1);
    __syncthreads();
    fx16 S[2]; S[0] = fx16{}; S[1] = fx16{};
    int bcur = 0;
    for (int c2 = 0; c2 < NCH; c2 += 2) {
#pragma unroll
        for (int par = 0; par < 2; ++par) { const int c = c2 + par;
        const unsigned char* cur = ldsb + bcur; const int bnxt = bcur == 2 * S2_BUF ? 0 : bcur + S2_BUF;
        if (c + 2 < NCH) { if (par == 0) S2_LOAD(preA, c + 2) else S2_LOAD(preB, c + 2) }
        if (wave < 2) {
            unsigned char* st = stb + (size_t)c * ST_STRIDE;
            bfx8 sb[4];
#pragma unroll
            for (int ks = 0; ks < 4; ++ks) { const fx16& T = S[ks >> 1]; const int o = 8 * (ks & 1);
                sb[ks] = __builtin_bit_cast(bfx8, (u32x4){cvtpk(T[o], T[o + 1]), cvtpk(T[o + 2], T[o + 3]), cvtpk(T[o + 4], T[o + 5]), cvtpk(T[o + 6], T[o + 7])}); }
            { bf16* Sg = (bf16*)(st + ST_S0);
#pragma unroll
              for (int ks = 0; ks < 4; ++ks) { const u32x4 w = __builtin_bit_cast(u32x4, sb[ks]);
                  *(u32x2*)(Sg + (32 * n + r) * 64 + 16 * ks + 4 * h) = (u32x2){w.x, w.y}; *(u32x2*)(Sg + (32 * n + r) * 64 + 16 * ks + 8 + 4 * h) = (u32x2){w.z, w.w}; } }
            fx16 U;
            { const bf16* QTl = (const bf16*)(cur + S2_QT);
#pragma unroll
              for (int g = 0; g < 4; ++g) { const u32x2 q2 = *(const u32x2*)(QTl + (32 * n + r) * 40 + 8 * g + 4 * h); U[4 * g] = bflo(q2.x); U[4 * g + 1] = bfhi(q2.x); U[4 * g + 2] = bflo(q2.y); U[4 * g + 3] = bfhi(q2.y); } }
            { const bf16* Pl = (const bf16*)(cur + S2_P);
#pragma unroll
              for (int ks = 0; ks < 4; ++ks) { const bfx8 pa = cat8(*(const u32x2*)(Pl + r * 72 + 16 * ks + 4 * h), *(const u32x2*)(Pl + r * 72 + 16 * ks + 8 + 4 * h)); U = MFMA32(pa, sb[ks], U); } }
            bfx8 ub[2];
#pragma unroll
            for (int ks = 0; ks < 2; ++ks) { const int o = 8 * ks; ub[ks] = __builtin_bit_cast(bfx8, (u32x4){cvtpk(U[o], U[o + 1]), cvtpk(U[o + 2], U[o + 3]), cvtpk(U[o + 4], U[o + 5]), cvtpk(U[o + 6], U[o + 7])}); }
            { bf16* Ug = (bf16*)(st + ST_UT);
#pragma unroll
              for (int ks = 0; ks < 2; ++ks) { const u32x4 w = __builtin_bit_cast(u32x4, ub[ks]);
                  *(u32x2*)(Ug + (32 * n + r) * 32 + 16 * ks + 4 * h) = (u32x2){w.x, w.y}; *(u32x2*)(Ug + (32 * n + r) * 32 + 16 * ks + 8 + 4 * h) = (u32x2){w.z, w.w}; } }
            const bf16* BHl = (const bf16*)(cur + S2_BHT); const bf16* KHl = (const bf16*)(cur + S2_KHT); const bf16* VTl = (const bf16*)(cur + S2_VT); const float* El = (const float*)(cur + S2_ECW);
            bfx8 vb[2];
#pragma unroll
            for (int ks = 0; ks < 2; ++ks) vb[ks] = *(const bfx8*)(VTl + (32 * n + r) * 40 + 16 * ks + 8 * h);
#pragma unroll
            for (int m = 0; m < 2; ++m) { fx16 acc;
#pragma unroll
                for (int g = 0; g < 4; ++g) { const f32x4 e4 = *(const f32x4*)(El + 32 * m + 8 * g + 4 * h); acc[4 * g] = S[m][4 * g] * e4.x; acc[4 * g + 1] = S[m][4 * g + 1] * e4.y; acc[4 * g + 2] = S[m][4 * g + 2] * e4.z; acc[4 * g + 3] = S[m][4 * g + 3] * e4.w; }
#pragma unroll
                for (int ks = 0; ks < 2; ++ks) { const bfx8 ba = cat8(*(const u32x2*)(BHl + (32 * m + r) * 40 + 16 * ks + 4 * h), *(const u32x2*)(BHl + (32 * m + r) * 40 + 16 * ks + 8 + 4 * h));
                    const bfx8 ka = *(const bfx8*)(KHl + (32 * m + r) * 40 + 16 * ks + 8 * h);
                    acc = MFMA32(ba, ub[ks], acc); acc = MFMA32(ka, vb[ks], acc); }
                S[m] = acc; }
        }
        if (c + 1 < NCH) { if (par == 0) S2_WRITE(preB, bnxt) else S2_WRITE(preA, bnxt) }
        __syncthreads();
        bcur = bnxt; }
    }
#undef S2_LOAD
#undef S2_WRITE
}

__device__ __forceinline__ void rwkv_stage3(int item, const bf16* __restrict__ p, const RwkvP& P, const RwcBuf& B, bf16* ybuf, unsigned char* wl) {
    const int TID = tidx();
    const int lane = TID & 63, r = lane & 31, h = lane >> 5;
    const int bh = item / NCH, chunk = item % NCH, b = bh / NH, hd = bh % NH;
    const unsigned char* ch = B.CH + (size_t)item * CH_STRIDE; const unsigned char* o1 = B.O1 + (size_t)item * O_STRIDE; const unsigned char* st = B.ST + (size_t)item * ST_STRIDE;
    const bf16* Sg = (const bf16*)(st + ST_S0); const bf16* UT = (const bf16*)(st + ST_UT);
    float* Yf = (float*)wl;
    const bf16* ARB = (const bf16*)(o1 + O_ARB); const bf16* ARK = (const bf16*)(o1 + O_ARK);
    const bf16* RT = (const bf16*)(ch + CH_RT); const bf16* VT = (const bf16*)(ch + CH_VT); const bf16* VR = (const bf16*)(ch + CH_VR);
    bfx8 fR[4], fArb[2], fArk[2], sbf[2][4], ubf[2][2], vbf[2][2];
#pragma unroll
    for (int ks = 0; ks < 4; ++ks) fR[ks] = *(const bfx8*)(RT + r * 64 + 16 * ks + 8 * h);
#pragma unroll
    for (int ks = 0; ks < 2; ++ks) { fArb[ks] = *(const bfx8*)(ARB + r * 32 + 16 * ks + 8 * h); fArk[ks] = *(const bfx8*)(ARK + r * 32 + 16 * ks + 8 * h); }
#pragma unroll
    for (int n = 0; n < 2; ++n) {
#pragma unroll
        for (int ks = 0; ks < 4; ++ks) sbf[n][ks] = *(const bfx8*)(Sg + (32 * n + r) * 64 + 16 * ks + 8 * h);
#pragma unroll
        for (int ks = 0; ks < 2; ++ks) { ubf[n][ks] = *(const bfx8*)(UT + (32 * n + r) * 32 + 16 * ks + 8 * h); vbf[n][ks] = *(const bfx8*)(VT + (32 * n + r) * 32 + 16 * ks + 8 * h); } }
#pragma unroll
    for (int n = 0; n < 2; ++n) { fx16 y = {};
#pragma unroll
        for (int ks = 0; ks < 4; ++ks) y = MFMA32(fR[ks], sbf[n][ks], y);
#pragma unroll
        for (int ks = 0; ks < 2; ++ks) { y = MFMA32(fArb[ks], ubf[n][ks], y); y = MFMA32(fArk[ks], vbf[n][ks], y); }
#pragma unroll
        for (int reg = 0; reg < 16; ++reg) Yf[crow16(reg, h) * 68 + 32 * n + r] = y[reg]; }
    { const int t = lane >> 1, hf = lane & 1; const float* yr = Yf + t * 68 + 32 * hf; float yv[32]; float s = 0.f;
#pragma unroll
      for (int q = 0; q < 8; ++q) { const f32x4 v4 = *(const f32x4*)(yr + 4 * q); yv[4 * q] = v4.x; yv[4 * q + 1] = v4.y; yv[4 * q + 2] = v4.z; yv[4 * q + 3] = v4.w; s += (v4.x + v4.y) + (v4.z + v4.w); }
      s += dpp0<0xB1, 0xf>(s); const float mu = s * (1.f / 64.f); float q2 = 0.f;
#pragma unroll
      for (int i = 0; i < 32; ++i) { yv[i] -= mu; q2 += yv[i] * yv[i]; }
      q2 += dpp0<0xB1, 0xf>(q2); const float rstd = rsqrtf(q2 * (1.f / 64.f) + 64e-5f);
      const float c3 = ((const float*)(ch + CH_C3))[t];
      const size_t row = (size_t)(b * SEQ + chunk * RC + t); const int c0 = hd * HD + 32 * hf;
      const u32x4* vr = (const u32x4*)(VR + t * 64 + 32 * hf); const u32x4* gp = (const u32x4*)(p + row * NINP + OFF_GB + c0); u32x4* yo = (u32x4*)(ybuf + row * DM + LRU_W + c0);
      const f32x4* lwp = (const f32x4*)(P.ln_w + c0); const f32x4* lbp = (const f32x4*)(P.ln_b + c0);
      u32x4 vvq[4], ggq[4]; f32x4 lwq[8], lbq[8];
#pragma unroll
      for (int q = 0; q < 4; ++q) { vvq[q] = vr[q]; ggq[q] = gp[q]; lwq[2 * q] = lwp[2 * q]; lwq[2 * q + 1] = lwp[2 * q + 1]; lbq[2 * q] = lbp[2 * q]; lbq[2 * q + 1] = lbp[2 * q + 1]; }
      asm volatile("" : "+v"(vvq[0]), "+v"(vvq[1]), "+v"(vvq[2]), "+v"(vvq[3]), "+v"(ggq[0]), "+v"(ggq[1]), "+v"(ggq[2]), "+v"(ggq[3]));
      asm volatile("" : "+v"(lwq[0]), "+v"(lwq[1]), "+v"(lwq[2]), "+v"(lwq[3]), "+v"(lwq[4]), "+v"(lwq[5]), "+v"(lwq[6]), "+v"(lwq[7]));
      asm volatile("" : "+v"(lbq[0]), "+v"(lbq[1]), "+v"(lbq[2]), "+v"(lbq[3]), "+v"(lbq[4]), "+v"(lbq[5]), "+v"(lbq[6]), "+v"(lbq[7]));
#pragma unroll
      for (int q = 0; q < 4; ++q) { const u32x4 vv = vvq[q], gg = ggq[q]; const f32x4 w0 = lwq[2 * q], w1 = lwq[2 * q + 1], b0 = lbq[2 * q], b1 = lbq[2 * q + 1]; u32x4 o;
          const float wv[8] = {w0.x, w0.y, w0.z, w0.w, w1.x, w1.y, w1.z, w1.w}, bv[8] = {b0.x, b0.y, b0.z, b0.w, b1.x, b1.y, b1.z, b1.w};
#pragma unroll
          for (int e = 0; e < 4; ++e) { const float v0 = bflo(vv[e]), v1 = bfhi(vv[e]), g0 = bflo(gg[e]), g1 = bfhi(gg[e]);
              const float y0 = yv[8 * q + 2 * e] * rstd * wv[2 * e] + bv[2 * e] + c3 * v0, y1 = yv[8 * q + 2 * e + 1] * rstd * wv[2 * e + 1] + bv[2 * e + 1] + c3 * v1;
              o[e] = cvtpk(y0 * siluf_(g0), y1 * siluf_(g1)); }
          yo[q] = o; } }
}


__device__ __forceinline__ void phase_moba_kmean(const bf16* p, float* kmean, int vbid, int vgrid) {
    const int TID = tidx();
    const int lane = TID & 63, wave = TID >> 6;
    for (int item = vbid * NWAVES + wave; item < NB * NH * NBLK; item += vgrid * NWAVES) {
        const int n = item % NBLK, bh = item / NBLK, b = bh / NH, h = bh % NH;
        const bf16* kp = p + (size_t)(b * SEQ + n * BLK + (lane >> 3)) * NINP + OFF_QKV + MOW + h * HD + (lane & 7) * 8;
        float s[8];
#pragma unroll
        for (int e = 0; e < 8; ++e) s[e] = 0.f;
#pragma unroll
        for (int half = 0; half < 2; ++half) { u32x4 v[16];
#pragma unroll
            for (int q = 0; q < 16; ++q) v[q] = *(const u32x4*)(kp + (size_t)(8 * (16 * half + q)) * NINP);
#pragma unroll
            for (int q = 0; q < 16; ++q)
#pragma unroll
                for (int e = 0; e < 4; ++e) { s[2 * e] += bflo(v[q][e]); s[2 * e + 1] += bfhi(v[q][e]); } }
#pragma unroll
        for (int e = 0; e < 8; ++e) { s[e] += dpp0<0x128, 0xf>(s[e]);
            s[e] += __builtin_bit_cast(float, __builtin_amdgcn_ds_swizzle(__builtin_bit_cast(int, s[e]), 0x401F));
            float a_ = s[e], b_ = s[e]; asm volatile("s_nop 1\n\tv_permlane32_swap_b32 %0, %1" : "+v"(a_), "+v"(b_)); s[e] = a_ + b_; }
        if (lane < 8) { float* dst = kmean + ((size_t)bh * NBLK + n) * HD + lane * 8;
            *(f32x4*)dst = (f32x4){s[0], s[1], s[2], s[3]} * (1.f / BLK); *(f32x4*)(dst + 4) = (f32x4){s[4], s[5], s[6], s[7]} * (1.f / BLK); }
    }
}
namespace attn_body {
using bf16=__hip_bfloat16;
using bf16x8=__attribute__((ext_vector_type(8)))short;
using s16x4=__attribute__((ext_vector_type(4)))short;
using f32x16=__attribute__((ext_vector_type(16)))float;
using u32x4=__attribute__((ext_vector_type(4)))unsigned;
using f32x4v=__attribute__((ext_vector_type(4)))float;
constexpr int BATCH=2,NHEAD=12,SEQ=4096,D=64,DM=7424;
constexpr int YP=2048, QCOL=4224, KCOL=4224+768, VCOL=4224+1536, GCOL=6528, YCOL=1280;
constexpr int NW=8,QBLK=32,QB=QBLK*NW,KVBLK=64,NQB=SEQ/QB;
constexpr int ATTN_PITCH=DM, ATTN_UNIT_ROWS=QB;
__device__ __forceinline__ int crow(int r,int hi){return (r&3)+8*(r>>2)+4*hi;}
#define SBAR() __builtin_amdgcn_sched_barrier(0)
__device__ __forceinline__ void moba_hook(f32x16&p0,f32x16&p1,int t,int NT,int qrel,int hi,unsigned selbits,const float*tab){
  const float NEG=-INFINITY;
  asm volatile("":"+v"(qrel));
  const int jb=t-(NT-4);
  if(t>=NT-6){
    const bool keep=jb>=0?true:(((selbits>>(t>>2))&1u)!=0u);
    const int dq=qrel-64*jb-4*hi;
    #pragma unroll
    for(int g=0;g<4;++g){
      #pragma unroll
      for(int rr=0;rr<4;++rr){ const int r=4*g+rr; const int d0=dq-((r&3)+8*(r>>2)), d1=d0-32;
        const int i0=d0<0?0:(d0<127?d0:127), i1=d1<0?0:(d1<127?d1:127);
        const float b0=tab[i0], b1=tab[i1];
        p0[r]=(keep&&d0>=0)?p0[r]+b0:NEG; p1[r]=(keep&&d1>=0)?p1[r]+b1:NEG; }
      asm volatile("":"+v"(p0),"+v"(p1)); SBAR();
    }
  } else {
    const bool keep=(selbits>>(t>>2))&1u;
    #pragma unroll
    for(int r=0;r<16;++r){p0[r]=keep?p0[r]:NEG; p1[r]=keep?p1[r]:NEG;}
  }
}
__device__ __forceinline__ void swap32(float&a,float&b){asm volatile("s_nop 1\n\tv_permlane32_swap_b32 %0, %1":"+v"(a),"+v"(b));}

constexpr int NSLOT=3, SLOTB=8192;
constexpr int LDS_K=0, LDS_V=NSLOT*SLOTB, LDS_WS=2*NSLOT*SLOTB, LDS_OST=LDS_WS+NW*64*4, LDS_TAB=LDS_OST+NW*4096, LDS_BYTES=LDS_TAB+512;
constexpr float C2=0.125f*1.4426950408889634f;
__device__ __forceinline__ void glds16(const void*gsrc,unsigned lds_dst){unsigned keep;
  asm volatile("s_mov_b32 %0, m0\n\ts_mov_b32 m0, %2\n\ts_nop 0\n\tglobal_load_lds_dwordx4 %1, off\n\ts_mov_b32 m0, %0":"=&s"(keep):"v"(gsrc),"s"(lds_dst):"memory");}
__device__ __forceinline__ float max3f(float a,float b,float c){float r;asm("v_max3_f32 %0, %1, %2, %3":"=v"(r):"v"(a),"v"(b),"v"(c));return r;}
__device__ __forceinline__ float max2f(float a,float b){float r;asm("v_max_f32_e32 %0, %1, %2":"=v"(r):"v"(a),"v"(b));return r;}
__device__ __forceinline__ float fadd_s(float a,float b){float r;asm("v_add_f32_e32 %0, %1, %2":"=v"(r):"v"(a),"v"(b));return r;}
__device__ __forceinline__ float fsub_s(float a,float b){float r;asm("v_sub_f32_e32 %0, %1, %2":"=v"(r):"v"(a),"v"(b));return r;}
typedef float f32x2_t __attribute__((ext_vector_type(2))); typedef __bf16 bf16x2_t __attribute__((ext_vector_type(2)));
__device__ __forceinline__ unsigned cvtpk_s(float lo,float hi){f32x2_t v={lo,hi};bf16x2_t b=__builtin_convertvector(v,bf16x2_t);return __builtin_bit_cast(unsigned,b);}
#define WAIT_BAR(N) asm volatile("s_waitcnt vmcnt(" #N ") lgkmcnt(0)\n\ts_barrier":::"memory")

__device__ __forceinline__ void qkt(f32x16&p0,f32x16&p1,const char*Kslot,const bf16x8*qr,const f32x16&negm,int r32,int hi){
  const char*kb=Kslot+hi*1024+r32*16;
  #pragma unroll
  for(int d0=0;d0<4;++d0){
    const bf16x8 b0=*reinterpret_cast<const bf16x8*>(kb+d0*2048);
    const bf16x8 b1=*reinterpret_cast<const bf16x8*>(kb+d0*2048+512);
    if(d0==0){p0=__builtin_amdgcn_mfma_f32_32x32x16_bf16(b0,qr[0],negm,0,0,0);p1=__builtin_amdgcn_mfma_f32_32x32x16_bf16(b1,qr[0],negm,0,0,0);}
    else{p0=__builtin_amdgcn_mfma_f32_32x32x16_bf16(b0,qr[d0],p0,0,0,0);p1=__builtin_amdgcn_mfma_f32_32x32x16_bf16(b1,qr[d0],p1,0,0,0);}}
}
typedef __attribute__((address_space(3))) const char* lds_cptr;
typedef short v4i16_t __attribute__((ext_vector_type(4)));
__device__ __forceinline__ void kload8(bf16x8*kf,lds_cptr kp){
  kf[0]=*(const __attribute__((address_space(3))) bf16x8*)(kp);      kf[1]=*(const __attribute__((address_space(3))) bf16x8*)(kp+512);
  kf[2]=*(const __attribute__((address_space(3))) bf16x8*)(kp+2048); kf[3]=*(const __attribute__((address_space(3))) bf16x8*)(kp+2560);
  kf[4]=*(const __attribute__((address_space(3))) bf16x8*)(kp+4096); kf[5]=*(const __attribute__((address_space(3))) bf16x8*)(kp+4608);
  kf[6]=*(const __attribute__((address_space(3))) bf16x8*)(kp+6144); kf[7]=*(const __attribute__((address_space(3))) bf16x8*)(kp+6656);
}
__device__ __forceinline__ void kload2(bf16x8*kf,lds_cptr kp,int j){ kf[2*j]=*(const __attribute__((address_space(3))) bf16x8*)(kp+j*2048); kf[2*j+1]=*(const __attribute__((address_space(3))) bf16x8*)(kp+j*2048+512); }
__device__ __forceinline__ s16x4 vtr(lds_cptr p){ return __builtin_bit_cast(s16x4,__builtin_amdgcn_ds_read_tr16_b64_v4i16((__attribute__((address_space(3))) v4i16_t*)p)); }
__device__ __forceinline__ float rowmax(const f32x16&p0,const f32x16&p1){
  float a=max3f(p0[0],p0[1],p1[0]),b=max3f(p0[2],p0[3],p1[1]);a=max3f(a,p1[2],p1[3]);
  #pragma unroll
  for(int r=4;r<16;r+=4){a=max3f(a,p0[r],p0[r+1]);b=max3f(b,p0[r+2],p0[r+3]);a=max3f(a,p1[r],p1[r+1]);b=max3f(b,p1[r+2],p1[r+3]);}
  float m=max2f(a,b), m2=m; swap32(m,m2);
  return max2f(m,m2);
}
__device__ __forceinline__ void pv(f32x16*o,int vb,bf16x8 pa0,bf16x8 pa1,bf16x8 pa2,bf16x8 pa3){
  #pragma unroll
  for(int d0=0;d0<2;++d0){s16x4 lo[4],hi[4];
    #pragma unroll
    for(int ks=0;ks<4;++ks){
      asm volatile("ds_read_b64_tr_b16 %0,%1 offset:%c2":"=&v"(lo[ks]):"v"(vb),"i"(d0*4096+ks*1024):"memory");
      asm volatile("ds_read_b64_tr_b16 %0,%1 offset:%c2":"=&v"(hi[ks]):"v"(vb),"i"(d0*4096+ks*1024+512):"memory");}
    asm volatile("s_waitcnt lgkmcnt(0)":::"memory");SBAR();
    #define PK(k) (bf16x8){lo[k][0],lo[k][1],lo[k][2],lo[k][3],hi[k][0],hi[k][1],hi[k][2],hi[k][3]}
    o[d0]=__builtin_amdgcn_mfma_f32_32x32x16_bf16(pa0,PK(0),o[d0],0,0,0);
    o[d0]=__builtin_amdgcn_mfma_f32_32x32x16_bf16(pa1,PK(1),o[d0],0,0,0);
    o[d0]=__builtin_amdgcn_mfma_f32_32x32x16_bf16(pa2,PK(2),o[d0],0,0,0);
    o[d0]=__builtin_amdgcn_mfma_f32_32x32x16_bf16(pa3,PK(3),o[d0],0,0,0);
    #undef PK
  }
}

#ifndef ATTN_STORE16
#define ATTN_STORE16(p,v) (*(u32x4*)(p)=(v))
#endif
template<int THRL> __device__ __forceinline__ void attn_unit(int b,int h,int qb,const bf16*__restrict__ Pq,const float*__restrict__ kmean_bh,const float*__restrict__ rel_bias,bf16*__restrict__ Yo,char*shm,unsigned*qctr,int nslot){
  int tid_=threadIdx.x; asm volatile("":"+v"(tid_)); const int tid=tid_,lane=tid&63,r32=lane&31,hi=lane>>5; const int wid=__builtin_amdgcn_readfirstlane(tid>>6);
  const long rowbase=(long)b*SEQ; const int q0=qb*QB;
  const bf16*Qw=Pq+(rowbase+q0+wid*QBLK)*DM+QCOL+h*D;
  const bf16*Kh=Pq+rowbase*DM+KCOL+h*D,*Vh=Pq+rowbase*DM+VCOL+h*D;
  float*tab=(float*)(shm+LDS_TAB);
  const unsigned lds0=(unsigned)(uintptr_t)shm;
  float*wsf=(float*)(shm+LDS_WS)+wid*64;
  const bf16*ksrc=Kh+(long)lane*DM+wid*8;
  const bf16*vsrc=Vh+(long)(16*(wid&3)+(lane>>2))*DM+(wid>>2)*32+(lane&3)*8;
  const unsigned kdst=lds0+LDS_K+wid*1024, vdst=lds0+LDS_V+wid*1024;
  #define DMA_K(t,slot) glds16(ksrc+(long)(t)*KVBLK*DM,(unsigned)__builtin_amdgcn_readfirstlane(kdst+(slot)))
  #define DMA_V(t,slot) glds16(vsrc+(long)(t)*KVBLK*DM,(unsigned)__builtin_amdgcn_readfirstlane(vdst+(slot)))
  const int vb0=(int)(lds0+LDS_V)+((lane>>4)&1)*32+(lane&3)*8+(4*hi+((lane&15)>>2))*64;
  const char*Kbase=shm+LDS_K; bf16x8 kf[8];
  const lds_cptr shm3=(lds_cptr)shm; const lds_cptr kp0=shm3+LDS_K+hi*1024+r32*16; const lds_cptr vp0=shm3+LDS_V+((lane>>4)&1)*32+(lane&3)*8+(4*hi+((lane&15)>>2))*64;
  const int NT=(q0+QB)/KVBLK;
  DMA_K(0,0);DMA_V(0,0);DMA_K(1,SLOTB);
  bf16x8 qr[4];
  #pragma unroll
  for(int d0=0;d0<4;++d0)qr[d0]=*reinterpret_cast<const bf16x8*>(&Qw[(long)r32*DM+d0*16+hi*8]);
  if(tid<128){ const int n=tid; int bk=n; if(n>=16){ bk=16+(int)(logf((float)n/16.f)/2.0794415416798357f*16.f); bk=bk<31?bk:31; }
    tab[n]=(rel_bias[bk*NHEAD+h]-rel_bias[31*NHEAD+h])*1.4426950408889634f; }
  unsigned selbits=0u;
  { float qf[32];
    #pragma unroll
    for(int d0=0;d0<4;++d0){
      #pragma unroll
      for(int j=0;j<8;++j)qf[8*d0+j]=__uint_as_float(((unsigned)(unsigned short)qr[d0][j])<<16); }
    int s0=-1,s1=-1,s2=-1; float g0=-INFINITY,g1=-INFINITY,g2=-INFINITY;
    for(int n=0;n<qb;++n){ const float*km=kmean_bh+n*64+8*hi; float g=0.f;
      #pragma unroll
      for(int d0=0;d0<4;++d0){ const f32x4v k0=*(const f32x4v*)(km+16*d0), k1=*(const f32x4v*)(km+16*d0+4);
        g+=qf[8*d0+0]*k0[0]+qf[8*d0+1]*k0[1]+qf[8*d0+2]*k0[2]+qf[8*d0+3]*k0[3]+qf[8*d0+4]*k1[0]+qf[8*d0+5]*k1[1]+qf[8*d0+6]*k1[2]+qf[8*d0+7]*k1[3]; }
      float g_=g; swap32(g,g_); g=g+g_;
      if(g>g0){g2=g1;s2=s1;g1=g0;s1=s0;g0=g;s0=n;} else if(g>g1){g2=g1;s2=s1;g1=g;s1=n;} else if(g>g2){g2=g;s2=n;} }
    if(s0>=0)selbits|=1u<<s0; if(s1>=0)selbits|=1u<<s1; if(s2>=0)selbits|=1u<<s2; }
  float mhat=0.f,l_reg=0.f;f32x16 o[2];o[0]=f32x16{};o[1]=f32x16{};f32x16 negm=f32x16{};asm volatile("":"+v"(negm));
  const int qrel=wid*QBLK+r32;
  #define CMASK(P0,P1,t) moba_hook(P0,P1,t,NT,qrel,hi,selbits,tab)
  bool resc=false;
  #define START(P0,P1) do{ const float rm=rowmax(P0,P1); resc=false; \
    { const float dl=rm<-1e30f?-1024.f:rm; mhat=fadd_s(mhat,dl); \
      _Pragma("unroll") for(int r=0;r<16;++r){P0[r]=fsub_s(P0[r],dl);P1[r]=fsub_s(P1[r],dl);} \
      _Pragma("unroll") for(int r=0;r<16;++r)negm[r]=-mhat; asm volatile("":"+v"(negm)); } \
    _Pragma("unroll") for(int r=0;r<16;++r)P0[r]=__builtin_amdgcn_exp2f(P0[r]); }while(0)
  #define RESC() do{ if(resc){ asm volatile("s_waitcnt lgkmcnt(0)":::"memory"); \
      _Pragma("unroll") for(int d_=0;d_<2;++d_) _Pragma("unroll") for(int r=0;r<16;++r)o[d_][r]*=wsf[crow(r,hi)]; } }while(0)
  f32x16 pA0,pA1,pB0,pB1;
  int sl_prev=0,sl_cur=0,sl_next=SLOTB;
  #define ROT() do{sl_prev=sl_cur;sl_cur=sl_next;sl_next=(sl_next==(NSLOT-1)*SLOTB)?0:sl_next+SLOTB;}while(0)
  DMA_K(2,2*SLOTB);
  if(tid==448){ const unsigned nx_=__hip_atomic_fetch_add(qctr,1u,__ATOMIC_RELAXED,__HIP_MEMORY_SCOPE_AGENT); *(volatile __attribute__((address_space(3))) unsigned*)(lds0+131072u+320u+4u*(unsigned)nslot)=nx_; }
  WAIT_BAR(3);
  qkt(pA0,pA1,Kbase,qr,negm,r32,hi);asm volatile("s_nop 15\n\ts_nop 7":"+v"(pA0),"+v"(pA1));CMASK(pA0,pA1,0);
  START(pA0,pA1);
  _Pragma("unroll") for(int r=0;r<16;++r)pA1[r]=__builtin_amdgcn_exp2f(pA1[r]);
  WAIT_BAR(0);
  DMA_K(3,0);DMA_V(1,SLOTB);
  ROT();
  kload8(kf,kp0+sl_cur);
  WAIT_BAR(2);
  s16x4 vlo[8],vhi[8]; u32x4 pw0,pw1,pw2,pw3;
  #define PKW(P,B) cvtpk_s(P[B],P[B+1])
  #define PAF(k) __builtin_bit_cast(bf16x8,pw##k)
  #define VFR(i) (bf16x8){vlo[i][0],vlo[i][1],vlo[i][2],vlo[i][3],vhi[i][0],vhi[i][1],vhi[i][2],vhi[i][3]}
  #define PIN(x) asm volatile("":"+v"(x))
  #define MX3(a,b,c) __builtin_fmaxf(__builtin_fmaxf((a),(b)),(c))
  #define GAPA(MF,A0,A1,A2,A3,W0,W1,PW) do{ MF; sacc+=A0; sacc+=A1; sacc+=A2; sacc+=A3; PIN(sacc); W0; W1; PIN(PW); SBAR(); }while(0)
  #define EX(v) __builtin_amdgcn_exp2f(v)
  #define GAPB(MF,X,B) do{ MF; X[B]=EX(X[B]); X[B+1]=EX(X[B+1]); X[B+2]=EX(X[B+2]); X[B+3]=EX(X[B+3]); PIN(X); SBAR(); }while(0)
  #define VRD(i) do{ vlo[i]=vtr(vp_+(((i)>>2)*4096+((i)&3)*1024)); vhi[i]=vtr(vp_+(((i)>>2)*4096+((i)&3)*1024+512)); }while(0)
  #define KRD(G,j) do{ if(G){ kload2(kf,kp0+sl_next,j); SBAR(); } }while(0)
  #define STEP(C0,C1,P0,P1,t,GK,GV,GL) do{ SBAR(); \
    const lds_cptr vp_=vp0+sl_prev; \
    VRD(0); SBAR(); float sacc=(P0[0]+P0[1]); \
    GAPA(C0=__builtin_amdgcn_mfma_f32_32x32x16_bf16(kf[0],qr[0],negm,0,0,0), P0[2],P0[3],P0[4],P0[5],     pw0[0]=PKW(P0,0), pw0[1]=PKW(P0,2), pw0); \
    VRD(4); SBAR(); GAPA(C1=__builtin_amdgcn_mfma_f32_32x32x16_bf16(kf[1],qr[0],negm,0,0,0), P0[6],P0[7],P0[8],P0[9],     pw0[2]=PKW(P0,4), pw0[3]=PKW(P0,6), pw0); \
    VRD(1); SBAR(); GAPA(C0=__builtin_amdgcn_mfma_f32_32x32x16_bf16(kf[2],qr[1],C0,0,0,0),   P0[10],P0[11],P0[12],P0[13], pw1[0]=PKW(P0,8), pw1[1]=PKW(P0,10), pw1); \
    VRD(5); SBAR(); GAPA(C1=__builtin_amdgcn_mfma_f32_32x32x16_bf16(kf[3],qr[1],C1,0,0,0),   P0[14],P0[15],P1[0],P1[1],   pw1[2]=PKW(P0,12),pw1[3]=PKW(P0,14), pw1); \
    VRD(2); SBAR(); GAPA(C0=__builtin_amdgcn_mfma_f32_32x32x16_bf16(kf[4],qr[2],C0,0,0,0),   P1[2],P1[3],P1[4],P1[5],     pw2[0]=PKW(P1,0), pw2[1]=PKW(P1,2), pw2); \
    VRD(6); SBAR(); GAPA(C1=__builtin_amdgcn_mfma_f32_32x32x16_bf16(kf[5],qr[2],C1,0,0,0),   P1[6],P1[7],P1[8],P1[9],     pw2[2]=PKW(P1,4), pw2[3]=PKW(P1,6), pw2); \
    VRD(3); SBAR(); GAPA(C0=__builtin_amdgcn_mfma_f32_32x32x16_bf16(kf[6],qr[3],C0,0,0,0),   P1[10],P1[11],P1[12],P1[13], pw3[0]=PKW(P1,8), pw3[1]=PKW(P1,10), pw3); \
    VRD(7); SBAR(); GAPA(C1=__builtin_amdgcn_mfma_f32_32x32x16_bf16(kf[7],qr[3],C1,0,0,0),   P1[14],P1[15],0.f,0.f,       pw3[2]=PKW(P1,12),pw3[3]=PKW(P1,14), pw3); \
    l_reg+=sacc; \
    if(GK){DMA_K((t)+3,sl_cur);} if(GV){DMA_V((t)+1,sl_next);} \
    CMASK(C0,C1,t); \
    { float a=MX3(C0[0],C0[1],C1[0]),b=MX3(C0[2],C0[3],C1[1]); a=MX3(a,C1[2],C1[3]); \
      _Pragma("unroll") for(int r=4;r<16;r+=4){a=MX3(a,C0[r],C0[r+1]);b=MX3(b,C0[r+2],C0[r+3]);a=MX3(a,C1[r],C1[r+1]);b=MX3(b,C1[r+2],C1[r+3]);} \
      float rm=__builtin_fmaxf(a,b); { float rm2_=rm; swap32(rm,rm2_); rm=__builtin_fmaxf(rm,rm2_); } \
      resc=false; \
      if(__builtin_expect(__any(rm>(float)THRL),0)){ const float dl=__builtin_fmaxf(rm,0.f); mhat+=dl; \
        _Pragma("unroll") for(int r=0;r<16;++r){C0[r]-=dl;C1[r]-=dl;} \
        _Pragma("unroll") for(int r=0;r<16;++r)negm[r]=-mhat; asm volatile("":"+v"(negm)); \
        const float f=__builtin_amdgcn_exp2f(-dl); l_reg*=f; if(hi==0)wsf[r32]=f; resc=true; } } \
    SBAR(); \
    GAPB(o[0]=__builtin_amdgcn_mfma_f32_32x32x16_bf16(PAF(0),VFR(0),o[0],0,0,0), C0,0); \
    GAPB(o[1]=__builtin_amdgcn_mfma_f32_32x32x16_bf16(PAF(0),VFR(4),o[1],0,0,0), C0,4); \
    KRD(GL,0); GAPB(o[0]=__builtin_amdgcn_mfma_f32_32x32x16_bf16(PAF(1),VFR(1),o[0],0,0,0), C0,8); \
    KRD(GL,1); GAPB(o[1]=__builtin_amdgcn_mfma_f32_32x32x16_bf16(PAF(1),VFR(5),o[1],0,0,0), C0,12); \
    KRD(GL,2); GAPB(o[0]=__builtin_amdgcn_mfma_f32_32x32x16_bf16(PAF(2),VFR(2),o[0],0,0,0), C1,0); \
    KRD(GL,3); GAPB(o[1]=__builtin_amdgcn_mfma_f32_32x32x16_bf16(PAF(2),VFR(6),o[1],0,0,0), C1,4); \
    GAPB(o[0]=__builtin_amdgcn_mfma_f32_32x32x16_bf16(PAF(3),VFR(3),o[0],0,0,0), C1,8); \
    GAPB(o[1]=__builtin_amdgcn_mfma_f32_32x32x16_bf16(PAF(3),VFR(7),o[1],0,0,0), C1,12); \
    }while(0)
  int t=1;
  for(;t+5<NT;t+=2){
    STEP(pB0,pB1,pA0,pA1,t,true,true,true);     WAIT_BAR(2); RESC(); ROT();
    STEP(pA0,pA1,pB0,pB1,t+1,true,true,true);   WAIT_BAR(2); RESC(); ROT();
  }
  #define ENDW(tt) do{ if((tt)+3<NT){WAIT_BAR(2);} else if((tt)+2<NT){WAIT_BAR(1);} else {WAIT_BAR(0);} }while(0)
  for(;t+1<NT;t+=2){
    STEP(pB0,pB1,pA0,pA1,t,(t+3<NT),(t+1<NT),(t+1<NT));       ENDW(t);   RESC(); ROT();
    STEP(pA0,pA1,pB0,pB1,t+1,(t+4<NT),(t+2<NT),(t+2<NT));     ENDW(t+1); RESC(); ROT();
  }
  STEP(pB0,pB1,pA0,pA1,NT-1,false,false,false); RESC();
  { float sacc=pB0[0]+pB0[1]; _Pragma("unroll") for(int r=2;r<16;++r)sacc+=pB0[r]; _Pragma("unroll") for(int r=0;r<16;++r)sacc+=pB1[r]; l_reg+=sacc;
    pw0=(u32x4){PKW(pB0,0),PKW(pB0,2),PKW(pB0,4),PKW(pB0,6)};pw1=(u32x4){PKW(pB0,8),PKW(pB0,10),PKW(pB0,12),PKW(pB0,14)};pw2=(u32x4){PKW(pB1,0),PKW(pB1,2),PKW(pB1,4),PKW(pB1,6)};pw3=(u32x4){PKW(pB1,8),PKW(pB1,10),PKW(pB1,12),PKW(pB1,14)};
    SBAR(); pv(o,vb0+sl_cur,PAF(0),PAF(1),PAF(2),PAF(3)); }
  #undef PKW
  #undef PAF
  #undef VFR
  #undef PIN
  #undef MX3
  #undef GAPA
  #undef GAPB
  #undef EX
  #undef VRD
  #undef KRD
  #undef STEP
  #undef ENDW
  { float l2_=l_reg; swap32(l_reg,l2_); l_reg=l_reg+l2_; }
  if(hi==0)wsf[32+r32]=l_reg;asm volatile("s_waitcnt lgkmcnt(0)":::"memory");
  float rli[16];
  #pragma unroll
  for(int r=0;r<16;++r)rli[r]=__builtin_amdgcn_rcpf(wsf[32+crow(r,hi)]);
  bf16*Ow=Yo+(rowbase+q0+wid*QBLK)*YP+YCOL+h*D; const bf16*Gw=Pq+(rowbase+q0+wid*QBLK)*DM+GCOL+h*D;
  { bf16*stg=(bf16*)(shm+LDS_OST)+wid*2048;
    #pragma unroll
    for(int r=0;r<16;++r){const int orow=crow(r,hi);
      #pragma unroll
      for(int d0=0;d0<2;++d0)stg[orow*64+d0*32+r32]=__float2bfloat16(o[d0][r]*rli[r]);}
    asm volatile("s_waitcnt lgkmcnt(0)":::"memory");
    #pragma unroll
    for(int i=0;i<4;++i){const int row=i*8+(lane>>3),ch=lane&7; const u32x4 v=*(const u32x4*)(stg+row*64+ch*8); const u32x4 g=*(const u32x4*)(Gw+(long)row*DM+ch*8); u32x4 w;
      #pragma unroll
      for(int e=0;e<4;++e){ const float a0=__uint_as_float(v[e]<<16),a1=__uint_as_float(v[e]&0xffff0000u),g0=__uint_as_float(g[e]<<16),g1=__uint_as_float(g[e]&0xffff0000u);
        w[e]=cvtpk_s(a0*g0*__builtin_amdgcn_rcpf(1.f+__expf(-g0)),a1*g1*__builtin_amdgcn_rcpf(1.f+__expf(-g1))); }
      ATTN_STORE16(Ow+(long)row*YP+ch*8,w);} }
  asm volatile("s_waitcnt lgkmcnt(0)\n\ts_barrier":::"memory");
  #undef DMA_K
  #undef DMA_V
  #undef CMASK
  #undef START
  #undef RESC
  #undef ROT
}
constexpr int ATTN_LDS_BYTES=LDS_BYTES;
#undef SBAR
#undef WAIT_BAR
}

#define LAS __attribute__((address_space(3)))
#define XB_TMO      128
#define XB_XCNT(j)  (256  + 64 * (j))
#define XB_XSUB(j)  (1280 + 64 * (j))
#define XB_XGEN(j)  (2304 + 64 * (j))
#define XB_TOP      3328
#define XB_TOPGEN   3392
#define XCD_BAR_WORDS 3456
#define XB_SPIN_CAP (1u << 18)

__device__ __forceinline__ unsigned xb_ld(unsigned* p)              { return __hip_atomic_load(p, __ATOMIC_RELAXED, __HIP_MEMORY_SCOPE_AGENT); }
__device__ __forceinline__ unsigned xb_add(unsigned* p, unsigned v) { return __hip_atomic_fetch_add(p, v, __ATOMIC_RELAXED, __HIP_MEMORY_SCOPE_AGENT); }
__device__ __forceinline__ unsigned xb_xcc_id() { return (unsigned)__builtin_amdgcn_s_getreg((3 << 11) | 20) & 0xFu; }
#define XB_SPIN(cond, bar) do { unsigned _sp = 0; while (cond) { __builtin_amdgcn_s_sleep(1); \
    if ((++_sp & 255u) == 0u) { if (xb_ld(&(bar)[XB_TMO])) break; if (_sp > XB_SPIN_CAP) { atomicAdd(&(bar)[XB_TMO], 1u); break; } } } } while (0)

struct XcdBarrier {
    unsigned* bar; unsigned x;
    volatile LAS unsigned* st;
};

__device__ __forceinline__ XcdBarrier xcd_barrier_post(unsigned* bar, volatile LAS unsigned* st) {
    XcdBarrier b; b.bar = bar; b.x = (unsigned)__builtin_amdgcn_readfirstlane((int)xb_xcc_id()); b.st = st;
    if (threadIdx.x == 0) (void)xb_add(&bar[XB_XCNT(b.x)], 1u);
    return b;
}
__device__ __forceinline__ void xcd_barrier_complete(unsigned* bar, unsigned x, unsigned& nloc, unsigned& nx) {
    const unsigned G = gridDim.x * gridDim.y * gridDim.z;
    unsigned sum, cnt, mine, sp = 0u;
    for (;;) {
        sum = 0u; cnt = 0u; mine = 0u;
#pragma unroll
        for (unsigned j = 0; j < 16; ++j) { const unsigned c = xb_ld(&bar[XB_XCNT(j)]); sum += c; cnt += (c > 0u) ? 1u : 0u; mine = (j == x) ? c : mine; }
        if (sum == G) break;
        __builtin_amdgcn_s_sleep(1);
        if ((++sp & 255u) == 0u) { if (xb_ld(&bar[XB_TMO])) break; if (sp > XB_SPIN_CAP) { atomicAdd(&bar[XB_TMO], 1u); break; } }
    }
    nloc = mine > 0u ? mine : 1u; nx = cnt > 0u ? cnt : 1u;
}

__device__ __forceinline__ void xcd_barrier(const XcdBarrier& b) {
    asm volatile("s_waitcnt vmcnt(0)" ::: "memory");
    __syncthreads();
    if (threadIdx.x == 0) {
        unsigned* bar = b.bar; asm volatile("" : "+s"(bar)); unsigned bx = b.x; asm volatile("" : "+s"(bx));
        __builtin_amdgcn_s_waitcnt(0);
        unsigned nloc = b.st[0], nx = b.st[1];
        if (nloc == 0u) { xcd_barrier_complete(bar, bx, nloc, nx); b.st[0] = nloc; b.st[1] = nx; }
        const unsigned old = xb_add(&bar[XB_XSUB(bx)], 1u);
        const unsigned gen = old / nloc;
        if (old + 1u == (gen + 1u) * nloc) {
            __builtin_amdgcn_fence(__ATOMIC_RELEASE, "agent");
            asm volatile("s_waitcnt vmcnt(0)" ::: "memory");
            const unsigned og = xb_add(&bar[XB_TOP], 1u);
            const unsigned tg = og / nx;
            if (og + 1u == (tg + 1u) * nx) xb_add(&bar[XB_TOPGEN], 1u);
            else XB_SPIN(xb_ld(&bar[XB_TOPGEN]) == tg, bar);
            __builtin_amdgcn_fence(__ATOMIC_ACQUIRE, "agent");
            asm volatile("s_waitcnt vmcnt(0)" ::: "memory");
        } else {
            XB_SPIN(xb_ld(&bar[XB_TOPGEN]) == gen, bar);
            __builtin_amdgcn_fence(__ATOMIC_ACQUIRE, "agent");
            asm volatile("s_waitcnt vmcnt(0)" ::: "memory");
        }
    }
    __syncthreads();
}

namespace cg = cooperative_groups;
__global__ void __launch_bounds__(NTHREADS, 2) mega_fwd(Args a) {
    extern __shared__ __attribute__((aligned(16))) unsigned char lds[];
    cg::grid_group grid = cg::this_grid();
    float* lds_f = (float*)lds;
    unsigned char* ws = a.ws;
    bf16* WinT = (bf16*)(ws + WS_WINT); bf16* WoutT = (bf16*)(ws + WS_WOUTT); bf16* X = (bf16*)(ws + WS_X); bf16* H = (bf16*)(ws + WS_H); bf16* Pb = (bf16*)(ws + WS_P); bf16* Y = (bf16*)(ws + WS_Y);
    RwcBuf RB; RB.CH = ws + WS_RW; RB.ST = ws + WS_RWST; RB.O1 = ws + WS_O1;
    float* kmean = (float*)(ws + WS_KMEAN);
    LruBuf LB; LB.HL = (float*)(ws + WS_LRU); LB.AC = LB.HL + (size_t)MROWS * LRU_W; LB.SH = LB.AC + (size_t)MROWS * LRU_W; LB.SA = LB.SH + NB * NSEG * LRU_W;
    const int G = gridDim.x, bid = blockIdx.x;
    volatile LAS unsigned* MISC = (volatile LAS unsigned*)((LAS unsigned char*)lds + 131072 + 320);
    if (threadIdx.x < 64) MISC[threadIdx.x] = 0u;
    __syncthreads();
    grid.sync();
    XcdBarrier bar = xcd_barrier_post((unsigned*)(ws + WS_CTL) + 4096, MISC + 8);
#define GRID_BAR() xcd_barrier(bar)

    phase_prep_weights(a, lds_f);
    for (int l = 0; l < DEPTH; ++l) {
        const void* xcur = l == 0 ? (const void*)a.in[0] : (const void*)X; const int xf32 = l == 0;
        if (l == 0) { const int i = bid * NTHREADS + tidx(); if (i < NB * NH * NBLK * HD) kmean[i] = 0.f; }
        if (l == 0 || G != 256) { phase_rmsnorm<false>(xcur, xf32, a.in[1] + (size_t)l * DM, H, (float*)(ws + WS_CTL + 512 * 1024));
        GRID_BAR(); }
        for (int rep = 0; rep < (PROBE_PH == 2 ? 2 : 1); ++rep) {
        { pg8::Gemm g{l == 0 ? H : X, WinT + (size_t)l * NINP * DM, MROWS, NINP, DM};   pg8::StaticOrder S; S.init(MROWS, NINP, G, bid);
          EpiP E{Pb, NINP, (const float*)(ws + WS_CTL + 512 * 1024), kmean};
          pg8::gemm_phase<EpiP, pg8::StaticOrder, true, true>((PG8_LAS unsigned char*)lds, g, S, E); }
        GRID_BAR(); }
        { RwkvP P{a.in[11] + (size_t)l * RSTREAM, a.in[12] + (size_t)l * RW, a.in[13] + (size_t)l * 64 * RW, a.in[14] + (size_t)l * RW, a.in[15] + (size_t)l * 64 * RW,
                  a.in[16] + (size_t)l * RW, a.in[17] + (size_t)l * RW, a.in[18] + (size_t)l * RW, a.in[19] + (size_t)l * RW, a.in[20] + (size_t)l * RW,
                  (const bf16*)(ws + WS_LORA) + (size_t)l * NH * 2 * 64 * 64};
          { LruP LP{a.in[4] + (size_t)l * 4 * LRU_W, a.in[5] + (size_t)l * LRU_W, a.in[6] + (size_t)l * 8 * 4096, a.in[7] + (size_t)l * LRU_W, a.in[8] + (size_t)l * 8 * 4096, a.in[9] + (size_t)l * LRU_W, a.in[10] + (size_t)l * LRU_W};
            if (PROBE_PH == 31) { for (int u = bid; u < NB * 8 * NSEG; u += G) lru_local_unit(u, Pb, LP, LB, lds_f); GRID_BAR(); } }
          if (PROBE_PH == 34) { for (int u = bid; u < MROWS / 32; u += G) rwkv_phaseA(u, Pb, P, RB, (unsigned char*)lds); GRID_BAR(); }
          if (PROBE_PH == 35) { for (int u = bid; u < MROWS / 32; u += G) { const int bb_ = (u * 32) >> 12, ck_ = ((u * 32) & (SEQ - 1)) >> 5; const int wv_ = tidx() >> 6;
              for (int k = wv_; k < NH; k += NWAVES) rwkv_stage1((bb_ * NH + k) * NCH + ck_, RB, (unsigned char*)lds + wv_ * 16384); } GRID_BAR(); }
          for (int rep = 0; rep < (PROBE_PH == 32 ? 2 : 1); ++rep) { if (PROBE_PH == 32 && rep == 1) GRID_BAR();
          for (int u = bid; u < MROWS / 32; u += G) {
              rwkv_phaseA(u, Pb, P, RB, (unsigned char*)lds);
              const int bb_ = (u * 32) >> 12, ck_ = ((u * 32) & (SEQ - 1)) >> 5; const int wv_ = tidx() >> 6;
              { const int k = wv_ < 4 ? wv_ : wv_ + 4;
                rwkv_stage1((bb_ * NH + k) * NCH + ck_, RB, (unsigned char*)lds + wv_ * 16384); }
              __syncthreads(); } }
          GRID_BAR();
          if (PROBE_PH == 41) { if (bid < NB * NH) rwkv_stage2(bid, RB, (unsigned char*)lds); GRID_BAR(); }
          if (bid < NB * NH) rwkv_stage2(bid, RB, (unsigned char*)lds);
          else { LruP LP{a.in[4] + (size_t)l * 4 * LRU_W, a.in[5] + (size_t)l * LRU_W, a.in[6] + (size_t)l * 8 * 4096, a.in[7] + (size_t)l * LRU_W, a.in[8] + (size_t)l * 8 * 4096, a.in[9] + (size_t)l * LRU_W, a.in[10] + (size_t)l * LRU_W};
              for (int u = bid - NB * NH; u < NB * 8 * NSEG; u += G - NB * NH) lru_local_unit(u, Pb, LP, LB, lds_f); }
          {
            unsigned* qc = (unsigned*)(ws + WS_CTL) + 8192 + 64 * (2 * l);
            __syncthreads();
            if (threadIdx.x == 0) MISC[16] = __hip_atomic_fetch_add(qc, 1u, __ATOMIC_RELAXED, __HIP_MEMORY_SCOPE_AGENT);
            __syncthreads();
            int idx = (int)MISC[16], slot = 0;
            while (idx < NB * NH * NBLK) {
                const int qb = NBLK - 1 - idx / (NB * NH), bh = idx % (NB * NH);
                attn_body::attn_unit<8>(bh / NH, bh % NH, qb, (const attn_body::bf16*)Pb, kmean + (size_t)bh * NBLK * HD, a.in[21], (attn_body::bf16*)Y, (char*)lds, qc, 17 + slot);
                idx = (int)MISC[17 + slot]; slot ^= 1; }
          }
          GRID_BAR();
          { const int i = bid * NTHREADS + tidx(); if (i < NB * NH * NBLK * HD) kmean[i] = 0.f; }
          for (int rep = 0; rep < (PROBE_PH == 5 ? 2 : 1); ++rep) {
          { const int wv_ = tidx() >> 6; for (int it = bid * NWAVES + wv_; it < NB * NH * NCH; it += G * NWAVES) rwkv_stage3(it, Pb, P, RB, Y, (unsigned char*)lds + wv_ * 16384); }
          for (int u = bid; u < NB * 8 * NSEG; u += G) lru_final_unit(u, Pb, LB, Y, lds_f);
          if (PROBE_PH == 5 && rep == 0) GRID_BAR(); }
        }
        GRID_BAR();
        { pg8::Gemm g{Y, WoutT + (size_t)l * DM * DM, MROWS, DM, DM}; pg8::StaticOrder S; S.init(MROWS, DM, G, bid);
          float* lpart = (float*)((unsigned char*)lds + 132096);
          EpiRes E{xcur, X, DM, xf32, lpart};
          pg8::gemm_phase<EpiRes, pg8::StaticOrder, true, true>((PG8_LAS unsigned char*)lds, g, S, E);
          __syncthreads();
          { pg8::Unit u; const int t_ = tidx(); if (G == 256 && S.next(0, u) && t_ < 256) ((float*)(ws + WS_CTL + 512 * 1024))[(size_t)(u.pm * 256 + t_) * 8 + u.pn] = (lpart[t_] + lpart[256 + t_]) + (lpart[512 + t_] + lpart[768 + t_]); } }
        GRID_BAR();
    }
    phase_rmsnorm<true>(X, 0, a.in[22], nullptr, a.out);
}

extern "C" void kernel_launch(void* const* d_in, const int* in_sizes, int n_in, void* d_out, int out_size, void* d_ws, size_t ws_size, hipStream_t stream) {
    static int grid_blocks = 0;
    if (grid_blocks == 0) {
        if (ws_size < WS_END || n_in != 23) { fprintf(stderr, "kernel_launch: bad workspace/inputs: ws %zu need %zu, n_in %d\n", ws_size, (size_t)WS_END, n_in); grid_blocks = -1; return; }
        int dev = 0, cus = 0, per_cu = 0;
        (void)hipGetDevice(&dev); (void)hipDeviceGetAttribute(&cus, hipDeviceAttributeMultiprocessorCount, dev);
        (void)hipFuncSetAttribute((const void*)mega_fwd, hipFuncAttributeMaxDynamicSharedMemorySize, LDS_BYTES);
        (void)hipOccupancyMaxActiveBlocksPerMultiprocessor(&per_cu, (const void*)mega_fwd, NTHREADS, LDS_BYTES);
        if (per_cu < 1) { fprintf(stderr, "kernel_launch: occupancy query says %d blocks per CU\n", per_cu); per_cu = 1; }
        if (cus != 256) fprintf(stderr, "kernel_launch: this build assumes 256 compute units (one GEMM2 tile per workgroup), found %d\n", cus);
        grid_blocks = cus;
        fprintf(stderr, "kernel_launch: cus %d per_cu %d grid %d\n", cus, per_cu, grid_blocks);
    }
    if (grid_blocks < 0) return;
    Args a; memset(&a, 0, sizeof(a));
    for (int i = 0; i < 23; ++i) a.in[i] = (const float*)d_in[i];
    a.out = (float*)d_out; a.ws = (unsigned char*)d_ws;
    (void)hipMemsetAsync((unsigned char*)d_ws + WS_CTL, 0, 1 * MiB, stream);
    void* args[] = {&a};
    hipError_t e = hipLaunchCooperativeKernel((const void*)mega_fwd, dim3(grid_blocks), dim3(NTHREADS), args, LDS_BYTES, stream);
    if (e != hipSuccess) fprintf(stderr, "cooperative launch failed: %s (grid %d)\n", hipGetErrorString(e), grid_blocks);
}
```
